# Optimizing an MI355X kernel written in HIP

```python
import jax, jax.numpy as jnp
from jax import lax
import numpy as np

D_MODEL = 1024
BATCH = 8
SEQ = 8192
DEPTH = 2

N_BRANCH = 4
BRANCH_WIDTH = D_MODEL // 4
HEAD_DIM = 64
N_HEADS = BRANCH_WIDTH // HEAD_DIM
CONV_WIDTH = 31
ROPE_THETA = 500000.0
ROPE_DIMS = HEAD_DIM // 4
TOPK_MAX = 256
Q_BLOCK = 128
IDX_HEADS = 4
IDX_DIM = 64
GLA_DK = HEAD_DIM // 2
GLA_QK_WIDTH = N_HEADS * GLA_DK
GLA_RANK = 16
GLA_TAU = 16.0
CHUNK = 64
D_FF = 4 * D_MODEL
EPS = 1e-6
POS_OFFSET_MAX = 1024

A_COLS = 2 * BRANCH_WIDTH
B_COLS = BRANCH_WIDTH + 2 * HEAD_DIM + IDX_HEADS * IDX_DIM + IDX_DIM + IDX_HEADS
C_COLS = 2 * GLA_QK_WIDTH + 2 * BRANCH_WIDTH + GLA_RANK
D_COLS = 4 * BRANCH_WIDTH
G_COLS = N_BRANCH * D_MODEL
N_IN = A_COLS + B_COLS + C_COLS + D_COLS + G_COLS

kernel_name = 'hybrid_gated_four_mixer_block'


def _split(z, sizes):
    offs = np.cumsum(sizes)[:-1].tolist()
    return jnp.split(z, offs, axis=-1)


def _rmsnorm(x, g):
    xf = x.astype(jnp.float32)
    y = xf * lax.rsqrt(jnp.mean(xf * xf, axis=-1, keepdims=True) + EPS)
    return (y * g.astype(jnp.float32)).astype(x.dtype)


def _layernorm(x, g, b):
    xf = x.astype(jnp.float32)
    mu = jnp.mean(xf, axis=-1, keepdims=True)
    xc = xf - mu
    var = jnp.mean(xc * xc, axis=-1, keepdims=True)
    return (xc * lax.rsqrt(var + EPS) * g.astype(jnp.float32) + b.astype(jnp.float32)).astype(x.dtype)


def _rope(x, pos):
    half = ROPE_DIMS // 2
    inv = jnp.power(jnp.float32(ROPE_THETA), -jnp.arange(half, dtype=jnp.float32) * (2.0 / ROPE_DIMS))
    ang = pos.astype(jnp.float32)[..., None] * inv
    cos = jnp.cos(ang)[:, :, None, :]
    sin = jnp.sin(ang)[:, :, None, :]
    x1 = x[..., :half].astype(jnp.float32)
    x2 = x[..., half:ROPE_DIMS].astype(jnp.float32)
    rot = jnp.concatenate([x1 * cos - x2 * sin, x1 * sin + x2 * cos], axis=-1).astype(x.dtype)
    return jnp.concatenate([rot, x[..., ROPE_DIMS:]], axis=-1)


def _conv_branch(za, conv_w, conv_b, ln_g, ln_b):
    val, gate = jnp.split(za, 2, axis=-1)
    u = val * jax.nn.sigmoid(gate)
    u = jnp.pad(u, ((0, 0), (CONV_WIDTH - 1, 0), (0, 0)))
    u = lax.conv_general_dilated(u, conv_w[:, None, :].astype(u.dtype), window_strides=(1,),
                                 padding='VALID', dimension_numbers=('NWC', 'WIO', 'NWC'),
                                 feature_group_count=BRANCH_WIDTH) + conv_b.astype(u.dtype)
    return jax.nn.silu(_layernorm(u, ln_g, ln_b))


def _sparse_attn_branch(zb, pos):
    B_, S_ = zb.shape[0], zb.shape[1]
    q, k, v, qi, ki, wi = _split(zb, [BRANCH_WIDTH, HEAD_DIM, HEAD_DIM, IDX_HEADS * IDX_DIM, IDX_DIM, IDX_HEADS])
    q = _rope(q.reshape(B_, S_, N_HEADS, HEAD_DIM), pos)
    k = _rope(k.reshape(B_, S_, 1, HEAD_DIM), pos)[:, :, 0]
    qi = _rope(qi.reshape(B_, S_, IDX_HEADS, IDX_DIM), pos)
    ki = _rope(ki.reshape(B_, S_, 1, IDX_DIM), pos)[:, :, 0]
    wi = wi * (IDX_HEADS ** -0.5)
    topk = min(TOPK_MAX, S_ // 4)
    nb = S_ // Q_BLOCK
    key_pos = jnp.arange(S_)

    def blockify(a):
        return a.reshape((B_, nb, Q_BLOCK) + a.shape[2:]).swapaxes(0, 1)

    def one_block(args):
        qb, qib, wib, blk = args
        tq = blk * Q_BLOCK + jnp.arange(Q_BLOCK)
        causal = key_pos[None, :] <= tq[:, None]
        logits = jnp.einsum('bqhd,bsd->bqhs', qib, ki) * (IDX_DIM ** -0.5)
        score = jnp.einsum('bqh,bqhs->bqs', wib, jax.nn.relu(logits)).astype(jnp.float32)
        score = jnp.where(causal[None], score, -jnp.inf)
        _, idx = lax.top_k(score, topk)
        valid = idx <= tq[None, :, None]
        ks = jax.vmap(lambda kk, ii: kk[ii])(k, idx)
        vs = jax.vmap(lambda vv, ii: vv[ii])(v, idx)
        s = jnp.einsum('bqhd,bqkd->bhqk', qb, ks).astype(jnp.float32) * (HEAD_DIM ** -0.5)
        s = jnp.where(valid[:, None], s, -jnp.inf)
        p = jax.nn.softmax(s, axis=-1).astype(vs.dtype)
        return jnp.einsum('bhqk,bqkd->bqhd', p, vs)

    out = lax.map(one_block, (blockify(q), blockify(qi), blockify(wi), jnp.arange(nb)))
    return out.swapaxes(0, 1).reshape(B_, S_, BRANCH_WIDTH)


def _chunked_gated_linear_attn(q, k, v, log_f):
    B_, S_, H_, dk = q.shape
    dv = v.shape[-1]
    nc = S_ // CHUNK

    def chunks(a):
        return a.astype(jnp.float32).reshape(B_, nc, CHUNK, H_, a.shape[-1]).transpose(1, 0, 3, 2, 4)

    qc, kc, vc = chunks(q), chunks(k), chunks(v)
    gc = jnp.cumsum(chunks(log_f), axis=3)
    causal = jnp.tril(jnp.ones((CHUNK, CHUNK), dtype=bool))

    def step(state, inp):
        qb, kb, vb, gb = inp
        diff = gb[:, :, :, None, :] - gb[:, :, None, :, :]
        decay = jnp.exp(jnp.where(causal[:, :, None], diff, -jnp.inf))
        attn = jnp.einsum('bhid,bhjd,bhijd->bhij', qb, kb, decay)
        o = jnp.einsum('bhij,bhjv->bhiv', attn, vb) + jnp.einsum('bhid,bhdv->bhiv', qb * jnp.exp(gb), state)
        g_last = gb[:, :, -1:, :]
        state = state * jnp.exp(g_last[:, :, 0, :, None]) + jnp.einsum('bhjd,bhjv->bhdv', kb * jnp.exp(g_last - gb), vb)
        return state, o

    state0 = jnp.zeros((B_, H_, dk, dv), jnp.float32)
    _, o = lax.scan(step, state0, (qc, kc, vc, gc))
    return o.transpose(1, 0, 3, 2, 4).reshape(B_, S_, H_, dv).astype(v.dtype)


def _gla_branch(zc, gate_w, gate_b, norm_g):
    B_, S_ = zc.shape[0], zc.shape[1]
    q, k, v, og, glr = _split(zc, [GLA_QK_WIDTH, GLA_QK_WIDTH, BRANCH_WIDTH, BRANCH_WIDTH, GLA_RANK])
    q = q.reshape(B_, S_, N_HEADS, GLA_DK) * (GLA_DK ** -0.5)
    k = k.reshape(B_, S_, N_HEADS, GLA_DK)
    v = v.reshape(B_, S_, N_HEADS, HEAD_DIM)
    log_a = jax.nn.log_sigmoid((glr @ gate_w + gate_b).astype(jnp.float32)) / GLA_TAU
    o = _chunked_gated_linear_attn(q, k, v, log_a.reshape(B_, S_, N_HEADS, GLA_DK))
    return _rmsnorm(o, norm_g).reshape(B_, S_, BRANCH_WIDTH) * jax.nn.silu(og)


def _hgrn2_branch(zd, lb, norm_g):
    B_, S_ = zd.shape[0], zd.shape[1]
    f_in, q, i, og = _split(zd, [BRANCH_WIDTH] * 4)
    zf = f_in.astype(jnp.float32)
    f = lb + (1.0 - lb) * jax.nn.sigmoid(zf)
    log_f = jnp.log(f)
    k = (1.0 - lb) * jax.nn.sigmoid(-zf)
    q = jax.nn.silu(q)
    shp = (B_, S_, N_HEADS, HEAD_DIM)
    o = _chunked_gated_linear_attn(q.reshape(shp), k.reshape(shp), i.reshape(shp), log_f.reshape(shp))
    return _rmsnorm(o, norm_g).reshape(B_, S_, BRANCH_WIDTH) * jax.nn.silu(og)


def setup_inputs(seed: int = 0) -> dict:
    key = jax.random.key(seed)
    ks = jax.random.split(key, 24)
    L, D, W = DEPTH, D_MODEL, BRANCH_WIDTH

    def nrm(k, shape, fan_in):
        return jax.random.normal(k, shape, jnp.float32) * (fan_in ** -0.5)

    def small(k, shape, s):
        return jax.random.normal(k, shape, jnp.float32) * s

    x = jax.random.normal(ks[0], (BATCH, SEQ, D), jnp.float32)
    c = jax.random.normal(ks[1], (BATCH, D), jnp.float32)
    positions = jnp.arange(SEQ, dtype=jnp.int32)[None, :] + jax.random.randint(ks[2], (BATCH, 1), 0, POS_OFFSET_MAX, dtype=jnp.int32)
    return {
        'x': x,
        'c': c,
        'positions': positions,
        'ada_w': nrm(ks[3], (L, D, 6 * D), D) * 0.5,
        'ada_b': small(ks[4], (L, 6 * D), 0.02),
        'norm_mix_g': 1.0 + small(ks[5], (L, D), 0.02),
        'norm_mlp_g': 1.0 + small(ks[6], (L, D), 0.02),
        'w_in': nrm(ks[7], (L, D, N_IN), D),
        'conv_w': nrm(ks[8], (L, CONV_WIDTH, W), CONV_WIDTH),
        'conv_b': small(ks[9], (L, W), 0.02),
        'conv_ln_g': 1.0 + small(ks[10], (L, W), 0.02),
        'conv_ln_b': small(ks[11], (L, W), 0.02),
        'gla_gate_w': nrm(ks[12], (L, GLA_RANK, GLA_QK_WIDTH), GLA_RANK),
        'gla_gate_b': small(ks[13], (L, GLA_QK_WIDTH), 0.1),
        'gla_norm_g': 1.0 + small(ks[14], (L, HEAD_DIM), 0.02),
        'hgrn_lb_logits': small(ks[15], (L, W), 0.1),
        'hgrn_norm_g': 1.0 + small(ks[16], (L, HEAD_DIM), 0.02),
        'w_branch_out': nrm(ks[17], (L, N_BRANCH, W, D), W),
        'w_o': nrm(ks[18], (L, D, D), D),
        'mlp_w1': nrm(ks[19], (L, D, D_FF), D),
        'mlp_w2': nrm(ks[20], (L, D_FF, D), D_FF),
        'final_g': 1.0 + small(ks[21], (D,), 0.02),
    }


def reference(x, c, positions, ada_w, ada_b, norm_mix_g, norm_mlp_g, w_in, conv_w, conv_b, conv_ln_g,
              conv_ln_b, gla_gate_w, gla_gate_b, gla_norm_g, hgrn_lb_logits, hgrn_norm_g, w_branch_out,
              w_o, mlp_w1, mlp_w2, final_g):
    B_, S_, D_ = x.shape
    p_lb = jax.nn.softmax(hgrn_lb_logits.astype(jnp.float32), axis=0)
    lower_bounds = jnp.cumsum(p_lb, axis=0) - p_lb[0:1]
    c_act = jax.nn.silu(c)
    for l in range(DEPTH):
        cmod = (c_act @ ada_w[l] + ada_b[l])[:, None, :]
        sh1, sc1, g1, sh2, sc2, g2 = jnp.split(cmod, 6, axis=-1)
        h = _rmsnorm(x, norm_mix_g[l]) * (1.0 + sc1) + sh1
        z = h @ w_in[l]
        za, zb, zc, zd, zg = _split(z, [A_COLS, B_COLS, C_COLS, D_COLS, G_COLS])
        ya = _conv_branch(za, conv_w[l], conv_b[l], conv_ln_g[l], conv_ln_b[l])
        yb = _sparse_attn_branch(zb, positions)
        yc = _gla_branch(zc, gla_gate_w[l], gla_gate_b[l], gla_norm_g[l])
        yd = _hgrn2_branch(zd, lower_bounds[l], hgrn_norm_g[l])
        ys = jnp.stack([ya, yb, yc, yd], axis=2)
        gates = jax.nn.sigmoid(zg).reshape(B_, S_, N_BRANCH, D_)
        merged = jnp.sum(jnp.einsum('bsnw,nwd->bsnd', ys, w_branch_out[l]) * gates, axis=2)
        x = x + g1 * (merged @ w_o[l])
        h = _rmsnorm(x, norm_mlp_g[l]) * (1.0 + sc2) + sh2
        x = x + g2 * (jnp.square(jax.nn.relu(h @ mlp_w1[l])) @ mlp_w2[l])
    return _rmsnorm(x, final_g)
```

```cpp
#include <hip/hip_runtime.h>
#include <cstdio>
#include <cstdint>
namespace pg8 {
#define PG8_LAS __attribute__((address_space(3)))
typedef unsigned short bf16_t;
typedef short bf16x8 __attribute__((ext_vector_type(8)));
typedef float f32x4 __attribute__((ext_vector_type(4)));
typedef unsigned u32x4 __attribute__((ext_vector_type(4)));
constexpr int BM = 256, BK = 64, HALF = 128, HTB = HALF * BK * 2  , STAGE_BYTES = 8 * HTB, NXCD = 8, WGM = 8;

__host__ __device__ __forceinline__ int lds_byte(int r, int c) { const int st = (r >> 4) * 2 + (c >> 5), rr = r & 15, cc = c & 31, ob = rr * 64 + cc * 2; return st * 1024 + (ob ^ (((ob >> 9) & 1) << 5)); }
__host__ __device__ __forceinline__ void stage_rc(int b, int& R, int& C) { const int st = b / 1024, sb = b % 1024, swz = sb ^ (((sb >> 9) & 1) << 5); R = (st >> 1) * 16 + swz / 64; C = (st & 1) * 32 + (swz % 64) / 2; }
__host__ __device__ __forceinline__ int perm32(int rho) { const int n = rho >> 4, i = rho & 15; return 8 * (i >> 2) + 4 * n + (i & 3); }

struct Unit { int pm, pn; };
struct Gemm { const bf16_t* A; const bf16_t* Bt; int M, N, K; };

struct StaticOrder {
    int nM, nN, nwg, G, c;
    __host__ __device__ void init(int M, int N, int G_, int c_) { nM = M / BM; nN = N / BM; nwg = nM * nN; G = G_; c = c_; }
    __host__ __device__ bool next(int i, Unit& u) const {
        const long L = (long)i * G + c; if (L >= nwg) return false;
        int wgid = (int)L; { const int q = nwg / NXCD, r = nwg % NXCD, xcd = wgid % NXCD, off = wgid / NXCD; wgid = (xcd < r ? xcd * (q + 1) : r * (q + 1) + (xcd - r) * q) + off; }
        const int nig = WGM * nN, gid = wgid / nig, fm = gid * WGM, gsz = (nM - fm) < WGM ? (nM - fm) : WGM;
        u.pm = fm + ((wgid % nig) % gsz); u.pn = (wgid % nig) / gsz; return true;
    }
    __device__ __forceinline__ void a_ready(const Unit&) const {}
    __device__ __forceinline__ void done(const Unit&) const {}
};
__device__ __forceinline__ unsigned cvt_pk_bf16(float lo, float hi) { unsigned r; asm volatile("v_cvt_pk_bf16_f32 %0, %1, %2" : "=v"(r) : "v"(lo), "v"(hi)); return r; }
typedef float f32x2 __attribute__((ext_vector_type(2)));
template <class Epi, class Sched, bool ALIGN_EPI = false, bool SP2 = false>
__device__ __forceinline__ void gemm_phase(PG8_LAS unsigned char* lds, const Gemm g, const Sched& S, const Epi& E, int tid_in) {
    int tid_l = tid_in; asm volatile("" : "+v"(tid_l));
    const int tid = tid_l, wid = __builtin_amdgcn_readfirstlane(tid >> 6), lane = tid & 63, wr = wid >> 2, wc = wid & 3, fr = lane & 15, fq = lane >> 4;
    const int K = g.K, nt = K / BK;
    unsigned voffA[2], voffB[2];
#pragma unroll
    for (int i = 0; i < 2; ++i) { int R, C; stage_rc(tid * 16 + i * 8192, R, C); const int Rb = Epi::PERM ? ((R & ~31) + perm32(R & 31)) : R;
        voffA[i] = (unsigned)(R * K + C) * 2u; voffB[i] = (unsigned)(Rb * K + C) * 2u; }
    const size_t kstep = (size_t)(BK * 2);
    const size_t hstep = (size_t)HALF * K * 2;
    const size_t tstep = 2 * hstep;
    const unsigned ldsw = (unsigned)wid * 1024u;
    const int aoff = lds_byte(wr * 64 + fr, fq * 8), boff = lds_byte(wc * 32 + fr, fq * 8);
#define PG8_SA(b, h) (((b) * 2 + (h)) * HTB)
#define PG8_SB(b, h) ((4 + (b) * 2 + (h)) * HTB)
#define PG8_STAGE(bufoff, gbase, voff) do { _Pragma("unroll") for (int _i = 0; _i < 2; ++_i) \
        __builtin_amdgcn_global_load_lds((const unsigned*)((const char*)(gbase) + (voff)[_i]), (PG8_LAS unsigned*)(lds + (bufoff) + ldsw + _i * 8192), 16, 0, 0); } while (0)
#define PG8_LDA(dst, b, h) do { _Pragma("unroll") for (int m = 0; m < 4; ++m) _Pragma("unroll") for (int k = 0; k < 2; ++k) dst[m][k] = *(const PG8_LAS bf16x8*)(lds + PG8_SA(b, h) + aoff + m * 2048 + k * 1024); } while (0)
#define PG8_LDB(dst, b, h) do { _Pragma("unroll") for (int n = 0; n < 2; ++n) _Pragma("unroll") for (int k = 0; k < 2; ++k) dst[n][k] = *(const PG8_LAS bf16x8*)(lds + PG8_SB(b, h) + boff + n * 2048 + k * 1024); } while (0)
#define PG8_MMA(ai, bj, At, Bt) do { __builtin_amdgcn_s_setprio(1); _Pragma("unroll") for (int m = 0; m < 4; ++m) _Pragma("unroll") for (int n = 0; n < 2; ++n) _Pragma("unroll") for (int k = 0; k < 2; ++k) \
        acc[ai][bj][m][n] = __builtin_amdgcn_mfma_f32_16x16x32_bf16(Bt[n][k], At[m][k], acc[ai][bj][m][n], 0, 0, 0); __builtin_amdgcn_s_setprio(0); } while (0)
#define PG8_WAIT_V(n) asm volatile("s_waitcnt vmcnt(" #n ")" ::: "memory")
#define PG8_WAIT_L(n) asm volatile("s_waitcnt lgkmcnt(" #n ")" ::: "memory")
#define PG8_BAR __builtin_amdgcn_s_barrier()
#define PG8_SCHED __builtin_amdgcn_sched_barrier(0)
    Unit cur, nxt; int ui = 0;
    if (!S.next(0, cur)) return;
    f32x4 acc[2][2][4][2];
#pragma unroll
    for (int a = 0; a < 2; ++a)
#pragma unroll
        for (int b = 0; b < 2; ++b)
#pragma unroll
            for (int m = 0; m < 4; ++m)
#pragma unroll
                for (int n = 0; n < 2; ++n) acc[a][b][m][n] = (f32x4){0.f, 0.f, 0.f, 0.f};
    bf16x8 At[4][2], B0[2][2], B1[2][2];
    const char* cA = (const char*)g.A + (size_t)cur.pm * tstep; const char* cB = (const char*)g.Bt + (size_t)cur.pn * tstep;
    S.a_ready(cur);
    if constexpr (SP2) {
        PG8_STAGE(PG8_SB(0, 0), cB, voffB); PG8_STAGE(PG8_SB(0, 1), cB + hstep, voffB); PG8_STAGE(PG8_SA(0, 0), cA, voffA); PG8_STAGE(PG8_SA(0, 1), cA + hstep, voffA);
        if (wr == 1) PG8_BAR;
        PG8_WAIT_V(2); PG8_BAR;
        PG8_STAGE(PG8_SB(1, 0), cB + kstep, voffB); PG8_STAGE(PG8_SA(1, 0), cA + kstep, voffA); PG8_STAGE(PG8_SB(1, 1), cB + hstep + kstep, voffB);
        PG8_WAIT_V(6); PG8_BAR;
    } else {
        PG8_STAGE(PG8_SB(0, 0), cB, voffB); PG8_STAGE(PG8_SA(0, 0), cA, voffA); PG8_STAGE(PG8_SB(0, 1), cB + hstep, voffB); PG8_STAGE(PG8_SA(0, 1), cA + hstep, voffA);
        if (wr == 1) PG8_BAR;
        PG8_WAIT_V(4); PG8_BAR;
        PG8_STAGE(PG8_SB(1, 0), cB + kstep, voffB); PG8_STAGE(PG8_SA(1, 0), cA + kstep, voffA); PG8_STAGE(PG8_SB(1, 1), cB + hstep + kstep, voffB);
        PG8_WAIT_V(6); PG8_BAR;
    }
    for (;;) {
        const bool has_next = S.next(ui + 1, nxt);
        const char* nA = has_next ? (const char*)g.A + (size_t)nxt.pm * tstep : cA; const char* nB = has_next ? (const char*)g.Bt + (size_t)nxt.pn * tstep : cB;
        for (int t = 0; t < nt; t += 2) {
            const bool last = (t == nt - 2);
            const char* a1 = cA + (size_t)(t + 1) * kstep;
            const char* a2 = last ? nA : cA + (size_t)(t + 2) * kstep; const char* b2 = last ? nB : cB + (size_t)(t + 2) * kstep;
            const char* a3 = a2 + kstep; const char* b3 = b2 + kstep;
            if (last && has_next) S.a_ready(nxt);
            if constexpr (SP2) {
            PG8_LDB(B0, 0, 0); PG8_LDB(B1, 0, 1); PG8_SCHED; PG8_LDA(At, 0, 0); PG8_STAGE(PG8_SA(1, 1), a1 + hstep, voffA);
            PG8_WAIT_V(8); PG8_WAIT_L(0); PG8_BAR; PG8_MMA(0, 0, At, B0); PG8_MMA(0, 1, At, B1); PG8_BAR; PG8_SCHED;
            PG8_LDA(At, 0, 1); PG8_STAGE(PG8_SB(0, 0), b2, voffB); PG8_STAGE(PG8_SB(0, 1), b2 + hstep, voffB); PG8_STAGE(PG8_SA(0, 0), a2, voffA);
            PG8_WAIT_V(8); PG8_WAIT_L(0); PG8_BAR; PG8_MMA(1, 0, At, B0); PG8_MMA(1, 1, At, B1); PG8_BAR; PG8_SCHED;
            PG8_LDB(B0, 1, 0); PG8_LDB(B1, 1, 1); PG8_SCHED; PG8_LDA(At, 1, 0); PG8_STAGE(PG8_SA(0, 1), a2 + hstep, voffA);
            PG8_WAIT_V(8); PG8_WAIT_L(0); PG8_BAR; PG8_MMA(0, 0, At, B0); PG8_MMA(0, 1, At, B1); PG8_BAR; PG8_SCHED;
            PG8_LDA(At, 1, 1); PG8_STAGE(PG8_SB(1, 0), b3, voffB); PG8_STAGE(PG8_SB(1, 1), b3 + hstep, voffB); PG8_STAGE(PG8_SA(1, 0), a3, voffA);
            PG8_WAIT_V(8); PG8_WAIT_L(0); PG8_BAR; PG8_MMA(1, 0, At, B0); PG8_MMA(1, 1, At, B1); PG8_BAR; PG8_SCHED;
            } else {
            PG8_LDB(B0, 0, 0); PG8_SCHED; PG8_LDA(At, 0, 0); PG8_STAGE(PG8_SA(1, 1), a1 + hstep, voffA);
            PG8_WAIT_L(8); PG8_BAR; PG8_WAIT_L(0); PG8_MMA(0, 0, At, B0); PG8_BAR; PG8_SCHED;
            PG8_LDB(B1, 0, 1); PG8_STAGE(PG8_SB(0, 0), b2, voffB);
            PG8_BAR; PG8_WAIT_L(0); PG8_MMA(0, 1, At, B1); PG8_BAR;
            PG8_LDA(At, 0, 1); PG8_STAGE(PG8_SA(0, 0), a2, voffA);
            PG8_BAR; PG8_WAIT_L(0); PG8_MMA(1, 0, At, B0); PG8_BAR; PG8_SCHED;
            PG8_STAGE(PG8_SB(0, 1), b2 + hstep, voffB);
            PG8_WAIT_V(6); PG8_BAR; PG8_MMA(1, 1, At, B1); PG8_BAR;
            PG8_LDB(B0, 1, 0); PG8_SCHED; PG8_LDA(At, 1, 0); PG8_STAGE(PG8_SA(0, 1), a2 + hstep, voffA);
            PG8_WAIT_L(8); PG8_BAR; PG8_WAIT_L(0); PG8_MMA(0, 0, At, B0); PG8_BAR; PG8_SCHED;
            PG8_LDB(B1, 1, 1); PG8_STAGE(PG8_SB(1, 0), b3, voffB);
            PG8_BAR; PG8_WAIT_L(0); PG8_MMA(0, 1, At, B1); PG8_BAR;
            PG8_LDA(At, 1, 1); PG8_STAGE(PG8_SA(1, 0), a3, voffA);
            PG8_BAR; PG8_WAIT_L(0); PG8_MMA(1, 0, At, B0); PG8_BAR; PG8_SCHED;
            PG8_STAGE(PG8_SB(1, 1), b3 + hstep, voffB);
            PG8_WAIT_V(6); PG8_BAR; PG8_MMA(1, 1, At, B1); PG8_BAR;
            }
        }
        if constexpr (ALIGN_EPI) { if (wr == 0) PG8_BAR; }
        if constexpr (!Epi::AFTER_DRAIN) { E(acc, cur, wr, wc, fr, fq); S.done(cur); }
        if (!has_next) break;
#pragma unroll
        for (int a = 0; a < 2; ++a)
#pragma unroll
            for (int b = 0; b < 2; ++b)
#pragma unroll
                for (int m = 0; m < 4; ++m)
#pragma unroll
                    for (int n = 0; n < 2; ++n) acc[a][b][m][n] = (f32x4){0.f, 0.f, 0.f, 0.f};
        cur = nxt; cA = nA; cB = nB; ++ui;
        if constexpr (ALIGN_EPI) { if (wr == 1) PG8_BAR; }
    }
    PG8_WAIT_V(0);
    if constexpr (!ALIGN_EPI) { if (wr == 0) PG8_BAR; }
    PG8_BAR;
    if constexpr (Epi::AFTER_DRAIN) { E.fused(acc, cur, wr, wc, fr, fq, lds, wid, lane); S.done(cur); }
#undef PG8_SA
#undef PG8_SB
#undef PG8_STAGE
#undef PG8_LDA
#undef PG8_LDB
#undef PG8_MMA
#undef PG8_WAIT_V
#undef PG8_WAIT_L
#undef PG8_BAR
#undef PG8_SCHED
}
}

#ifndef MK_N_LAUNCHES
#define MK_N_LAUNCHES 1
#endif
#ifndef MK_SKIP
#define MK_SKIP 0
#endif
constexpr int NB = 8, SEQ = 8192, DM = 1024, NL = 2, BW = 256, DFF = 4096;
constexpr int M_ALL = NB * SEQ;
constexpr int NGRP = 2, GB = NB / NGRP;
constexpr int MG = GB * SEQ;
constexpr int N_IN = 7124, NV = 7168, ZLD = 3072, GLD = 4096;
constexpr int NCH = SEQ / 64;
constexpr float EPS = 1e-6f;
constexpr int ZA_VAL = 0, ZA_GATE = 256, ZB_Q = 512, ZB_K = 768, ZB_V = 832, ZB_QI = 896, ZB_KI = 1152, ZB_WI = 1216;
constexpr int ZC_Q = 1224, ZC_K = 1352, ZC_V = 1480, ZC_OG = 1736, ZC_GLR = 1992, ZD_F = 2008, ZD_Q = 2264, ZD_I = 2520, ZD_OG = 2776;
__host__ __device__ __forceinline__ int win_src(int j) { if (j < 1220) return j; if (j < 1224) return -1; if (j < 3032) return j - 4; if (j < 3072) return -1; return j - 44; }

constexpr size_t MiB = 1u << 20;
constexpr size_t WS_CTL = 0, CTL_ZERO_BYTES = 1 * MiB;
constexpr size_t WS_CMOD = 1 * MiB;
constexpr size_t WS_ROPE = 1 * MiB + 512 * 1024;
constexpr size_t WS_WIN = 4 * MiB;
constexpr size_t WS_WBO = 32 * MiB;
constexpr size_t WS_WO = 36 * MiB;
constexpr size_t WS_W1 = 40 * MiB;
constexpr size_t WS_W2 = 56 * MiB;
constexpr size_t WS_H = 76 * MiB;
constexpr size_t WS_Z = 204 * MiB;
constexpr size_t WS_GATES = 396 * MiB;
constexpr size_t WS_YS = 652 * MiB;
constexpr size_t WS_MF32 = 716 * MiB;
constexpr size_t WS_STC = 844 * MiB;
constexpr size_t WS_STD = 860 * MiB;
constexpr size_t WS_DECC = 892 * MiB;
constexpr size_t WS_DECD = 893 * MiB;
constexpr size_t WS_U = 204 * MiB;
constexpr size_t WS_END = 896 * MiB;
constexpr int CW_BAR = 4096;

constexpr int NWAVES = 8, NTHREADS = 512;
constexpr int LDS_BYTES = 163840, MISC_OFF = LDS_BYTES - 512;

#define GAS __attribute__((address_space(1)))
#define LAS __attribute__((address_space(3)))
typedef unsigned short bf16;
typedef unsigned v4u __attribute__((ext_vector_type(4)));
typedef unsigned v2u __attribute__((ext_vector_type(2)));
typedef float f32x4 __attribute__((ext_vector_type(4)));
typedef short bf16x8 __attribute__((ext_vector_type(8)));
typedef float f32x16 __attribute__((ext_vector_type(16)));
#define LDS_WAIT() asm volatile("s_waitcnt lgkmcnt(0)" ::: "memory")
#define VM_WAIT() asm volatile("s_waitcnt vmcnt(0)" ::: "memory")
__device__ __forceinline__ float bf2f(unsigned v) { return __uint_as_float(v << 16); }
__device__ __forceinline__ float bflo(unsigned w) { return __uint_as_float(w << 16); }
__device__ __forceinline__ float bfhi(unsigned w) { return __uint_as_float(w & 0xffff0000u); }
__device__ __forceinline__ unsigned f2bf(float f) { unsigned u = __float_as_uint(f); return (u + 0x7fffu + ((u >> 16) & 1u)) >> 16; }
__device__ __forceinline__ unsigned pk2(float lo, float hi) { return f2bf(lo) | (f2bf(hi) << 16); }
__device__ __forceinline__ float wave_sum(float v) {
#pragma unroll
    for (int o = 1; o < 64; o <<= 1) v += __shfl_xor(v, o);
    return v;
}
__device__ __forceinline__ float wave_max(float v) {
#pragma unroll
    for (int o = 1; o < 64; o <<= 1) v = fmaxf(v, __shfl_xor(v, o));
    return v;
}
__device__ __forceinline__ float sigm(float x) { return 1.0f / (1.0f + __expf(-x)); }
__device__ __forceinline__ float siluf(float x) { return x * sigm(x); }
__device__ __forceinline__ float logsigm(float x) { return fminf(x, 0.f) - __logf(1.0f + __expf(-fabsf(x))); }

#define XB_TMO      128
#define XB_XCNT(j)  (256  + 64 * (j))
#define XB_XSUB(j)  (1280 + 64 * (j))
#define XB_XGEN(j)  (2304 + 64 * (j))
#define XB_TOP      3328
#define XB_TOPGEN   3392
#define XCD_BAR_WORDS 3456
#define XB_SPIN_CAP (1u << 18)
__device__ __forceinline__ unsigned xb_ld(unsigned* p)              { return __hip_atomic_load(p, __ATOMIC_RELAXED, __HIP_MEMORY_SCOPE_AGENT); }
__device__ __forceinline__ unsigned xb_add(unsigned* p, unsigned v) { return __hip_atomic_fetch_add(p, v, __ATOMIC_RELAXED, __HIP_MEMORY_SCOPE_AGENT); }
__device__ __forceinline__ unsigned xb_xcc_id() { return (unsigned)__builtin_amdgcn_s_getreg((3 << 11) | 20) & 0xFu; }
#define XB_SPIN(cond, bar) do { unsigned _sp = 0; while (cond) { __builtin_amdgcn_s_sleep(1); \
    if ((++_sp & 255u) == 0u) { if (xb_ld(&(bar)[XB_TMO])) break; if (_sp > XB_SPIN_CAP) { atomicAdd(&(bar)[XB_TMO], 1u); break; } } } } while (0)
struct XcdBarrier { unsigned* bar; unsigned x; volatile LAS unsigned* st; };
__device__ __forceinline__ XcdBarrier xcd_barrier_post(unsigned* bar, volatile LAS unsigned* st) {
    XcdBarrier b; b.bar = bar; b.x = xb_xcc_id(); b.st = st;
    if (threadIdx.x == 0) (void)xb_add(&bar[XB_XCNT(b.x)], 1u);
    return b;
}
__device__ __forceinline__ void xcd_barrier_complete(unsigned* bar, unsigned x, unsigned& nloc, unsigned& nx) {
    const unsigned G = gridDim.x * gridDim.y * gridDim.z;
    unsigned sum, cnt, mine, sp = 0u;
    for (;;) {
        sum = 0u; cnt = 0u; mine = 0u;
#pragma unroll
        for (unsigned j = 0; j < 16; ++j) { const unsigned c = xb_ld(&bar[XB_XCNT(j)]); sum += c; cnt += (c > 0u) ? 1u : 0u; mine = (j == x) ? c : mine; }
        if (sum == G) break;
        __builtin_amdgcn_s_sleep(1);
        if ((++sp & 255u) == 0u) { if (xb_ld(&bar[XB_TMO])) break; if (sp > XB_SPIN_CAP) { atomicAdd(&bar[XB_TMO], 1u); break; } }
    }
    nloc = mine > 0u ? mine : 1u; nx = cnt > 0u ? cnt : 1u;
}
__device__ __forceinline__ void xcd_barrier(const XcdBarrier& b) {
    asm volatile("s_waitcnt vmcnt(0)" ::: "memory");
    __syncthreads();
    if (threadIdx.x == 0) {
        unsigned* bar = b.bar;
        __builtin_amdgcn_s_waitcnt(0);
        unsigned nloc = b.st[0], nx = b.st[1];
        if (nloc == 0u) { xcd_barrier_complete(bar, b.x, nloc, nx); b.st[0] = nloc; b.st[1] = nx; }
        const unsigned old = xb_add(&bar[XB_XSUB(b.x)], 1u);
        const unsigned gen = old / nloc;
        if (old + 1u == (gen + 1u) * nloc) {
            __builtin_amdgcn_fence(__ATOMIC_RELEASE, "agent");
            asm volatile("s_waitcnt vmcnt(0)" ::: "memory");
            const unsigned og = xb_add(&bar[XB_TOP], 1u);
            const unsigned tg = og / nx;
            if (og + 1u == (tg + 1u) * nx) xb_add(&bar[XB_TOPGEN], 1u);
            else XB_SPIN(xb_ld(&bar[XB_TOPGEN]) == tg, bar);
            __builtin_amdgcn_fence(__ATOMIC_ACQUIRE, "agent");
            xb_add(&bar[XB_XGEN(b.x)], 1u);
            asm volatile("s_waitcnt vmcnt(0)" ::: "memory");
        } else {
            XB_SPIN(xb_ld(&bar[XB_XGEN(b.x)]) == gen, bar);
            __builtin_amdgcn_fence(__ATOMIC_ACQUIRE, "agent");
            asm volatile("s_waitcnt vmcnt(0)" ::: "memory");
        }
    }
    __syncthreads();
}

struct EpiZ {
    static constexpr bool PERM = true, AFTER_DRAIN = false;
    GAS bf16* Z; GAS bf16* Gt;
    __device__ __forceinline__ void operator()(const pg8::f32x4 (&acc)[2][2][4][2], const pg8::Unit& u, int wr, int wc, int fr_, int fq_) const {
        int fr = fr_, fq = fq_; asm volatile("" : "+v"(fr), "+v"(fq));
        const int row0 = u.pm * 256 + wr * 64 + fr;
        const bool isg = u.pn >= 12;
        GAS bf16* base = isg ? Gt : Z; const int ld = isg ? GLD : ZLD; const int col0 = (isg ? u.pn - 12 : u.pn) * 256 + wc * 32 + 8 * fq;
#pragma unroll
        for (int ai = 0; ai < 2; ++ai)
#pragma unroll
            for (int m = 0; m < 4; ++m) { GAS bf16* rowp = base + (size_t)(row0 + ai * 128 + m * 16) * ld + col0;
#pragma unroll
                for (int bj = 0; bj < 2; ++bj) { pg8::f32x4 v0 = acc[ai][bj][m][0], v1 = acc[ai][bj][m][1];
                    if (isg) {
#pragma unroll
                        for (int j = 0; j < 4; ++j) { v0[j] = sigm(v0[j]); v1[j] = sigm(v1[j]); } }
                    pg8::u32x4 w; w.x = pg8::cvt_pk_bf16(v0[0], v0[1]); w.y = pg8::cvt_pk_bf16(v0[2], v0[3]); w.z = pg8::cvt_pk_bf16(v1[0], v1[1]); w.w = pg8::cvt_pk_bf16(v1[2], v1[3]);
                    *(GAS pg8::u32x4*)(rowp + bj * 128) = w; } }
    }
};
struct EpiGated {
    static constexpr bool PERM = false, AFTER_DRAIN = false;
    const GAS bf16* Gt; GAS float* T; GAS bf16* Mo;
    __device__ __forceinline__ void operator()(const pg8::f32x4 (&acc)[2][2][4][2], const pg8::Unit& u, int wr, int wc, int fr_, int fq_) const {
        int fr = fr_, fq = fq_; asm volatile("" : "+v"(fr), "+v"(fq));
        const int nb = u.pn >> 2;
        const int row0 = (u.pm - nb * (MG / 256)) * 256 + wr * 64 + fr, col0 = (u.pn & 3) * 256 + wc * 32 + 4 * fq;
#pragma unroll
        for (int ai = 0; ai < 2; ++ai)
#pragma unroll
            for (int m = 0; m < 4; ++m) { const unsigned r = (unsigned)(row0 + ai * 128 + m * 16);
#pragma unroll
                for (int bj = 0; bj < 2; ++bj) {
#pragma unroll
                    for (int n = 0; n < 2; ++n) { asm volatile("" ::: "memory"); const unsigned c = (unsigned)(col0 + bj * 128 + n * 16);
                        const v2u gw = *(const GAS v2u*)(Gt + (r * (unsigned)GLD + (unsigned)nb * 1024u + c));
                        pg8::f32x4 v = acc[ai][bj][m][n];
                        v[0] *= bflo(gw.x); v[1] *= bfhi(gw.x); v[2] *= bflo(gw.y); v[3] *= bfhi(gw.y);
                        if (nb > 0) v += *(const GAS pg8::f32x4*)(T + (r * 1024u + c));
                        if (nb < 3) *(GAS pg8::f32x4*)(T + (r * 1024u + c)) = v;
                        else { v2u o; o.x = pg8::cvt_pk_bf16(v[0], v[1]); o.y = pg8::cvt_pk_bf16(v[2], v[3]); *(GAS v2u*)(Mo + (r * 1024u + c)) = o; } } }
                asm volatile("" ::: "memory"); }
    }
};
struct EpiResid {
    static constexpr bool PERM = false, AFTER_DRAIN = false;
    const GAS float* base; GAS float* out; const GAS float* gv;
    __device__ __forceinline__ void operator()(const pg8::f32x4 (&acc)[2][2][4][2], const pg8::Unit& u, int wr, int wc, int fr_, int fq_) const {
        int fr = fr_, fq = fq_; asm volatile("" : "+v"(fr), "+v"(fq));
        const int row0 = u.pm * 256 + wr * 64 + fr, col0 = u.pn * 256 + wc * 32 + 4 * fq;
        const GAS float* gb = gv + (size_t)((u.pm * 256) / SEQ) * 6144 + col0;
        pg8::f32x4 g4[2][2];
#pragma unroll
        for (int bj = 0; bj < 2; ++bj)
#pragma unroll
            for (int n = 0; n < 2; ++n) g4[bj][n] = *(const GAS pg8::f32x4*)(gb + bj * 128 + n * 16);
#pragma unroll
        for (int ai = 0; ai < 2; ++ai)
#pragma unroll
            for (int m = 0; m < 4; ++m) { const size_t off = (size_t)(row0 + ai * 128 + m * 16) * 1024 + col0;
#pragma unroll
                for (int bj = 0; bj < 2; ++bj)
#pragma unroll
                    for (int n = 0; n < 2; ++n) { const pg8::f32x4 bs = *(const GAS pg8::f32x4*)(base + off + bj * 128 + n * 16);
                        *(GAS pg8::f32x4*)(out + off + bj * 128 + n * 16) = bs + g4[bj][n] * acc[ai][bj][m][n]; }
                asm volatile("" ::: "memory"); }
    }
};
struct EpiRelu2 {
    static constexpr bool PERM = true, AFTER_DRAIN = false;
    GAS bf16* O;
    __device__ __forceinline__ void operator()(const pg8::f32x4 (&acc)[2][2][4][2], const pg8::Unit& u, int wr, int wc, int fr_, int fq_) const {
        int fr = fr_, fq = fq_; asm volatile("" : "+v"(fr), "+v"(fq));
        const int row0 = u.pm * 256 + wr * 64 + fr, col0 = u.pn * 256 + wc * 32 + 8 * fq;
#pragma unroll
        for (int ai = 0; ai < 2; ++ai)
#pragma unroll
            for (int m = 0; m < 4; ++m) { GAS bf16* rowp = O + (size_t)(row0 + ai * 128 + m * 16) * DFF + col0;
#pragma unroll
                for (int bj = 0; bj < 2; ++bj) { pg8::f32x4 v0 = acc[ai][bj][m][0], v1 = acc[ai][bj][m][1];
#pragma unroll
                    for (int j = 0; j < 4; ++j) { const float a = fmaxf(v0[j], 0.f), b = fmaxf(v1[j], 0.f); v0[j] = a * a; v1[j] = b * b; }
                    pg8::u32x4 w; w.x = pg8::cvt_pk_bf16(v0[0], v0[1]); w.y = pg8::cvt_pk_bf16(v0[2], v0[3]); w.z = pg8::cvt_pk_bf16(v1[0], v1[1]); w.w = pg8::cvt_pk_bf16(v1[2], v1[3]);
                    *(GAS pg8::u32x4*)(rowp + bj * 128) = w; } }
    }
};

template <bool MAPPED>
__device__ __forceinline__ void p0_item(const GAS float* W, int K, int ldw, GAS bf16* WT, LAS float* scr, int nblk, int item, int lane) {
    const int kb = item / nblk, nb = item % nblk, k0 = 64 * kb, n0 = 32 * nb;
    const int nv = n0 + (lane & 31); const int src = MAPPED ? win_src(nv) : nv;
#pragma unroll 8
    for (int i = 0; i < 32; ++i) { const int kk = 2 * i + (lane >> 5); scr[kk * 33 + (lane & 31)] = (src >= 0) ? W[(size_t)(k0 + kk) * ldw + src] : 0.f; }
    LDS_WAIT(); asm volatile("" ::: "memory");
    const int c = lane & 7;
#pragma unroll
    for (int j = 0; j < 4; ++j) { const int n = (lane >> 3) + 8 * j; const LAS float* s = scr + (8 * c) * 33 + n;
        v4u o; o.x = pk2(s[0 * 33], s[1 * 33]); o.y = pk2(s[2 * 33], s[3 * 33]); o.z = pk2(s[4 * 33], s[5 * 33]); o.w = pk2(s[6 * 33], s[7 * 33]);
        *(GAS v4u*)(WT + (size_t)(n0 + n) * K + k0 + 8 * c) = o; }
    LDS_WAIT(); asm volatile("" ::: "memory");
}
__device__ __forceinline__ void p0_weights(const GAS float* w_in, const GAS float* w_bo, const GAS float* w_o, const GAS float* w1, const GAS float* w2, GAS unsigned char* ws, LAS unsigned char* lds, int gw, int NGW, int wave, int lane) {
    LAS float* scr = (LAS float*)(lds + wave * 8704);
    constexpr int I_IN = 16 * (NV / 32), I_BO = 4 * 32, I_O = 16 * 32, I_1 = 16 * 128, I_2 = 64 * 32;
    constexpr int NITEMS = NL * (I_IN + 4 * I_BO + I_O + I_1 + I_2);
    for (int it = gw; it < NITEMS; it += NGW) {
        int r = it;
        if (r < NL * I_IN) { const int l = r / I_IN; r -= l * I_IN; p0_item<true>(w_in + (size_t)l * 1024 * N_IN, 1024, N_IN, (GAS bf16*)(ws + WS_WIN) + (size_t)l * NV * 1024, scr, NV / 32, r, lane); continue; } r -= NL * I_IN;
        if (r < NL * 4 * I_BO) { const int ln = r / I_BO; r -= ln * I_BO; p0_item<false>(w_bo + (size_t)ln * 256 * 1024, 256, 1024, (GAS bf16*)(ws + WS_WBO) + (size_t)ln * 1024 * 256, scr, 32, r, lane); continue; } r -= NL * 4 * I_BO;
        if (r < NL * I_O) { const int l = r / I_O; r -= l * I_O; p0_item<false>(w_o + (size_t)l * 1024 * 1024, 1024, 1024, (GAS bf16*)(ws + WS_WO) + (size_t)l * 1024 * 1024, scr, 32, r, lane); continue; } r -= NL * I_O;
        if (r < NL * I_1) { const int l = r / I_1; r -= l * I_1; p0_item<false>(w1 + (size_t)l * 1024 * DFF, 1024, DFF, (GAS bf16*)(ws + WS_W1) + (size_t)l * DFF * 1024, scr, 128, r, lane); continue; } r -= NL * I_1;
        { const int l = r / I_2; r -= l * I_2; p0_item<false>(w2 + (size_t)l * DFF * 1024, DFF, 1024, (GAS bf16*)(ws + WS_W2) + (size_t)l * 1024 * DFF, scr, 32, r, lane); }
    }
}
__device__ __forceinline__ void p0_rope(GAS float* T, int gtid, int gstride) {
    for (int idx = gtid; idx < 16384 * 8; idx += gstride) {
        const int p = idx >> 3, j = idx & 7;
        const double inv = (j == 0) ? 1.0 : (j == 1) ? 0.19392274474868576 : (j == 2) ? 0.03760603093086393 : (j == 3) ? 0.007292664737217109 : (j == 4) ? 0.001414213562373095 :
                           (j == 5) ? 0.0002742481756762073 : (j == 6) ? 5.318295896944988e-05 : 1.031338537721246e-05;
        const double ang = (double)p * inv;
        const double n = __builtin_rint(ang * 0.15915494309189535);
        double r = __builtin_fma(-n, 6.283185307179586, ang); r = __builtin_fma(-n, 2.4492935982947064e-16, r);
        const double r2 = r * r;
        double s = 1.0, c = 1.0;
#pragma unroll
        for (int k = 14; k >= 1; --k) { s = 1.0 - r2 * s / (double)((2 * k) * (2 * k + 1)); c = 1.0 - r2 * c / (double)((2 * k - 1) * (2 * k)); }
        T[p * 16 + j] = (float)c; T[p * 16 + 8 + j] = (float)(r * s);
    }
}
__device__ __forceinline__ void p0_cmod(const GAS float* cin, const GAS float* ada_w, const GAS float* ada_b, GAS float* cmod, LAS unsigned char* lds, int vcu, int G, int tid, int wave, int lane) {
    LAS float* ca = (LAS float*)lds;
    LAS float* red = (LAS float*)(lds + 32768);
    for (int i = tid; i < 8192; i += NTHREADS) { const int b = i >> 10, k = i & 1023; const float v = cin[i]; ca[k * 8 + b] = siluf(v); }
    __syncthreads();
    for (int u = vcu; u < NL * 96; u += G) {
        const int l = u / 96, j0 = (u % 96) * 64;
        const GAS float* W = ada_w + (size_t)l * 1024 * 6144 + j0 + lane;
        float acc[8];
#pragma unroll
        for (int b = 0; b < 8; ++b) acc[b] = 0.f;
#pragma unroll 4
        for (int k = wave * 128; k < wave * 128 + 128; ++k) {
            const float wv = W[(size_t)k * 6144];
            const f32x4 c0 = *(const LAS f32x4*)(ca + k * 8), c1 = *(const LAS f32x4*)(ca + k * 8 + 4);
            acc[0] += c0[0] * wv; acc[1] += c0[1] * wv; acc[2] += c0[2] * wv; acc[3] += c0[3] * wv;
            acc[4] += c1[0] * wv; acc[5] += c1[1] * wv; acc[6] += c1[2] * wv; acc[7] += c1[3] * wv;
        }
#pragma unroll
        for (int b = 0; b < 8; ++b) red[(wave * 8 + b) * 64 + lane] = acc[b];
        __syncthreads();
        { const int b = tid >> 6, jj = tid & 63; float s = 0.f;
#pragma unroll
          for (int w = 0; w < 8; ++w) s += red[(w * 8 + b) * 64 + jj];
          cmod[((size_t)l * NB + b) * 6144 + j0 + jj] = s + ada_b[l * 6144 + j0 + jj]; }
        __syncthreads();
    }
}

__device__ __forceinline__ void norm_rows(const GAS float* xin, GAS bf16* hout, const GAS float* gvec, const GAS float* cm  , int off_sh, int off_sc, int gw, int NGW, int lane) {
    for (int m = gw; m < M_ALL; m += NGW) {
        const GAS f32x4* xr = (const GAS f32x4*)(xin + (size_t)m * DM) + lane;
        f32x4 v[4]; float ss = 0.f;
#pragma unroll
        for (int j = 0; j < 4; ++j) { v[j] = xr[64 * j]; ss += (v[j][0] * v[j][0] + v[j][1] * v[j][1]) + (v[j][2] * v[j][2] + v[j][3] * v[j][3]); }
        const float r = 1.0f / sqrtf(wave_sum(ss) * (1.0f / DM) + EPS);
        const GAS float* cb = cm + (size_t)(m / SEQ) * 6144;
        GAS v2u* o8 = (GAS v2u*)(hout + (size_t)m * DM) + lane;
#pragma unroll
        for (int j = 0; j < 4; ++j) { const int col = 4 * (64 * j + lane);
            const f32x4 g4 = *(const GAS f32x4*)(gvec + col), sc4 = *(const GAS f32x4*)(cb + off_sc + col), sh4 = *(const GAS f32x4*)(cb + off_sh + col);
            const f32x4 y = v[j] * r * g4 * (sc4 + 1.0f) + sh4;
            v2u w; w.x = pk2(y[0], y[1]); w.y = pk2(y[2], y[3]); o8[64 * j] = w; }
    }
}
__device__ __forceinline__ void final_norm_rows(GAS float* xio, const GAS float* gvec, int gw, int NGW, int lane) {
    for (int m = gw; m < M_ALL; m += NGW) {
        GAS f32x4* xr = (GAS f32x4*)(xio + (size_t)m * DM) + lane;
        f32x4 v[4]; float ss = 0.f;
#pragma unroll
        for (int j = 0; j < 4; ++j) { v[j] = xr[64 * j]; ss += (v[j][0] * v[j][0] + v[j][1] * v[j][1]) + (v[j][2] * v[j][2] + v[j][3] * v[j][3]); }
        const float r = 1.0f / sqrtf(wave_sum(ss) * (1.0f / DM) + EPS);
#pragma unroll
        for (int j = 0; j < 4; ++j) { const f32x4 g4 = *(const GAS f32x4*)(gvec + 4 * (64 * j + lane)); xr[64 * j] = v[j] * r * g4; }
    }
}
__device__ __forceinline__ void copy_rows(const GAS float* xin, GAS float* xout, int gw, int NGW, int lane) {
    for (int m = gw; m < M_ALL; m += NGW) {
        const GAS f32x4* xr = (const GAS f32x4*)(xin + (size_t)m * DM) + lane; GAS f32x4* xo = (GAS f32x4*)(xout + (size_t)m * DM) + lane;
#pragma unroll
        for (int j = 0; j < 4; ++j) xo[64 * j] = xr[64 * j];
    }
}

__device__ __forceinline__ void rope_unit(GAS bf16* Z, const GAS int* pos, const GAS float* T, int u, int tid) {
    const int row = u * NTHREADS + tid;
    int p = pos[row]; p = p < 0 ? 0 : (p > 16383 ? 16383 : p);
    const GAS f32x4* tp = (const GAS f32x4*)(T + (size_t)p * 16);
    const f32x4 c0 = tp[0], c1 = tp[1], s0 = tp[2], s1 = tp[3];
    float cs[8] = {c0[0], c0[1], c0[2], c0[3], c1[0], c1[1], c1[2], c1[3]};
    float sn[8] = {s0[0], s0[1], s0[2], s0[3], s1[0], s1[1], s1[2], s1[3]};
#pragma unroll
    for (int blk = 0; blk < 10; ++blk) {
        const int col = (blk < 4) ? ZB_Q + 64 * blk : (blk == 4) ? ZB_K : (blk < 9) ? ZB_QI + 64 * (blk - 5) : ZB_KI;
        GAS v4u* ptr = (GAS v4u*)(Z + (size_t)row * ZLD + col);
        const v4u a = ptr[0], b = ptr[1];
        const unsigned aw[4] = {a.x, a.y, a.z, a.w}, bw[4] = {b.x, b.y, b.z, b.w};
        unsigned oa[4], ob[4];
#pragma unroll
        for (int q = 0; q < 4; ++q) {
            const float x1l = bflo(aw[q]), x1h = bfhi(aw[q]), x2l = bflo(bw[q]), x2h = bfhi(bw[q]);
            const float cl = cs[2 * q], ch = cs[2 * q + 1], sl = sn[2 * q], sh = sn[2 * q + 1];
            oa[q] = pk2(x1l * cl - x2l * sl, x1h * ch - x2h * sh);
            ob[q] = pk2(x1l * sl + x2l * cl, x1h * sh + x2h * ch);
        }
        ptr[0] = (v4u){oa[0], oa[1], oa[2], oa[3]}; ptr[1] = (v4u){ob[0], ob[1], ob[2], ob[3]};
    }
}
__device__ __forceinline__ void conv_unit(const GAS bf16* Z, GAS bf16* YA, const GAS float* cw, const GAS float* cb, const GAS float* lng, const GAS float* lnb, LAS unsigned char* lds, int u, int tid, int wave, int lane) {
    LAS float* uL = (LAS float*)lds;
    LAS float* cv = (LAS float*)(lds + 62 * 256 * 4);
    const int b = u >> 8, blk = u & 255, t0 = blk * 32; const size_t growb = (size_t)b * SEQ;
    for (int e = tid; e < 62 * 256; e += NTHREADS) { const int tt = e >> 8, c = e & 255, t = t0 - 30 + tt; float val = 0.f;
        if (t >= 0) { const GAS bf16* zr = Z + (growb + t) * ZLD; val = bf2f(zr[ZA_VAL + c]) * sigm(bf2f(zr[ZA_GATE + c])); }
        uL[e] = val; }
    __syncthreads();
    { const int c = tid & 255, hf = tid >> 8; float w[31];
#pragma unroll
      for (int k = 0; k < 31; ++k) w[k] = cw[k * 256 + c];
      const float bias = cb[c];
#pragma unroll 1
      for (int tt = 0; tt < 16; ++tt) { const int tl = 16 * hf + tt; float acc = bias;
#pragma unroll
          for (int k = 0; k < 31; ++k) acc += uL[(tl + k) * 256 + c] * w[k];
          cv[tl * 256 + c] = acc; } }
    __syncthreads();
#pragma unroll
    for (int q = 0; q < 4; ++q) { const int tl = 4 * wave + q;
        const f32x4 x = *(const LAS f32x4*)(cv + tl * 256 + 4 * lane);
        const float mu = wave_sum((x[0] + x[1]) + (x[2] + x[3])) * (1.0f / 256.0f);
        const f32x4 d = x - mu;
        const float var = wave_sum((d[0] * d[0] + d[1] * d[1]) + (d[2] * d[2] + d[3] * d[3])) * (1.0f / 256.0f);
        const float rs = 1.0f / sqrtf(var + EPS);
        const f32x4 g4 = *(const GAS f32x4*)(lng + 4 * lane), b4 = *(const GAS f32x4*)(lnb + 4 * lane);
        f32x4 y = d * rs * g4 + b4;
        v2u o; o.x = pk2(siluf(y[0]), siluf(y[1])); o.y = pk2(siluf(y[2]), siluf(y[3]));
        *(GAS v2u*)(YA + (growb + t0 + tl) * 256 + 4 * lane) = o; }
    __syncthreads();
}

struct LinPar { const GAS bf16* Z; const GAS float* gate_w; const GAS float* gate_b; const GAS float* lb_logits; int layer; };
constexpr int L_LF = 0, L_Q = 16384, L_K = 32768, L_V = 49152, L_QT = 65536, L_KT = 82944, L_QH = 100352, L_AT = 117760, L_S = 135168;
constexpr int TS = 68;
template <int DK>
__device__ __forceinline__ void lin_load(const LinPar& P, LAS unsigned char* lds, int b, int c, int h, int tid) {
    LAS float* gL = (LAS float*)(lds + L_LF); LAS float* qL = (LAS float*)(lds + L_Q); LAS float* kL = (LAS float*)(lds + L_K); LAS float* vL = (LAS float*)(lds + L_V);
    const int t = tid >> 3, part = tid & 7;
    const GAS bf16* zr = P.Z + ((size_t)b * SEQ + c * 64 + t) * ZLD;
    if (DK == 32) {
        const v2u qw = *(const GAS v2u*)(zr + ZC_Q + h * 32 + 4 * part), kw = *(const GAS v2u*)(zr + ZC_K + h * 32 + 4 * part);
        const float qs = 0.17677669529663687f;
        const float qv[4] = {bflo(qw.x) * qs, bfhi(qw.x) * qs, bflo(qw.y) * qs, bfhi(qw.y) * qs};
        const float kv[4] = {bflo(kw.x), bfhi(kw.x), bflo(kw.y), bfhi(kw.y)};
        const v4u g0 = *(const GAS v4u*)(zr + ZC_GLR), g1 = *(const GAS v4u*)(zr + ZC_GLR + 8);
        const unsigned gw[8] = {g0.x, g0.y, g0.z, g0.w, g1.x, g1.y, g1.z, g1.w};
        float a[4];
#pragma unroll
        for (int j = 0; j < 4; ++j) a[j] = P.gate_b[h * 32 + 4 * part + j];
#pragma unroll
        for (int r2 = 0; r2 < 8; ++r2) { const float x0 = bflo(gw[r2]), x1 = bfhi(gw[r2]);
            const f32x4 w0 = *(const GAS f32x4*)(P.gate_w + (2 * r2) * 128 + h * 32 + 4 * part), w1 = *(const GAS f32x4*)(P.gate_w + (2 * r2 + 1) * 128 + h * 32 + 4 * part);
#pragma unroll
            for (int j = 0; j < 4; ++j) a[j] += x0 * w0[j] + x1 * w1[j]; }
#pragma unroll
        for (int j = 0; j < 4; ++j) { const int d = 4 * part + j; gL[t * DK + d] = logsigm(a[j]) * (1.0f / 16.0f); qL[t * DK + d] = qv[j]; kL[t * DK + d] = kv[j]; }
        const v4u vw = *(const GAS v4u*)(zr + ZC_V + h * 64 + 8 * part);
        const unsigned vv[4] = {vw.x, vw.y, vw.z, vw.w};
#pragma unroll
        for (int j = 0; j < 4; ++j) { vL[t * 64 + 8 * part + 2 * j] = bflo(vv[j]); vL[t * 64 + 8 * part + 2 * j + 1] = bfhi(vv[j]); }
    } else {
        const v4u fw = *(const GAS v4u*)(zr + ZD_F + h * 64 + 8 * part), qw = *(const GAS v4u*)(zr + ZD_Q + h * 64 + 8 * part), iw = *(const GAS v4u*)(zr + ZD_I + h * 64 + 8 * part);
        const unsigned fa[4] = {fw.x, fw.y, fw.z, fw.w}, qa[4] = {qw.x, qw.y, qw.z, qw.w}, ia[4] = {iw.x, iw.y, iw.z, iw.w};
#pragma unroll
        for (int j = 0; j < 8; ++j) { const int d = 8 * part + j;
            const float zf = (j & 1) ? bfhi(fa[j >> 1]) : bflo(fa[j >> 1]), zq = (j & 1) ? bfhi(qa[j >> 1]) : bflo(qa[j >> 1]), zi = (j & 1) ? bfhi(ia[j >> 1]) : bflo(ia[j >> 1]);
            float lbv = 0.f;
            if (P.layer == 1) lbv = sigm(P.lb_logits[256 + h * 64 + d] - P.lb_logits[h * 64 + d]);
            const float sg = sigm(zf);
            const float f = lbv + (1.0f - lbv) * sg;
            gL[t * DK + d] = (P.layer == 0) ? logsigm(zf) : __logf(f);
            kL[t * DK + d] = (1.0f - lbv) * sigm(-zf);
            qL[t * DK + d] = siluf(zq);
            vL[t * 64 + d] = zi; }
    }
    __syncthreads();
    if (tid < DK) { float run = 0.f;
#pragma unroll 4
        for (int tt = 0; tt < 64; ++tt) { run += gL[tt * DK + tid]; gL[tt * DK + tid] = run; } }
    __syncthreads();
}
template <int DK>
__device__ __forceinline__ void lin_local_unit(const LinPar& P, GAS float* ST, GAS float* DEC, LAS unsigned char* lds, int u, int tid) {
    const int b = u / (NCH * 4), c = (u / 4) % NCH, h = u & 3;
    lin_load<DK>(P, lds, b, c, h, tid);
    LAS float* gL = (LAS float*)(lds + L_LF); LAS float* kL = (LAS float*)(lds + L_K); LAS float* vL = (LAS float*)(lds + L_V);
    for (int e = tid; e < 64 * DK; e += NTHREADS) { const int d = e % DK; kL[e] = kL[e] * __expf(gL[63 * DK + d] - gL[e]); }
    __syncthreads();
    constexpr int VPT = DK / 8, NVO = 64 / VPT;
    const int d = tid / NVO, vo = tid % NVO;
    float acc[VPT];
#pragma unroll
    for (int j = 0; j < VPT; ++j) acc[j] = 0.f;
#pragma unroll 4
    for (int t = 0; t < 64; ++t) { const float kk = kL[t * DK + d];
#pragma unroll
        for (int j = 0; j < VPT; ++j) acc[j] += kk * vL[t * 64 + vo * VPT + j]; }
    GAS float* so = ST + ((size_t)(b * NCH + c) * 4 + h) * DK * 64 + d * 64 + vo * VPT;
#pragma unroll
    for (int j = 0; j < VPT; ++j) so[j] = acc[j];
    if (tid < DK) DEC[(size_t)(b * NCH + c) * 4 * DK + h * DK + tid] = __expf(gL[63 * DK + tid]);
    __syncthreads();
}
__device__ __forceinline__ void scan_unit(GAS float* STC, GAS float* STD, const GAS float* DECC, const GAS float* DECD, int u, int tid) {
    const int e = u * NTHREADS + tid;
    GAS float* sp; const GAS float* dp; size_t sstride, dstride;
    if (e < GB * 8192) { const int b = e / 8192, rem = e % 8192; sp = STC + (size_t)b * NCH * 8192 + rem; sstride = 8192; dp = DECC + (size_t)b * NCH * 128 + rem / 64; dstride = 128; }
    else { const int e2 = e - GB * 8192; const int b = e2 / 16384, rem = e2 % 16384; sp = STD + (size_t)b * NCH * 16384 + rem; sstride = 16384; dp = DECD + (size_t)b * NCH * 256 + rem / 64; dstride = 256; }
    float s = 0.f;
#pragma unroll 1
    for (int c0 = 0; c0 < NCH; c0 += 8) {
        float uu[8], dd[8];
#pragma unroll
        for (int i = 0; i < 8; ++i) { uu[i] = sp[(size_t)(c0 + i) * sstride]; dd[i] = dp[(size_t)(c0 + i) * dstride]; }
#pragma unroll
        for (int i = 0; i < 8; ++i) { sp[(size_t)(c0 + i) * sstride] = s; s = dd[i] * s + uu[i]; }
    }
}
template <int DK>
__device__ __forceinline__ void lin_out_unit(const LinPar& P, const GAS float* ST, const GAS float* normg, GAS bf16* YS, LAS unsigned char* lds, int u, int tid) {
    const int b = u / (NCH * 4), c = (u / 4) % NCH, h = u & 3;
    lin_load<DK>(P, lds, b, c, h, tid);
    LAS float* gL = (LAS float*)(lds + L_LF); LAS float* qL = (LAS float*)(lds + L_Q); LAS float* kL = (LAS float*)(lds + L_K); LAS float* vL = (LAS float*)(lds + L_V);
    LAS float* qT = (LAS float*)(lds + L_QT); LAS float* kT = (LAS float*)(lds + L_KT); LAS float* qH = (LAS float*)(lds + L_QH); LAS float* aT = (LAS float*)(lds + L_AT); LAS float* sM = (LAS float*)(lds + L_S);
    for (int e = tid; e < 64 * DK; e += NTHREADS) { const int t = e / DK, d = e % DK;
        const float g = gL[e], r = gL[31 * DK + d], q = qL[e], k = kL[e];
        qT[d * TS + t] = q * __expf(fminf(g - r, 80.f)); kT[d * TS + t] = k * __expf(fminf(r - g, 80.f)); qH[d * TS + t] = q * __expf(g); }
    { const GAS float* sp = ST + ((size_t)(b * NCH + c) * 4 + h) * DK * 64;
      for (int e = tid; e < DK * 64; e += NTHREADS) sM[e] = sp[e]; }
    __syncthreads();
    const int i = tid >> 3, jo = tid & 7;
    { float a[8];
#pragma unroll
      for (int j = 0; j < 8; ++j) a[j] = 0.f;
#pragma unroll 4
      for (int d = 0; d < DK; ++d) { const float qv = qT[d * TS + i];
          const f32x4 k0 = *(const LAS f32x4*)(kT + d * TS + 8 * jo), k1 = *(const LAS f32x4*)(kT + d * TS + 8 * jo + 4);
          a[0] += qv * k0[0]; a[1] += qv * k0[1]; a[2] += qv * k0[2]; a[3] += qv * k0[3]; a[4] += qv * k1[0]; a[5] += qv * k1[1]; a[6] += qv * k1[2]; a[7] += qv * k1[3]; }
#pragma unroll
      for (int j = 0; j < 8; ++j) { const int jj = 8 * jo + j; aT[jj * TS + i] = (jj <= i) ? a[j] : 0.f; } }
    __syncthreads();
    { float o[8];
#pragma unroll
      for (int j = 0; j < 8; ++j) o[j] = 0.f;
#pragma unroll 4
      for (int j = 0; j < 64; ++j) { const float av = aT[j * TS + i];
          const f32x4 v0 = *(const LAS f32x4*)(vL + j * 64 + 8 * jo), v1 = *(const LAS f32x4*)(vL + j * 64 + 8 * jo + 4);
          o[0] += av * v0[0]; o[1] += av * v0[1]; o[2] += av * v0[2]; o[3] += av * v0[3]; o[4] += av * v1[0]; o[5] += av * v1[1]; o[6] += av * v1[2]; o[7] += av * v1[3]; }
#pragma unroll 4
      for (int d = 0; d < DK; ++d) { const float qv = qH[d * TS + i];
          const f32x4 s0 = *(const LAS f32x4*)(sM + d * 64 + 8 * jo), s1 = *(const LAS f32x4*)(sM + d * 64 + 8 * jo + 4);
          o[0] += qv * s0[0]; o[1] += qv * s0[1]; o[2] += qv * s0[2]; o[3] += qv * s0[3]; o[4] += qv * s1[0]; o[5] += qv * s1[1]; o[6] += qv * s1[2]; o[7] += qv * s1[3]; }
      float ss = 0.f;
#pragma unroll
      for (int j = 0; j < 8; ++j) ss += o[j] * o[j];
      ss += __shfl_xor(ss, 1); ss += __shfl_xor(ss, 2); ss += __shfl_xor(ss, 4);
      const float rs = 1.0f / sqrtf(ss * (1.0f / 64.0f) + EPS);
      const size_t grow = (size_t)b * SEQ + c * 64 + i;
      const v4u ogw = *(const GAS v4u*)(P.Z + grow * ZLD + (DK == 32 ? ZC_OG : ZD_OG) + h * 64 + 8 * jo);
      const unsigned oga[4] = {ogw.x, ogw.y, ogw.z, ogw.w};
      const f32x4 n0 = *(const GAS f32x4*)(normg + 8 * jo), n1 = *(const GAS f32x4*)(normg + 8 * jo + 4);
      const float ng[8] = {n0[0], n0[1], n0[2], n0[3], n1[0], n1[1], n1[2], n1[3]};
      float y[8];
#pragma unroll
      for (int j = 0; j < 8; ++j) { const float og = (j & 1) ? bfhi(oga[j >> 1]) : bflo(oga[j >> 1]); y[j] = o[j] * rs * ng[j] * siluf(og); }
      v4u w; w.x = pk2(y[0], y[1]); w.y = pk2(y[2], y[3]); w.z = pk2(y[4], y[5]); w.w = pk2(y[6], y[7]);
      *(GAS v4u*)(YS + grow * 256 + h * 64 + 8 * jo) = w; }
    __syncthreads();
}

constexpr int TK_CAP = 448, TK_TRIG = TK_CAP - 32, TK_K = 256;
constexpr int TKW_BUF = 0, TKW_PS = 8 * TK_CAP * 4, TKW_Q = TKW_PS + 4096, TKW_CT = TKW_Q + 1024, TKW_BYTES = TKW_CT + 64;
static_assert(TKW_BYTES * 8 <= MISC_OFF, "top-k LDS");
__device__ __forceinline__ unsigned tk_compact(LAS unsigned* bufq, int n, int lane) {
    unsigned e[7];
#pragma unroll
    for (int r = 0; r < 7; ++r) { const int idx = lane + 64 * r; e[r] = (idx < n) ? bufq[idx] : 0u; }
    unsigned T = 0u;
#pragma unroll 1
    for (int bit = 31; bit >= 0; --bit) { const unsigned cand = T | (1u << bit); int c = 0;
#pragma unroll
        for (int r = 0; r < 7; ++r) c += __popcll(__ballot(e[r] >= cand));
        if (c >= TK_K) T = cand; }
    LDS_WAIT();
    int base = 0;
#pragma unroll
    for (int r = 0; r < 7; ++r) { const bool keep = e[r] >= T; const unsigned long long m = __ballot(keep);
        const unsigned pre = __builtin_amdgcn_mbcnt_hi((unsigned)(m >> 32), __builtin_amdgcn_mbcnt_lo((unsigned)m, 0u));
        if (keep) bufq[base + pre] = e[r];
        base += __popcll(m); }
    LDS_WAIT();
    return T;
}
__device__ __forceinline__ void tk_compact_all(LAS unsigned* buf, LAS unsigned* ct, int limit, int lane) {
#pragma unroll 1
    for (int ql = 0; ql < 8; ++ql) { const int n = __builtin_amdgcn_readfirstlane(ct[ql]);
        if (n > limit) { const unsigned T = tk_compact(buf + ql * TK_CAP, n, lane); if (lane == 0) { ct[ql] = TK_K; ct[8 + ql] = T; } } }
    LDS_WAIT();
}
__device__ __forceinline__ void topk_attn_unit(const GAS bf16* Z, GAS bf16* YB, LAS unsigned char* lds, int b, int qb, int wave, int lane) {
    LAS unsigned char* wl = lds + wave * TKW_BYTES;
    LAS unsigned* buf = (LAS unsigned*)(wl + TKW_BUF); LAS float* ps = (LAS float*)(wl + TKW_PS); LAS float* qf = (LAS float*)(wl + TKW_Q); LAS unsigned* ct = (LAS unsigned*)(wl + TKW_CT);
    const int half = lane >> 5, l31 = lane & 31;
    const size_t growb = (size_t)b * SEQ;
    const int tq0 = qb * 64 + wave * 8;
    if (lane < 16) ct[lane] = 0u;
    bf16x8 aq[4];
    { const GAS bf16* qr = Z + (growb + tq0 + (l31 >> 2)) * ZLD + ZB_QI + (l31 & 3) * 64 + 8 * half;
#pragma unroll
      for (int ks = 0; ks < 4; ++ks) aq[ks] = *(const GAS bf16x8*)(qr + 16 * ks); }
    float wv[4][4];
#pragma unroll
    for (int g = 0; g < 4; ++g) { const v2u ww = *(const GAS v2u*)(Z + (growb + tq0 + 2 * g + half) * ZLD + ZB_WI);
        wv[g][0] = bflo(ww.x) * 0.0625f; wv[g][1] = bfhi(ww.x) * 0.0625f; wv[g][2] = bflo(ww.y) * 0.0625f; wv[g][3] = bfhi(ww.y) * 0.0625f; }
    unsigned thr[4] = {0u, 0u, 0u, 0u}; int cnt[4] = {0, 0, 0, 0};
    LDS_WAIT();
    const int ktmax = (tq0 + 7) >> 5;
#pragma unroll 1
    for (int kt = 0; kt <= ktmax; ++kt) {
        const GAS bf16* kr = Z + (growb + 32 * kt + l31) * ZLD + ZB_KI + 8 * half;
        bf16x8 bk[4];
#pragma unroll
        for (int ks = 0; ks < 4; ++ks) bk[ks] = *(const GAS bf16x8*)(kr + 16 * ks);
        f32x16 acc;
#pragma unroll
        for (int r = 0; r < 16; ++r) acc[r] = 0.f;
#pragma unroll
        for (int ks = 0; ks < 4; ++ks) acc = __builtin_amdgcn_mfma_f32_32x32x16_bf16(aq[ks], bk[ks], acc, 0, 0, 0);
        const int key = 32 * kt + l31;
        bool over = false;
#pragma unroll
        for (int g = 0; g < 4; ++g) {
            const int tq = tq0 + 2 * g + half;
            float s = 0.f;
#pragma unroll
            for (int h = 0; h < 4; ++h) s = fmaf(wv[g][h], fmaxf(acc[4 * g + h], 0.f), s);
            s = (s == 0.f) ? 0.f : s;
            const unsigned bb = __float_as_uint(s);
            const unsigned ord = bb ^ ((unsigned)((int)bb >> 31) | 0x80000000u);
            const unsigned packed = (ord & 0xFFFFE000u) | (0x1FFFu - (unsigned)key);
            const bool pass = (key <= tq) && (packed > thr[g]);
            const unsigned long long mask = __ballot(pass);
            if (mask != 0ull) {
                const unsigned mlo = (unsigned)mask, mhi = (unsigned)(mask >> 32);
                const unsigned pre = half ? __builtin_amdgcn_mbcnt_hi(mhi, 0u) : __builtin_amdgcn_mbcnt_lo(mlo, 0u);
                if (pass) buf[(2 * g + half) * TK_CAP + cnt[g] + (int)pre] = packed;
                cnt[g] += half ? __popc(mhi) : __popc(mlo);
            }
            over = over || (cnt[g] > TK_TRIG);
        }
        if (__ballot(over) != 0ull) {
#pragma unroll
            for (int g = 0; g < 4; ++g) if (l31 == 0) ct[2 * g + half] = (unsigned)cnt[g];
            LDS_WAIT();
            tk_compact_all(buf, ct, TK_TRIG, lane);
#pragma unroll
            for (int g = 0; g < 4; ++g) { cnt[g] = (int)ct[2 * g + half]; thr[g] = ct[8 + 2 * g + half]; }
        }
    }
#pragma unroll
    for (int g = 0; g < 4; ++g) if (l31 == 0) ct[2 * g + half] = (unsigned)cnt[g];
    LDS_WAIT();
    tk_compact_all(buf, ct, TK_K, lane);
#pragma unroll 1
    for (int ql = 0; ql < 8; ++ql) {
        const int n = __builtin_amdgcn_readfirstlane(ct[ql]);
        const size_t qrow = growb + tq0 + ql;
        LAS unsigned* bq = buf + ql * TK_CAP;
#pragma unroll
        for (int h = 0; h < 4; ++h) qf[h * 64 + lane] = bf2f(Z[qrow * ZLD + ZB_Q + h * 64 + lane]);
        LDS_WAIT();
        float sc[4][4];
#pragma unroll
        for (int p = 0; p < 4; ++p) {
            const int slot = 64 * p + lane; const bool valid = slot < n;
            const int key = valid ? (int)(0x1FFFu - (bq[slot] & 0x1FFFu)) : 0;
            const GAS bf16* kr = Z + (growb + key) * ZLD + ZB_K;
            float s0 = 0.f, s1 = 0.f, s2 = 0.f, s3 = 0.f;
#pragma unroll 1
            for (int c = 0; c < 8; ++c) { const v4u kw = *(const GAS v4u*)(kr + 8 * c);
                const float kf[8] = {bflo(kw.x), bfhi(kw.x), bflo(kw.y), bfhi(kw.y), bflo(kw.z), bfhi(kw.z), bflo(kw.w), bfhi(kw.w)};
                const f32x4 qa0 = *(const LAS f32x4*)(qf + 0 * 64 + 8 * c), qb0 = *(const LAS f32x4*)(qf + 0 * 64 + 8 * c + 4);
                const f32x4 qa1 = *(const LAS f32x4*)(qf + 1 * 64 + 8 * c), qb1 = *(const LAS f32x4*)(qf + 1 * 64 + 8 * c + 4);
                const f32x4 qa2 = *(const LAS f32x4*)(qf + 2 * 64 + 8 * c), qb2 = *(const LAS f32x4*)(qf + 2 * 64 + 8 * c + 4);
                const f32x4 qa3 = *(const LAS f32x4*)(qf + 3 * 64 + 8 * c), qb3 = *(const LAS f32x4*)(qf + 3 * 64 + 8 * c + 4);
#pragma unroll
                for (int j = 0; j < 4; ++j) { s0 = fmaf(kf[j], qa0[j], s0); s1 = fmaf(kf[j], qa1[j], s1); s2 = fmaf(kf[j], qa2[j], s2); s3 = fmaf(kf[j], qa3[j], s3);
                    s0 = fmaf(kf[4 + j], qb0[j], s0); s1 = fmaf(kf[4 + j], qb1[j], s1); s2 = fmaf(kf[4 + j], qb2[j], s2); s3 = fmaf(kf[4 + j], qb3[j], s3); } }
            sc[p][0] = valid ? s0 * 0.125f : -INFINITY; sc[p][1] = valid ? s1 * 0.125f : -INFINITY; sc[p][2] = valid ? s2 * 0.125f : -INFINITY; sc[p][3] = valid ? s3 * 0.125f : -INFINITY;
        }
#pragma unroll
        for (int h = 0; h < 4; ++h) {
            const float mx = wave_max(fmaxf(fmaxf(sc[0][h], sc[1][h]), fmaxf(sc[2][h], sc[3][h])));
            float e0 = __expf(sc[0][h] - mx), e1 = __expf(sc[1][h] - mx), e2 = __expf(sc[2][h] - mx), e3 = __expf(sc[3][h] - mx);
            const float inv = 1.0f / wave_sum((e0 + e1) + (e2 + e3));
            sc[0][h] = e0 * inv; sc[1][h] = e1 * inv; sc[2][h] = e2 * inv; sc[3][h] = e3 * inv;
        }
#pragma unroll
        for (int p = 0; p < 4; ++p) *(LAS f32x4*)(ps + (64 * p + lane) * 4) = (f32x4){sc[p][0], sc[p][1], sc[p][2], sc[p][3]};
        LDS_WAIT();
        const int ks2 = lane >> 3, dc = lane & 7;
        float o[4][8];
#pragma unroll
        for (int h = 0; h < 4; ++h)
#pragma unroll
            for (int j = 0; j < 8; ++j) o[h][j] = 0.f;
#pragma unroll 2
        for (int i = 0; i < 32; ++i) {
            const int slot = 8 * i + ks2;
            const int key = (slot < n) ? (int)(0x1FFFu - (bq[slot] & 0x1FFFu)) : 0;
            const f32x4 pp = *(const LAS f32x4*)(ps + slot * 4);
            const v4u vw = *(const GAS v4u*)(Z + (growb + key) * ZLD + ZB_V + 8 * dc);
            const float vf[8] = {bflo(vw.x), bfhi(vw.x), bflo(vw.y), bfhi(vw.y), bflo(vw.z), bfhi(vw.z), bflo(vw.w), bfhi(vw.w)};
#pragma unroll
            for (int j = 0; j < 8; ++j) { o[0][j] = fmaf(pp[0], vf[j], o[0][j]); o[1][j] = fmaf(pp[1], vf[j], o[1][j]); o[2][j] = fmaf(pp[2], vf[j], o[2][j]); o[3][j] = fmaf(pp[3], vf[j], o[3][j]); }
        }
#pragma unroll
        for (int h = 0; h < 4; ++h)
#pragma unroll
            for (int j = 0; j < 8; ++j) { float v = o[h][j]; v += __shfl_xor(v, 8); v += __shfl_xor(v, 16); v += __shfl_xor(v, 32); o[h][j] = v; }
        if (ks2 == 0) {
#pragma unroll
            for (int h = 0; h < 4; ++h) { v4u w; w.x = pk2(o[h][0], o[h][1]); w.y = pk2(o[h][2], o[h][3]); w.z = pk2(o[h][4], o[h][5]); w.w = pk2(o[h][6], o[h][7]);
                *(GAS v4u*)(YB + qrow * 256 + h * 64 + 8 * dc) = w; }
        }
        LDS_WAIT();
    }
}

__device__ __forceinline__ void zero_ys(GAS bf16* Y, int gtid, int gstride) { for (size_t i = gtid; i < (size_t)MG * 256 / 8; i += gstride) ((GAS v4u*)Y)[i] = (v4u){0u, 0u, 0u, 0u}; }

__device__ __forceinline__ const void* ld_arg(LAS unsigned char* lds, int k) {
    unsigned off = MISC_OFF + 128 + 8 * k; asm volatile("" : "+v"(off));
    const LAS unsigned* p = (const LAS unsigned*)(lds + off);
    const unsigned lo = __builtin_amdgcn_readfirstlane(p[0]), hi = __builtin_amdgcn_readfirstlane(p[1]);
    return (const void*)(((unsigned long long)hi << 32) | lo);
}
__device__ __forceinline__ bool run_step(int lo, int hi, int s) {
    asm volatile("" : "+s"(lo), "+s"(hi));
    return s >= lo && s < hi;
}
struct GatedOrder {
    int G, c;
    __device__ __forceinline__ void init(int G_, int c_) { G = G_; c = c_; }
    __device__ __forceinline__ bool next(int i, pg8::Unit& u) const {
        const int nb = i & 3, t = (i >> 2) * G + c; if (t >= (MG / 256) * 4) return false;
        u.pm = nb * (MG / 256) + (t >> 2); u.pn = nb * 4 + (t & 3); return true;
    }
    __device__ __forceinline__ void a_ready(const pg8::Unit&) const {}
    __device__ __forceinline__ void done(const pg8::Unit&) const {}
};
struct KArgs { const void* in[22]; float* out; unsigned char* ws; int step_lo, step_hi, li, pad; };
constexpr int N_STEPS = 32;

__global__ void __launch_bounds__(NTHREADS, 2) mega_fwd(KArgs a) {
    extern __shared__ __attribute__((aligned(16))) unsigned char lds_raw[];
    LAS unsigned char* lds = (LAS unsigned char*)lds_raw;
    volatile LAS unsigned* MISC = (volatile LAS unsigned*)(lds + MISC_OFF);
    const int G = gridDim.x; const int bx = blockIdx.x; const int vcu = (G % 8 == 0) ? (bx % 8) * (G / 8) + bx / 8 : bx;
    const int NGW = G * NWAVES, gstride = G * NTHREADS;
    if (threadIdx.x < 16) MISC[threadIdx.x] = 0u;
    const int wave_s = __builtin_amdgcn_readfirstlane(threadIdx.x >> 6);
    if (threadIdx.x < 22) ((volatile LAS unsigned long long*)(lds + MISC_OFF + 128))[threadIdx.x] = (unsigned long long)a.in[threadIdx.x];
    __syncthreads();
#define IN(k) ((const GAS float*)ld_arg(lds, (k)))
    GAS unsigned char* const ws_k = (GAS unsigned char*)a.ws;
    const bool use_bar = (a.step_hi - a.step_lo) > 1;
    XcdBarrier bar; bar.bar = (unsigned*)(ws_k + WS_CTL) + CW_BAR + a.li * XCD_BAR_WORDS; bar.x = 0; bar.st = nullptr;
    if (use_bar) bar = xcd_barrier_post((unsigned*)(ws_k + WS_CTL) + CW_BAR + a.li * XCD_BAR_WORDS, MISC + 8);
#define RUN(s) run_step(a.step_lo, a.step_hi, (s))
#define SEAM(s) do { if (RUN(s) && RUN((s) + 1)) xcd_barrier(bar); } while (0)
#define STEP_IDS unsigned ones_ = ~0u; asm volatile("" : "+s"(ones_)); GAS unsigned char* ws = ws_k; asm volatile("" : "+s"(ws)); const int lane = (int)__builtin_amdgcn_mbcnt_hi(ones_, __builtin_amdgcn_mbcnt_lo(ones_, 0u)); int wave = wave_s; asm volatile("" : "+s"(wave)); \
    const int tid = wave * 64 + lane; const int gw = vcu * NWAVES + wave, gtid = vcu * NTHREADS + tid; (void)gw; (void)gtid;
#define STEP_L int l = l0; asm volatile("" : "+s"(l));
#define STEP_G int g = g0; asm volatile("" : "+s"(g));
#define P_CMOD ((GAS float*)(ws + WS_CMOD))
#define P_ROPE ((GAS float*)(ws + WS_ROPE))
#define P_H ((GAS bf16*)(ws + WS_H))
#define P_Z ((GAS bf16*)(ws + WS_Z))
#define P_GT ((GAS bf16*)(ws + WS_GATES))
#define P_YS ((GAS bf16*)(ws + WS_YS))
#define P_MF ((GAS float*)(ws + WS_MF32))
#define P_STC ((GAS float*)(ws + WS_STC))
#define P_STD ((GAS float*)(ws + WS_STD))
#define P_DECC ((GAS float*)(ws + WS_DECC))
#define P_DECD ((GAS float*)(ws + WS_DECD))
#define P_U ((GAS bf16*)(ws + WS_U))

    if (RUN(0)) { STEP_IDS
        p0_weights(IN(7), IN(17), IN(18), IN(19), IN(20), ws, lds, gw, NGW, wave, lane);
        __syncthreads();
        p0_rope(P_ROPE, gtid, gstride);
        p0_cmod(IN(1), IN(3), IN(4), P_CMOD, lds, vcu, G, tid, wave, lane);
    }
    SEAM(0);

    for (int l0 = 0; l0 < NL; ++l0) {
        const int sb = 1 + l0 * 15;
        if (RUN(sb)) { STEP_IDS STEP_L
            if (MK_SKIP & 1) { if (l == 0) copy_rows(IN(0), ((GAS float*)a.out), gw, NGW, lane); }
            else norm_rows((l == 0) ? IN(0) : (const GAS float*)a.out, P_H, IN(5) + l * DM, P_CMOD + (size_t)l * NB * 6144, 0, 1024, gw, NGW, lane);
        }
        SEAM(sb);
        for (int g0 = 0; g0 < NGRP; ++g0) {
            const int sg = sb + 1 + g0 * 5;
            if (RUN(sg) && !(MK_SKIP & 1)) { STEP_IDS STEP_L STEP_G
                pg8::Gemm gm{(const bf16*)(P_H + (size_t)g * MG * DM), (const bf16*)((const GAS bf16*)(ws + WS_WIN) + (size_t)l * NV * 1024), MG, NV, 1024};
                pg8::StaticOrder S; S.init(MG, NV, G, bx);
                EpiZ E{P_Z, P_GT};
                pg8::gemm_phase<EpiZ, pg8::StaticOrder, true, true>(lds, gm, S, E, tid);
            }
            SEAM(sg);
            if (RUN(sg + 1) && !(MK_SKIP & 1)) { STEP_IDS STEP_L STEP_G
                LinPar LP{P_Z, IN(12) + l * 16 * 128, IN(13) + l * 128, IN(15), l};
                constexpr int U_ROPE = MG / NTHREADS, U_CONV = GB * 256, U_LIN = GB * NCH * 4;
                for (int u = vcu; u < U_ROPE + U_CONV + 2 * U_LIN; u += G) {
                    int r = u;
                    if (r < U_ROPE) { if (!(MK_SKIP & 8)) rope_unit(P_Z, (const GAS int*)IN(2) + (size_t)g * MG, P_ROPE, r, tid); continue; } r -= U_ROPE;
                    if (r < U_CONV) { if (!(MK_SKIP & 4)) conv_unit(P_Z, P_YS, IN(8) + l * 31 * 256, IN(9) + l * 256, IN(10) + l * 256, IN(11) + l * 256, lds, r, tid, wave, lane); continue; } r -= U_CONV;
                    if (r < U_LIN) { if (!(MK_SKIP & 16)) lin_local_unit<32>(LP, P_STC, P_DECC, lds, r, tid); continue; } r -= U_LIN;
                    if (!(MK_SKIP & 32)) lin_local_unit<64>(LP, P_STD, P_DECD, lds, r, tid);
                }
                if (MK_SKIP & 4) zero_ys(P_YS, gtid, gstride);
                if (MK_SKIP & 8) zero_ys(P_YS + (size_t)MG * 256, gtid, gstride);
                if (MK_SKIP & 16) zero_ys(P_YS + (size_t)2 * MG * 256, gtid, gstride);
                if (MK_SKIP & 32) zero_ys(P_YS + (size_t)3 * MG * 256, gtid, gstride);
            }
            SEAM(sg + 1);
            if (RUN(sg + 2) && !(MK_SKIP & 1)) { STEP_IDS STEP_L STEP_G
                constexpr int U_SCAN = (GB * 8192 + GB * 16384) / NTHREADS;
                if (!(MK_SKIP & 48)) for (int u = vcu; u < U_SCAN; u += G) scan_unit(P_STC, P_STD, P_DECC, P_DECD, u, tid);
                if (!(MK_SKIP & 8)) {
                    const int W = G / GB;
                    if (W > 0 && vcu < W * GB) { const int b = vcu / W, j = vcu % W;
                        for (int p2 = 2 * j; p2 < 128; p2 += 2 * W) for (int it = 0; it < 2; ++it) { const int p = p2 >> 1; topk_attn_unit(P_Z, P_YS + (size_t)MG * 256, lds, b, it ? p : 127 - p, wave, lane); } }
                }
            }
            SEAM(sg + 2);
            if (RUN(sg + 3) && !(MK_SKIP & 1)) { STEP_IDS STEP_L STEP_G
                LinPar LP{P_Z, IN(12) + l * 16 * 128, IN(13) + l * 128, IN(15), l};
                constexpr int U_LIN = GB * NCH * 4;
                for (int u = vcu; u < 2 * U_LIN; u += G) {
                    if (u < U_LIN) { if (!(MK_SKIP & 16)) lin_out_unit<32>(LP, P_STC, IN(14) + l * 64, P_YS + (size_t)2 * MG * 256, lds, u, tid); }
                    else { if (!(MK_SKIP & 32)) lin_out_unit<64>(LP, P_STD, IN(16) + l * 64, P_YS + (size_t)3 * MG * 256, lds, u - U_LIN, tid); }
                }
            }
            SEAM(sg + 3);
            if (RUN(sg + 4) && !(MK_SKIP & 1)) { STEP_IDS STEP_L STEP_G
                pg8::Gemm gm{(const bf16*)(P_YS), (const bf16*)((const GAS bf16*)(ws + WS_WBO) + (size_t)l * 4 * 1024 * 256), 4 * MG, 4 * 1024, 256};
                GatedOrder S; S.init(G, bx);
                EpiGated E{P_GT, P_MF, P_H + (size_t)g * MG * DM};
                pg8::gemm_phase<EpiGated, GatedOrder, true, true>(lds, gm, S, E, tid);
            }
            SEAM(sg + 4);
        }
        if (RUN(sb + 11) && !(MK_SKIP & 1)) { STEP_IDS STEP_L
            pg8::Gemm gm{(const bf16*)(P_H), (const bf16*)((const GAS bf16*)(ws + WS_WO) + (size_t)l * 1024 * 1024), M_ALL, 1024, 1024};
            pg8::StaticOrder S; S.init(M_ALL, 1024, G, bx);
            EpiResid E{(l == 0) ? IN(0) : (const GAS float*)a.out, ((GAS float*)a.out), P_CMOD + (size_t)l * NB * 6144 + 2048};
            pg8::gemm_phase<EpiResid, pg8::StaticOrder, true, true>(lds, gm, S, E, tid);
        }
        SEAM(sb + 11);
        if (RUN(sb + 12) && !(MK_SKIP & 2)) { STEP_IDS STEP_L
            norm_rows(((GAS float*)a.out), P_H, IN(6) + l * DM, P_CMOD + (size_t)l * NB * 6144, 3072, 4096, gw, NGW, lane); }
        SEAM(sb + 12);
        if (RUN(sb + 13) && !(MK_SKIP & 2)) { STEP_IDS STEP_L
            pg8::Gemm gm{(const bf16*)(P_H), (const bf16*)((const GAS bf16*)(ws + WS_W1) + (size_t)l * DFF * 1024), M_ALL, DFF, 1024};
            pg8::StaticOrder S; S.init(M_ALL, DFF, G, bx);
            EpiRelu2 E{P_U};
            pg8::gemm_phase<EpiRelu2, pg8::StaticOrder, true, true>(lds, gm, S, E, tid);
        }
        SEAM(sb + 13);
        if (RUN(sb + 14) && !(MK_SKIP & 2)) { STEP_IDS STEP_L
            pg8::Gemm gm{(const bf16*)(P_U), (const bf16*)((const GAS bf16*)(ws + WS_W2) + (size_t)l * 1024 * DFF), M_ALL, 1024, DFF};
            pg8::StaticOrder S; S.init(M_ALL, 1024, G, bx);
            EpiResid E{((GAS float*)a.out), ((GAS float*)a.out), P_CMOD + (size_t)l * NB * 6144 + 5120};
            pg8::gemm_phase<EpiResid, pg8::StaticOrder, true, true>(lds, gm, S, E, tid);
        }
        SEAM(sb + 14);
    }
    if (RUN(31)) { STEP_IDS final_norm_rows(((GAS float*)a.out), IN(21), gw, NGW, lane); }
#undef RUN
#undef SEAM
}

extern "C" void kernel_launch(void* const* d_in, const int* in_sizes, int n_in, void* d_out, int out_size, void* d_ws, size_t ws_size, hipStream_t stream) {
    static int grid = 0;
    if (grid == 0) {
        if (n_in != 22 || out_size != M_ALL * DM || ws_size < WS_END) { fprintf(stderr, "kernel_launch: unexpected problem shape (n_in %d out %d ws %zu)\n", n_in, out_size, ws_size); grid = -1; return; }
        int dev = 0, cus = 0, per_cu = 0;
        if (hipGetDevice(&dev) != hipSuccess || hipDeviceGetAttribute(&cus, hipDeviceAttributeMultiprocessorCount, dev) != hipSuccess) { grid = -1; return; }
        if (hipFuncSetAttribute((const void*)mega_fwd, hipFuncAttributeMaxDynamicSharedMemorySize, LDS_BYTES) != hipSuccess) { fprintf(stderr, "kernel_launch: hipFuncSetAttribute failed\n"); grid = -1; return; }
        if (hipOccupancyMaxActiveBlocksPerMultiprocessor(&per_cu, (const void*)mega_fwd, NTHREADS, LDS_BYTES) != hipSuccess || per_cu < 1) fprintf(stderr, "kernel_launch: occupancy query reports %d\n", per_cu);
        (void)hipGetLastError();
        grid = cus;
    }
    if (grid < 0) return;
    (void)hipMemsetAsync((char*)d_ws + WS_CTL, 0, CTL_ZERO_BYTES, stream);
    KArgs a{};
    for (int i = 0; i < 22; ++i) a.in[i] = d_in[i];
    a.out = (float*)d_out; a.ws = (unsigned char*)d_ws; a.pad = 0;
#if MK_N_LAUNCHES == 1
    a.step_lo = 0; a.step_hi = N_STEPS; a.li = 0;
    hipLaunchKernelGGL(mega_fwd, dim3(grid), dim3(NTHREADS), LDS_BYTES, stream, a);
#else
    for (int s = 0; s < N_STEPS; ++s) { a.step_lo = s; a.step_hi = s + 1; a.li = s;
        hipLaunchKernelGGL(mega_fwd, dim3(grid), dim3(NTHREADS), LDS_BYTES, stream, a); }
#endif
}
```

```cpp
#include <hip/hip_runtime.h>
#include <cstdio>
#include <cstdint>

namespace pg8 {
#define PG8_LAS __attribute__((address_space(3)))
typedef unsigned short bf16_t;
typedef short bf16x8 __attribute__((ext_vector_type(8)));
typedef float f32x4 __attribute__((ext_vector_type(4)));
typedef unsigned u32x4 __attribute__((ext_vector_type(4)));
constexpr int BM = 256, BK = 64, HALF = 128, HTB = HALF * BK * 2  , STAGE_BYTES = 8 * HTB, NXCD = 8, WGM = 8;

__host__ __device__ __forceinline__ int lds_byte(int r, int c) { const int st = (r >> 4) * 2 + (c >> 5), rr = r & 15, cc = c & 31, ob = rr * 64 + cc * 2; return st * 1024 + (ob ^ (((ob >> 9) & 1) << 5)); }
__host__ __device__ __forceinline__ void stage_rc(int b, int& R, int& C) { const int st = b / 1024, sb = b % 1024, swz = sb ^ (((sb >> 9) & 1) << 5); R = (st >> 1) * 16 + swz / 64; C = (st & 1) * 32 + (swz % 64) / 2; }
__host__ __device__ __forceinline__ int perm32(int rho) { const int n = rho >> 4, i = rho & 15; return 8 * (i >> 2) + 4 * n + (i & 3); }

struct Unit { int pm, pn; };
struct Gemm { const bf16_t* A; const bf16_t* Bt; int M, N, K; };

struct StaticOrder {
    int nM, nN, nwg, G, c;
    __host__ __device__ void init(int M, int N, int G_, int c_) { nM = M / BM; nN = N / BM; nwg = nM * nN; G = G_; c = c_; }
    __host__ __device__ bool next(int i, Unit& u) const {
        const long L = (long)i * G + c; if (L >= nwg) return false;
        int wgid = (int)L; { const int q = nwg / NXCD, r = nwg % NXCD, xcd = wgid % NXCD, off = wgid / NXCD; wgid = (xcd < r ? xcd * (q + 1) : r * (q + 1) + (xcd - r) * q) + off; }
        const int nig = WGM * nN, gid = wgid / nig, fm = gid * WGM, gsz = (nM - fm) < WGM ? (nM - fm) : WGM;
        u.pm = fm + ((wgid % nig) % gsz); u.pn = (wgid % nig) / gsz; return true;
    }
    __device__ __forceinline__ void a_ready(const Unit&) const {}
    __device__ __forceinline__ void done(const Unit&) const {}
};
__device__ __forceinline__ unsigned cvt_pk_bf16(float lo, float hi) { typedef __bf16 bf16pair_ __attribute__((ext_vector_type(2))); const bf16pair_ v = {(__bf16)lo, (__bf16)hi}; return __builtin_bit_cast(unsigned, v); }
typedef float f32x2 __attribute__((ext_vector_type(2)));
template <class Epi, class Sched, bool ALIGN_EPI = false, bool SP2 = false>
__device__ __forceinline__ void gemm_phase(PG8_LAS unsigned char* lds, const Gemm g, const Sched& S, const Epi& E, int tid_in) {
    int tid_l = tid_in; asm volatile("" : "+v"(tid_l));
    const int tid = tid_l, wid = __builtin_amdgcn_readfirstlane(tid >> 6), lane = tid & 63, wr = wid >> 2, wc = wid & 3, fr = lane & 15, fq = lane >> 4;
    const int K = g.K, nt = K / BK;
    unsigned voffA[2], voffB[2];
#pragma unroll
    for (int i = 0; i < 2; ++i) { int R, C; stage_rc(tid * 16 + i * 8192, R, C); const int Rb = Epi::PERM ? ((R & ~31) + perm32(R & 31)) : R;
        voffA[i] = (unsigned)(R * K + C) * 2u; voffB[i] = (unsigned)(Rb * K + C) * 2u; }
    const size_t kstep = (size_t)(BK * 2);
    const size_t hstep = (size_t)HALF * K * 2;
    const size_t tstep = 2 * hstep;
    const unsigned ldsw = (unsigned)wid * 1024u;
    const int aoff = lds_byte(wr * 64 + fr, fq * 8), boff = lds_byte(wc * 32 + fr, fq * 8);
#define PG8_SA(b, h) (((b) * 2 + (h)) * HTB)
#define PG8_SB(b, h) ((4 + (b) * 2 + (h)) * HTB)
#define PG8_STAGE(bufoff, gbase, voff) do { _Pragma("unroll") for (int _i = 0; _i < 2; ++_i) \
        __builtin_amdgcn_global_load_lds((const unsigned*)((const char*)(gbase) + (voff)[_i]), (PG8_LAS unsigned*)(lds + (bufoff) + ldsw + _i * 8192), 16, 0, 0); } while (0)
#define PG8_LDA(dst, b, h) do { _Pragma("unroll") for (int m = 0; m < 4; ++m) _Pragma("unroll") for (int k = 0; k < 2; ++k) dst[m][k] = *(const PG8_LAS bf16x8*)(lds + PG8_SA(b, h) + aoff + m * 2048 + k * 1024); } while (0)
#define PG8_LDB(dst, b, h) do { _Pragma("unroll") for (int n = 0; n < 2; ++n) _Pragma("unroll") for (int k = 0; k < 2; ++k) dst[n][k] = *(const PG8_LAS bf16x8*)(lds + PG8_SB(b, h) + boff + n * 2048 + k * 1024); } while (0)
#define PG8_MMA(ai, bj, At, Bt) do { __builtin_amdgcn_s_setprio(1); _Pragma("unroll") for (int m = 0; m < 4; ++m) _Pragma("unroll") for (int n = 0; n < 2; ++n) _Pragma("unroll") for (int k = 0; k < 2; ++k) \
        acc[ai][bj][m][n] = __builtin_amdgcn_mfma_f32_16x16x32_bf16(Bt[n][k], At[m][k], acc[ai][bj][m][n], 0, 0, 0); __builtin_amdgcn_s_setprio(0); } while (0)
#define PG8_WAIT_V(n) asm volatile("s_waitcnt vmcnt(" #n ")" ::: "memory")
#define PG8_WAIT_L(n) asm volatile("s_waitcnt lgkmcnt(" #n ")" ::: "memory")
#define PG8_BAR __builtin_amdgcn_s_barrier()
#define PG8_SCHED __builtin_amdgcn_sched_barrier(0)
    Unit cur, nxt; int ui = 0;
    if (!S.next(0, cur)) return;
    f32x4 acc[2][2][4][2];
#pragma unroll
    for (int a = 0; a < 2; ++a)
#pragma unroll
        for (int b = 0; b < 2; ++b)
#pragma unroll
            for (int m = 0; m < 4; ++m)
#pragma unroll
                for (int n = 0; n < 2; ++n) acc[a][b][m][n] = (f32x4){0.f, 0.f, 0.f, 0.f};
    bf16x8 At[4][2], B0[2][2], B1[2][2];
    const char* cA = (const char*)g.A + (size_t)cur.pm * tstep; const char* cB = (const char*)g.Bt + (size_t)cur.pn * tstep;
    S.a_ready(cur);
    if constexpr (SP2) {
        PG8_STAGE(PG8_SB(0, 0), cB, voffB); PG8_STAGE(PG8_SB(0, 1), cB + hstep, voffB); PG8_STAGE(PG8_SA(0, 0), cA, voffA); PG8_STAGE(PG8_SA(0, 1), cA + hstep, voffA);
        if (wr == 1) PG8_BAR;
        PG8_WAIT_V(2); PG8_BAR;
        PG8_STAGE(PG8_SB(1, 0), cB + kstep, voffB); PG8_STAGE(PG8_SA(1, 0), cA + kstep, voffA); PG8_STAGE(PG8_SB(1, 1), cB + hstep + kstep, voffB);
        PG8_WAIT_V(6); PG8_BAR;
    } else {
        PG8_STAGE(PG8_SB(0, 0), cB, voffB); PG8_STAGE(PG8_SA(0, 0), cA, voffA); PG8_STAGE(PG8_SB(0, 1), cB + hstep, voffB); PG8_STAGE(PG8_SA(0, 1), cA + hstep, voffA);
        if (wr == 1) PG8_BAR;
        PG8_WAIT_V(4); PG8_BAR;
        PG8_STAGE(PG8_SB(1, 0), cB + kstep, voffB); PG8_STAGE(PG8_SA(1, 0), cA + kstep, voffA); PG8_STAGE(PG8_SB(1, 1), cB + hstep + kstep, voffB);
        PG8_WAIT_V(6); PG8_BAR;
    }
    for (;;) {
        const bool has_next = S.next(ui + 1, nxt);
        const char* nA = has_next ? (const char*)g.A + (size_t)nxt.pm * tstep : cA; const char* nB = has_next ? (const char*)g.Bt + (size_t)nxt.pn * tstep : cB;
        for (int t = 0; t < nt; t += 2) {
            const bool last = (t == nt - 2);
            const char* a1 = cA + (size_t)(t + 1) * kstep;
            const char* a2 = last ? nA : cA + (size_t)(t + 2) * kstep; const char* b2 = last ? nB : cB + (size_t)(t + 2) * kstep;
            const char* a3 = a2 + kstep; const char* b3 = b2 + kstep;
            if (last && has_next) S.a_ready(nxt);
            if constexpr (SP2) {
            PG8_LDB(B0, 0, 0); PG8_LDB(B1, 0, 1); PG8_SCHED; PG8_LDA(At, 0, 0); PG8_STAGE(PG8_SA(1, 1), a1 + hstep, voffA);
            PG8_WAIT_V(8); PG8_WAIT_L(0); PG8_BAR; PG8_MMA(0, 0, At, B0); PG8_MMA(0, 1, At, B1); PG8_BAR; PG8_SCHED;
            PG8_LDA(At, 0, 1); PG8_STAGE(PG8_SB(0, 0), b2, voffB); PG8_STAGE(PG8_SB(0, 1), b2 + hstep, voffB); PG8_STAGE(PG8_SA(0, 0), a2, voffA);
            PG8_WAIT_V(8); PG8_WAIT_L(0); PG8_BAR; PG8_MMA(1, 0, At, B0); PG8_MMA(1, 1, At, B1); PG8_BAR; PG8_SCHED;
            PG8_LDB(B0, 1, 0); PG8_LDB(B1, 1, 1); PG8_SCHED; PG8_LDA(At, 1, 0); PG8_STAGE(PG8_SA(0, 1), a2 + hstep, voffA);
            PG8_WAIT_V(8); PG8_WAIT_L(0); PG8_BAR; PG8_MMA(0, 0, At, B0); PG8_MMA(0, 1, At, B1); PG8_BAR; PG8_SCHED;
            PG8_LDA(At, 1, 1); PG8_STAGE(PG8_SB(1, 0), b3, voffB); PG8_STAGE(PG8_SB(1, 1), b3 + hstep, voffB); PG8_STAGE(PG8_SA(1, 0), a3, voffA);
            PG8_WAIT_V(8); PG8_WAIT_L(0); PG8_BAR; PG8_MMA(1, 0, At, B0); PG8_MMA(1, 1, At, B1); PG8_BAR; PG8_SCHED;
            } else {
            PG8_LDB(B0, 0, 0); PG8_SCHED; PG8_LDA(At, 0, 0); PG8_STAGE(PG8_SA(1, 1), a1 + hstep, voffA);
            PG8_WAIT_L(8); PG8_BAR; PG8_WAIT_L(0); PG8_MMA(0, 0, At, B0); PG8_BAR; PG8_SCHED;
            PG8_LDB(B1, 0, 1); PG8_STAGE(PG8_SB(0, 0), b2, voffB);
            PG8_BAR; PG8_WAIT_L(0); PG8_MMA(0, 1, At, B1); PG8_BAR;
            PG8_LDA(At, 0, 1); PG8_STAGE(PG8_SA(0, 0), a2, voffA);
            PG8_BAR; PG8_WAIT_L(0); PG8_MMA(1, 0, At, B0); PG8_BAR; PG8_SCHED;
            PG8_STAGE(PG8_SB(0, 1), b2 + hstep, voffB);
            PG8_WAIT_V(6); PG8_BAR; PG8_MMA(1, 1, At, B1); PG8_BAR;
            PG8_LDB(B0, 1, 0); PG8_SCHED; PG8_LDA(At, 1, 0); PG8_STAGE(PG8_SA(0, 1), a2 + hstep, voffA);
            PG8_WAIT_L(8); PG8_BAR; PG8_WAIT_L(0); PG8_MMA(0, 0, At, B0); PG8_BAR; PG8_SCHED;
            PG8_LDB(B1, 1, 1); PG8_STAGE(PG8_SB(1, 0), b3, voffB);
            PG8_BAR; PG8_WAIT_L(0); PG8_MMA(0, 1, At, B1); PG8_BAR;
            PG8_LDA(At, 1, 1); PG8_STAGE(PG8_SA(1, 0), a3, voffA);
            PG8_BAR; PG8_WAIT_L(0); PG8_MMA(1, 0, At, B0); PG8_BAR; PG8_SCHED;
            PG8_STAGE(PG8_SB(1, 1), b3 + hstep, voffB);
            PG8_WAIT_V(6); PG8_BAR; PG8_MMA(1, 1, At, B1); PG8_BAR;
            }
        }
        if constexpr (ALIGN_EPI) { if (wr == 0) PG8_BAR; }
        if constexpr (!Epi::AFTER_DRAIN) { unsigned o_ = ~0u; asm volatile("" : "+s"(o_)); const int l_ = (int)__builtin_amdgcn_mbcnt_hi(o_, __builtin_amdgcn_mbcnt_lo(o_, 0u));
            E(acc, cur, wr, wc, l_ & 15, l_ >> 4); S.done(cur); }
        if (!has_next) break;
        if (!E.keep_acc(cur)) {
#pragma unroll
        for (int a = 0; a < 2; ++a)
#pragma unroll
            for (int b = 0; b < 2; ++b)
#pragma unroll
                for (int m = 0; m < 4; ++m)
#pragma unroll
                    for (int n = 0; n < 2; ++n) acc[a][b][m][n] = (f32x4){0.f, 0.f, 0.f, 0.f};
        }
        cur = nxt; cA = nA; cB = nB; ++ui;
        if constexpr (ALIGN_EPI) { if (wr == 1) PG8_BAR; }
    }
    PG8_WAIT_V(0);
    if constexpr (!ALIGN_EPI) { if (wr == 0) PG8_BAR; }
    PG8_BAR;
    if constexpr (Epi::AFTER_DRAIN) { E.fused(acc, cur, wr, wc, fr, fq, lds, wid, lane); S.done(cur); }
#undef PG8_SA
#undef PG8_SB
#undef PG8_STAGE
#undef PG8_LDA
#undef PG8_LDB
#undef PG8_MMA
#undef PG8_WAIT_V
#undef PG8_WAIT_L
#undef PG8_BAR
#undef PG8_SCHED
}
}

#ifndef MK_N_LAUNCHES
#define MK_N_LAUNCHES 1
#endif
#ifndef MK_REPEAT
#define MK_REPEAT 0
#endif
#ifndef MK_PROBE
#define MK_PROBE 0
#endif
#ifndef MK_PROBE_DIV
#define MK_PROBE_DIV 1
#endif
#ifndef MK_SKIP
#define MK_SKIP 0
#endif
constexpr int NB = 8, SEQ = 8192, DM = 1024, NL = 2, BW = 256, DFF = 4096;
constexpr int M_ALL = NB * SEQ;
constexpr int NGRP = 2, GB = NB / NGRP;
constexpr int MG = GB * SEQ;
constexpr int N_IN = 7124, NV = 7168, ZLD = 3072, GLD = 4096;
constexpr int NCH = SEQ / 64;
constexpr float EPS = 1e-6f;
constexpr int ZA_VAL = 0, ZA_GATE = 256, ZB_Q = 512, ZB_K = 768, ZB_V = 832, ZB_QI = 896, ZB_KI = 1152, ZB_WI = 1216;
constexpr int ZC_Q = 1224, ZC_K = 1352, ZC_V = 1480, ZC_OG = 1736, ZC_GLR = 1992, ZD_F = 2008, ZD_Q = 2264, ZD_I = 2520, ZD_OG = 2776;
__host__ __device__ __forceinline__ int win_src(int j) { if (j < 1220) return j; if (j < 1224) return -1; if (j < 3032) return j - 4; if (j < 3072) return -1;
    const int gi = j - 3072, q = gi >> 8, t = gi & 255; const int nbr = 2 * (t >> 7) + ((t >> 2) & 1), x = ((t >> 5) & 3) * 16 + ((t >> 3) & 3) * 4 + (t & 3);
    return 3028 + nbr * 1024 + 64 * q + x; }

constexpr size_t MiB = 1u << 20;
constexpr size_t WS_CTL = 0, CTL_ZERO_BYTES = 1 * MiB;
constexpr size_t WS_CMOD = 1 * MiB;
constexpr size_t WS_ROPE = 1 * MiB + 512 * 1024;
constexpr size_t WS_WIN = 4 * MiB;
constexpr size_t WS_WBO = 32 * MiB;
constexpr size_t WS_WO = 36 * MiB;
constexpr size_t WS_W1 = 40 * MiB;
constexpr size_t WS_W2 = 56 * MiB;
constexpr size_t WS_H = 76 * MiB;
constexpr size_t WS_Z = 204 * MiB;
constexpr size_t WS_GATES = 396 * MiB;
constexpr size_t WS_YS = 652 * MiB;
constexpr size_t WS_MF32 = 716 * MiB;
constexpr size_t WS_STC = 844 * MiB;
constexpr size_t WS_STD = 860 * MiB;
constexpr size_t WS_DECC = 892 * MiB;
constexpr size_t WS_DECD = 893 * MiB;
constexpr size_t WS_U = 204 * MiB;
constexpr size_t WS_KIT = 896 * MiB;
constexpr size_t WS_END = 900 * MiB;
constexpr int CW_BAR = 4096;

constexpr int NWAVES = 8, NTHREADS = 512;
constexpr int LDS_BYTES = 163840, MISC_OFF = LDS_BYTES - 512;

#define GAS __attribute__((address_space(1)))
#define LAS __attribute__((address_space(3)))
typedef unsigned short bf16;
typedef unsigned v4u __attribute__((ext_vector_type(4)));
typedef unsigned v2u __attribute__((ext_vector_type(2)));
typedef float f32x4 __attribute__((ext_vector_type(4)));
typedef short bf16x8 __attribute__((ext_vector_type(8)));
typedef float f32x16 __attribute__((ext_vector_type(16)));
#define LDS_WAIT() asm volatile("s_waitcnt lgkmcnt(0)" ::: "memory")
#define VM_WAIT() asm volatile("s_waitcnt vmcnt(0)" ::: "memory")
__device__ __forceinline__ float bf2f(unsigned v) { return __uint_as_float(v << 16); }
__device__ __forceinline__ float bflo(unsigned w) { return __uint_as_float(w << 16); }
__device__ __forceinline__ float bfhi(unsigned w) { return __uint_as_float(w & 0xffff0000u); }
typedef __bf16 bf16pair_t __attribute__((ext_vector_type(2)));
__device__ __forceinline__ unsigned pk2(float lo, float hi) { const bf16pair_t v = {(__bf16)lo, (__bf16)hi}; return __builtin_bit_cast(unsigned, v); }
__device__ __forceinline__ unsigned f2bf(float f) { return (unsigned)__builtin_bit_cast(unsigned short, (__bf16)f); }
template <int M> __device__ __forceinline__ float swz_xor(float v) { return __builtin_bit_cast(float, __builtin_amdgcn_ds_swizzle(__builtin_bit_cast(int, v), 0x1F | (M << 10))); }
__device__ __forceinline__ float half_sum(float v) { const unsigned u = __builtin_bit_cast(unsigned, v); auto r = __builtin_amdgcn_permlane32_swap(u, u, false, false);
    return __builtin_bit_cast(float, (unsigned)r[0]) + __builtin_bit_cast(float, (unsigned)r[1]); }
__device__ __forceinline__ float half_max(float v) { const unsigned u = __builtin_bit_cast(unsigned, v); auto r = __builtin_amdgcn_permlane32_swap(u, u, false, false);
    return fmaxf(__builtin_bit_cast(float, (unsigned)r[0]), __builtin_bit_cast(float, (unsigned)r[1])); }
__device__ __forceinline__ float wave_sum(float v) { v += swz_xor<1>(v); v += swz_xor<2>(v); v += swz_xor<4>(v); v += swz_xor<8>(v); v += swz_xor<16>(v); return half_sum(v); }
__device__ __forceinline__ float wave_max(float v) { v = fmaxf(v, swz_xor<1>(v)); v = fmaxf(v, swz_xor<2>(v)); v = fmaxf(v, swz_xor<4>(v)); v = fmaxf(v, swz_xor<8>(v)); v = fmaxf(v, swz_xor<16>(v)); return half_max(v); }
__device__ __forceinline__ float sigm(float x) { return __builtin_amdgcn_rcpf(1.0f + __expf(-x)); }
__device__ __forceinline__ float siluf(float x) { return x * sigm(x); }
__device__ __forceinline__ float logsigm(float x) { return fminf(x, 0.f) - __logf(1.0f + __expf(-fabsf(x))); }

#define XB_TMO      128
#define XB_XCNT(j)  (256  + 64 * (j))
#define XB_XSUB(j)  (1280 + 64 * (j))
#define XB_XGEN(j)  (2304 + 64 * (j))
#define XB_TOP      3328
#define XB_TOPGEN   3392
#define XCD_BAR_WORDS 3456
#define XB_SPIN_CAP (1u << 18)
__device__ __forceinline__ unsigned xb_ld(unsigned* p)              { return __hip_atomic_load(p, __ATOMIC_RELAXED, __HIP_MEMORY_SCOPE_AGENT); }
__device__ __forceinline__ unsigned xb_add(unsigned* p, unsigned v) { return __hip_atomic_fetch_add(p, v, __ATOMIC_RELAXED, __HIP_MEMORY_SCOPE_AGENT); }
__device__ __forceinline__ unsigned xb_xcc_id() { return (unsigned)__builtin_amdgcn_s_getreg((3 << 11) | 20) & 0xFu; }
#define XB_SPIN(cond, bar) do { unsigned _sp = 0; while (cond) { __builtin_amdgcn_s_sleep(1); \
    if ((++_sp & 255u) == 0u) { if (xb_ld(&(bar)[XB_TMO])) break; if (_sp > XB_SPIN_CAP) { atomicAdd(&(bar)[XB_TMO], 1u); break; } } } } while (0)
struct XcdBarrier { unsigned* bar; unsigned x; volatile LAS unsigned* st; };
__device__ __forceinline__ XcdBarrier xcd_barrier_post(unsigned* bar, volatile LAS unsigned* st) {
    XcdBarrier b; b.bar = bar; b.x = xb_xcc_id(); b.st = st;
    if (threadIdx.x == 0) (void)xb_add(&bar[XB_XCNT(b.x)], 1u);
    return b;
}
__device__ __forceinline__ void xcd_barrier_complete(unsigned* bar, unsigned x, unsigned& nloc, unsigned& nx) {
    const unsigned G = gridDim.x * gridDim.y * gridDim.z;
    unsigned sum, cnt, mine, sp = 0u;
    for (;;) {
        sum = 0u; cnt = 0u; mine = 0u;
#pragma unroll
        for (unsigned j = 0; j < 16; ++j) { const unsigned c = xb_ld(&bar[XB_XCNT(j)]); sum += c; cnt += (c > 0u) ? 1u : 0u; mine = (j == x) ? c : mine; }
        if (sum == G) break;
        __builtin_amdgcn_s_sleep(1);
        if ((++sp & 255u) == 0u) { if (xb_ld(&bar[XB_TMO])) break; if (sp > XB_SPIN_CAP) { atomicAdd(&bar[XB_TMO], 1u); break; } }
    }
    nloc = mine > 0u ? mine : 1u; nx = cnt > 0u ? cnt : 1u;
}
__device__ __forceinline__ void xcd_barrier(const XcdBarrier& b) {
    asm volatile("s_waitcnt vmcnt(0)" ::: "memory");
    __syncthreads();
    if (threadIdx.x == 0) {
        unsigned* bar = b.bar;
        __builtin_amdgcn_s_waitcnt(0);
        unsigned nloc = b.st[0], nx = b.st[1];
        if (nloc == 0u) { xcd_barrier_complete(bar, b.x, nloc, nx); b.st[0] = nloc; b.st[1] = nx; }
        const unsigned old = xb_add(&bar[XB_XSUB(b.x)], 1u);
        const unsigned gen = old / nloc;
        if (old + 1u == (gen + 1u) * nloc) {
            __builtin_amdgcn_fence(__ATOMIC_RELEASE, "agent");
            asm volatile("s_waitcnt vmcnt(0)" ::: "memory");
            const unsigned og = xb_add(&bar[XB_TOP], 1u);
            const unsigned tg = og / nx;
            if (og + 1u == (tg + 1u) * nx) xb_add(&bar[XB_TOPGEN], 1u);
            else XB_SPIN(xb_ld(&bar[XB_TOPGEN]) == tg, bar);
            __builtin_amdgcn_fence(__ATOMIC_ACQUIRE, "agent");
            xb_add(&bar[XB_XGEN(b.x)], 1u);
            asm volatile("s_waitcnt vmcnt(0)" ::: "memory");
        } else {
            XB_SPIN(xb_ld(&bar[XB_XGEN(b.x)]) == gen, bar);
            __builtin_amdgcn_fence(__ATOMIC_ACQUIRE, "agent");
            asm volatile("s_waitcnt vmcnt(0)" ::: "memory");
        }
    }
    __syncthreads();
}

struct EpiZ {
    static constexpr bool PERM = true, AFTER_DRAIN = false;
    __device__ __forceinline__ bool keep_acc(const pg8::Unit&) const { return false; }
    GAS bf16* Z; GAS bf16* Gt;
    __device__ __forceinline__ void operator()(const pg8::f32x4 (&acc)[2][2][4][2], const pg8::Unit& u, int wr, int wc, int fr_, int fq_) const {
        int fr = fr_, fq = fq_; asm volatile("" : "+v"(fr), "+v"(fq));
        if (u.pn < 12) {
            const int row0 = u.pm * 256 + wr * 64 + fr, col0 = u.pn * 256 + wc * 32 + 8 * fq;
#pragma unroll
            for (int ai = 0; ai < 2; ++ai)
#pragma unroll
                for (int m = 0; m < 4; ++m) { GAS bf16* rowp = Z + (size_t)(row0 + ai * 128 + m * 16) * ZLD + col0;
#pragma unroll
                    for (int bj = 0; bj < 2; ++bj) { const pg8::f32x4 v0 = acc[ai][bj][m][0], v1 = acc[ai][bj][m][1];
                        pg8::u32x4 w; w.x = pg8::cvt_pk_bf16(v0[0], v0[1]); w.y = pg8::cvt_pk_bf16(v0[2], v0[3]); w.z = pg8::cvt_pk_bf16(v1[0], v1[1]); w.w = pg8::cvt_pk_bf16(v1[2], v1[3]);
                        __builtin_nontemporal_store(w, (GAS pg8::u32x4*)(rowp + bj * 128)); } }
        } else {
            const int tid = (wr * 4 + wc) * 64 + fq * 16 + fr;
            GAS unsigned char* tb = (GAS unsigned char*)Gt + (size_t)(u.pm * 16 + (u.pn - 12)) * 131072 + tid * 8;
#pragma unroll
            for (int ai = 0; ai < 2; ++ai)
#pragma unroll
                for (int m = 0; m < 4; ++m) { float p0[4], p1[4], p2[4], p3[4];
#pragma unroll
                    for (int j = 0; j < 4; ++j) {
                        const float d0 = fminf(1.0f + __expf(-acc[ai][0][m][0][j]), 1e30f), d1 = fminf(1.0f + __expf(-acc[ai][0][m][1][j]), 1e30f);
                        const float d2 = fminf(1.0f + __expf(-acc[ai][1][m][0][j]), 1e30f), d3 = fminf(1.0f + __expf(-acc[ai][1][m][1][j]), 1e30f);
                        const float i0 = __builtin_amdgcn_rcpf(d0), i1 = __builtin_amdgcn_rcpf(d1), i2 = __builtin_amdgcn_rcpf(d2), i3 = __builtin_amdgcn_rcpf(d3);
                        p0[j] = d1 * i0; p1[j] = d2 * i1; p2[j] = d3 * i2; p3[j] = i3; }
                    GAS unsigned char* cb = tb + (ai * 4 + m) * 4096;
                    __builtin_nontemporal_store((v2u){pg8::cvt_pk_bf16(p0[0], p0[1]), pg8::cvt_pk_bf16(p0[2], p0[3])}, (GAS v2u*)(cb));
                    __builtin_nontemporal_store((v2u){pg8::cvt_pk_bf16(p1[0], p1[1]), pg8::cvt_pk_bf16(p1[2], p1[3])}, (GAS v2u*)(cb + 32768));
                    __builtin_nontemporal_store((v2u){pg8::cvt_pk_bf16(p2[0], p2[1]), pg8::cvt_pk_bf16(p2[2], p2[3])}, (GAS v2u*)(cb + 2 * 32768));
                    __builtin_nontemporal_store((v2u){pg8::cvt_pk_bf16(p3[0], p3[1]), pg8::cvt_pk_bf16(p3[2], p3[3])}, (GAS v2u*)(cb + 3 * 32768)); }
        }
    }
};
struct EpiGated {
    static constexpr bool PERM = true, AFTER_DRAIN = false;
    const GAS bf16* Gt; GAS bf16* Mo;
    __device__ __forceinline__ bool keep_acc(const pg8::Unit& u) const { return (u.pn >> 2) < 3; }
    __device__ __forceinline__ void operator()(pg8::f32x4 (&acc)[2][2][4][2], const pg8::Unit& u, int wr, int wc, int fr_, int fq_) const {
        int fr = fr_, fq = fq_; asm volatile("" : "+v"(fr), "+v"(fq));
        const int nb = u.pn >> 2;
        const int row0 = (u.pm - nb * (MG / 256)) * 256 + wr * 64 + fr, col0 = (u.pn & 3) * 256 + wc * 32 + 8 * fq;
        const int tz = (wr * 4 + 2 * (wc & 1) + (fq >> 1)) * 64 + (2 * (fq & 1)) * 16 + fr;
        const GAS unsigned char* tb = (const GAS unsigned char*)Gt + ((size_t)((u.pm - nb * (MG / 256)) * 16 + 4 * (u.pn & 3) + (wc >> 1)) * 4 + nb) * 32768 + tz * 8;
        v2u gf[2][4][2][2];
#pragma unroll
        for (int ai = 0; ai < 2; ++ai)
#pragma unroll
            for (int m = 0; m < 4; ++m)
#pragma unroll
                for (int bj = 0; bj < 2; ++bj)
#pragma unroll
                    for (int n = 0; n < 2; ++n) gf[ai][m][bj][n] = *(const GAS v2u*)(tb + (unsigned)(bj * (2 * 131072) + (ai * 4 + m) * 4096 + n * 128));
#pragma unroll
        for (int ai = 0; ai < 2; ++ai)
#pragma unroll
            for (int m = 0; m < 4; ++m) { const unsigned r = (unsigned)(row0 + ai * 128 + m * 16);
#pragma unroll
                for (int bj = 0; bj < 2; ++bj) {
                    pg8::f32x4 v0 = acc[ai][bj][m][0], v1 = acc[ai][bj][m][1];
                    const v2u a0 = gf[ai][m][bj][0], a1 = gf[ai][m][bj][1];
                    v0[0] *= bflo(a0.x); v0[1] *= bfhi(a0.x); v0[2] *= bflo(a0.y); v0[3] *= bfhi(a0.y); v1[0] *= bflo(a1.x); v1[1] *= bfhi(a1.x); v1[2] *= bflo(a1.y); v1[3] *= bfhi(a1.y);
                    if (nb < 3) { acc[ai][bj][m][0] = v0; acc[ai][bj][m][1] = v1; }
                    else { const unsigned c = (unsigned)(col0 + bj * 128); v4u o; o.x = pg8::cvt_pk_bf16(v0[0], v0[1]); o.y = pg8::cvt_pk_bf16(v0[2], v0[3]); o.z = pg8::cvt_pk_bf16(v1[0], v1[1]); o.w = pg8::cvt_pk_bf16(v1[2], v1[3]);
                        *(GAS v4u*)(Mo + (r * 1024u + c)) = o; } } }
    }
};
template <bool BASE_F32> struct EpiResid {
    static constexpr bool PERM = true, AFTER_DRAIN = false;
    __device__ __forceinline__ bool keep_acc(const pg8::Unit&) const { return false; }
    const GAS void* base; GAS bf16* out; const GAS float* gv;
    __device__ __forceinline__ void operator()(const pg8::f32x4 (&acc)[2][2][4][2], const pg8::Unit& u, int wr, int wc, int fr_, int fq_) const {
        int fr = fr_, fq = fq_; asm volatile("" : "+v"(fr), "+v"(fq));
        const int row0 = u.pm * 256 + wr * 64 + fr, col0 = u.pn * 256 + wc * 32 + 8 * fq;
        const GAS float* gb = gv + (size_t)((u.pm * 256) / SEQ) * 6144 + col0;
        pg8::f32x4 g4[2][2];
#pragma unroll
        for (int bj = 0; bj < 2; ++bj)
#pragma unroll
            for (int n = 0; n < 2; ++n) g4[bj][n] = *(const GAS pg8::f32x4*)(gb + bj * 128 + n * 4);
        if constexpr (BASE_F32) {
#pragma unroll
            for (int ai = 0; ai < 2; ++ai) { pg8::f32x4 bs[4][2][2];
#pragma unroll
                for (int m = 0; m < 4; ++m) { const size_t off = (size_t)(row0 + ai * 128 + m * 16) * 1024 + col0;
#pragma unroll
                    for (int bj = 0; bj < 2; ++bj) { bs[m][bj][0] = *(const GAS pg8::f32x4*)((const GAS float*)base + off + bj * 128); bs[m][bj][1] = *(const GAS pg8::f32x4*)((const GAS float*)base + off + bj * 128 + 4); } }
                asm volatile("" ::: "memory");
#pragma unroll
                for (int m = 0; m < 4; ++m) { const size_t off = (size_t)(row0 + ai * 128 + m * 16) * 1024 + col0;
#pragma unroll
                    for (int bj = 0; bj < 2; ++bj) { const pg8::f32x4 v0 = bs[m][bj][0] + g4[bj][0] * acc[ai][bj][m][0], v1 = bs[m][bj][1] + g4[bj][1] * acc[ai][bj][m][1];
                        v4u o; o.x = pg8::cvt_pk_bf16(v0[0], v0[1]); o.y = pg8::cvt_pk_bf16(v0[2], v0[3]); o.z = pg8::cvt_pk_bf16(v1[0], v1[1]); o.w = pg8::cvt_pk_bf16(v1[2], v1[3]);
                        *(GAS v4u*)(out + off + bj * 128) = o; } }
                asm volatile("" ::: "memory"); }
        } else {
#pragma unroll
            for (int ai = 0; ai < 2; ++ai) { v4u bw[4][2];
#pragma unroll
                for (int m = 0; m < 4; ++m) { const size_t off = (size_t)(row0 + ai * 128 + m * 16) * 1024 + col0;
#pragma unroll
                    for (int bj = 0; bj < 2; ++bj) bw[m][bj] = *(const GAS v4u*)((const GAS bf16*)base + off + bj * 128); }
                asm volatile("" ::: "memory");
#pragma unroll
                for (int m = 0; m < 4; ++m) { const size_t off = (size_t)(row0 + ai * 128 + m * 16) * 1024 + col0;
#pragma unroll
                    for (int bj = 0; bj < 2; ++bj) { const v4u w = bw[m][bj];
                        const pg8::f32x4 b0 = (pg8::f32x4){bflo(w.x), bfhi(w.x), bflo(w.y), bfhi(w.y)}, b1 = (pg8::f32x4){bflo(w.z), bfhi(w.z), bflo(w.w), bfhi(w.w)};
                        const pg8::f32x4 v0 = b0 + g4[bj][0] * acc[ai][bj][m][0], v1 = b1 + g4[bj][1] * acc[ai][bj][m][1];
                        v4u o; o.x = pg8::cvt_pk_bf16(v0[0], v0[1]); o.y = pg8::cvt_pk_bf16(v0[2], v0[3]); o.z = pg8::cvt_pk_bf16(v1[0], v1[1]); o.w = pg8::cvt_pk_bf16(v1[2], v1[3]);
                        *(GAS v4u*)(out + off + bj * 128) = o; } }
                asm volatile("" ::: "memory"); }
        }
    }
};
struct EpiRelu2 {
    static constexpr bool PERM = true, AFTER_DRAIN = false;
    __device__ __forceinline__ bool keep_acc(const pg8::Unit&) const { return false; }
    GAS bf16* O;
    __device__ __forceinline__ void operator()(const pg8::f32x4 (&acc)[2][2][4][2], const pg8::Unit& u, int wr, int wc, int fr_, int fq_) const {
        int fr = fr_, fq = fq_; asm volatile("" : "+v"(fr), "+v"(fq));
        const int row0 = u.pm * 256 + wr * 64 + fr, col0 = u.pn * 256 + wc * 32 + 8 * fq;
#pragma unroll
        for (int ai = 0; ai < 2; ++ai)
#pragma unroll
            for (int m = 0; m < 4; ++m) { GAS bf16* rowp = O + (size_t)(row0 + ai * 128 + m * 16) * DFF + col0;
#pragma unroll
                for (int bj = 0; bj < 2; ++bj) { pg8::f32x4 v0 = acc[ai][bj][m][0], v1 = acc[ai][bj][m][1];
#pragma unroll
                    for (int j = 0; j < 4; ++j) { const float a = fmaxf(v0[j], 0.f), b = fmaxf(v1[j], 0.f); v0[j] = a * a; v1[j] = b * b; }
                    pg8::u32x4 w; w.x = pg8::cvt_pk_bf16(v0[0], v0[1]); w.y = pg8::cvt_pk_bf16(v0[2], v0[3]); w.z = pg8::cvt_pk_bf16(v1[0], v1[1]); w.w = pg8::cvt_pk_bf16(v1[2], v1[3]);
                    __builtin_nontemporal_store(w, (GAS pg8::u32x4*)(rowp + bj * 128)); } }
    }
};

template <bool MAPPED>
__device__ __forceinline__ void p0_item(const GAS float* W, int K, int ldw, GAS bf16* WT, LAS float* scr, int nblk, int item, int lane) {
    const int kb = item / nblk, nb = item % nblk, k0 = 64 * kb, n0 = 32 * nb;
    const int nv = n0 + (lane & 31); const int src = MAPPED ? win_src(nv) : nv;
    float wv_[32];
#pragma unroll
    for (int i = 0; i < 32; ++i) { const int kk = 2 * i + (lane >> 5); wv_[i] = (src >= 0) ? W[(size_t)(k0 + kk) * ldw + src] : 0.f; }
#pragma unroll
    for (int i = 0; i < 32; ++i) { const int kk = 2 * i + (lane >> 5); scr[kk * 33 + (lane & 31)] = wv_[i]; }
    LDS_WAIT(); asm volatile("" ::: "memory");
    const int c = lane & 7;
#pragma unroll
    for (int j = 0; j < 4; ++j) { const int n = (lane >> 3) + 8 * j; const LAS float* s = scr + (8 * c) * 33 + n;
        v4u o; o.x = pk2(s[0 * 33], s[1 * 33]); o.y = pk2(s[2 * 33], s[3 * 33]); o.z = pk2(s[4 * 33], s[5 * 33]); o.w = pk2(s[6 * 33], s[7 * 33]);
        *(GAS v4u*)(WT + (size_t)(n0 + n) * K + k0 + 8 * c) = o; }
    LDS_WAIT(); asm volatile("" ::: "memory");
}
__device__ __forceinline__ void p0_weights(const GAS float* w_in, const GAS float* w_bo, const GAS float* w_o, const GAS float* w1, const GAS float* w2, GAS unsigned char* ws, LAS unsigned char* lds, int gw, int NGW, int wave, int lane) {
    LAS float* scr = (LAS float*)(lds + wave * 8704);
    constexpr int I_IN = 16 * (NV / 32), I_BO = 4 * 32, I_O = 16 * 32, I_1 = 16 * 128, I_2 = 64 * 32;
    constexpr int NITEMS = NL * (I_IN + 4 * I_BO + I_O + I_1 + I_2);
    for (int it = gw; it < NITEMS; it += NGW) {
        int r = it;
        if (r < NL * I_IN) { const int l = r / I_IN; r -= l * I_IN; p0_item<true>(w_in + (size_t)l * 1024 * N_IN, 1024, N_IN, (GAS bf16*)(ws + WS_WIN) + (size_t)l * NV * 1024, scr, NV / 32, r, lane); continue; } r -= NL * I_IN;
        if (r < NL * 4 * I_BO) { const int ln = r / I_BO; r -= ln * I_BO; p0_item<false>(w_bo + (size_t)ln * 256 * 1024, 256, 1024, (GAS bf16*)(ws + WS_WBO) + (size_t)ln * 1024 * 256, scr, 32, r, lane); continue; } r -= NL * 4 * I_BO;
        if (r < NL * I_O) { const int l = r / I_O; r -= l * I_O; p0_item<false>(w_o + (size_t)l * 1024 * 1024, 1024, 1024, (GAS bf16*)(ws + WS_WO) + (size_t)l * 1024 * 1024, scr, 32, r, lane); continue; } r -= NL * I_O;
        if (r < NL * I_1) { const int l = r / I_1; r -= l * I_1; p0_item<false>(w1 + (size_t)l * 1024 * DFF, 1024, DFF, (GAS bf16*)(ws + WS_W1) + (size_t)l * DFF * 1024, scr, 128, r, lane); continue; } r -= NL * I_1;
        { const int l = r / I_2; r -= l * I_2; p0_item<false>(w2 + (size_t)l * DFF * 1024, DFF, 1024, (GAS bf16*)(ws + WS_W2) + (size_t)l * 1024 * DFF, scr, 32, r, lane); }
    }
}
__device__ __forceinline__ void p0_rope(GAS float* T, int gtid, int gstride) {
    for (int idx = gtid; idx < 16384 * 8; idx += gstride) {
        const int p = idx >> 3, j = idx & 7;
        const double inv = (j == 0) ? 1.0 : (j == 1) ? 0.19392274474868576 : (j == 2) ? 0.03760603093086393 : (j == 3) ? 0.007292664737217109 : (j == 4) ? 0.001414213562373095 :
                           (j == 5) ? 0.0002742481756762073 : (j == 6) ? 5.318295896944988e-05 : 1.031338537721246e-05;
        const double ang = (double)p * inv;
        const double n = __builtin_rint(ang * 0.15915494309189535);
        double r = __builtin_fma(-n, 6.283185307179586, ang); r = __builtin_fma(-n, 2.4492935982947064e-16, r);
        const double r2 = r * r;
        double s = 1.0, c = 1.0;
#pragma unroll
        for (int k = 14; k >= 1; --k) { s = 1.0 - r2 * s / (double)((2 * k) * (2 * k + 1)); c = 1.0 - r2 * c / (double)((2 * k - 1) * (2 * k)); }
        T[p * 16 + j] = (float)c; T[p * 16 + 8 + j] = (float)(r * s);
    }
}
__device__ __forceinline__ void p0_cmod(const GAS float* cin, const GAS float* ada_w, const GAS float* ada_b, GAS float* cmod, LAS unsigned char* lds, int vcu, int G, int tid, int wave, int lane) {
    LAS float* ca = (LAS float*)lds;
    LAS float* red = (LAS float*)(lds + 32768);
    for (int i = tid; i < 8192; i += NTHREADS) { const int b = i >> 10, k = i & 1023; const float v = cin[i]; ca[k * 8 + b] = siluf(v); }
    __syncthreads();
    for (int u = vcu; u < NL * 96; u += G) {
        const int l = u / 96, j0 = (u % 96) * 64;
        const GAS float* W = ada_w + (size_t)l * 1024 * 6144 + j0 + lane;
        float acc[8];
#pragma unroll
        for (int b = 0; b < 8; ++b) acc[b] = 0.f;
#pragma unroll 16
        for (int k = wave * 128; k < wave * 128 + 128; ++k) {
            const float wv = W[(size_t)k * 6144];
            const f32x4 c0 = *(const LAS f32x4*)(ca + k * 8), c1 = *(const LAS f32x4*)(ca + k * 8 + 4);
            acc[0] += c0[0] * wv; acc[1] += c0[1] * wv; acc[2] += c0[2] * wv; acc[3] += c0[3] * wv;
            acc[4] += c1[0] * wv; acc[5] += c1[1] * wv; acc[6] += c1[2] * wv; acc[7] += c1[3] * wv;
        }
#pragma unroll
        for (int b = 0; b < 8; ++b) red[(wave * 8 + b) * 64 + lane] = acc[b];
        __syncthreads();
        { const int b = tid >> 6, jj = tid & 63; float s = 0.f;
#pragma unroll
          for (int w = 0; w < 8; ++w) s += red[(w * 8 + b) * 64 + jj];
          cmod[((size_t)l * NB + b) * 6144 + j0 + jj] = s + ada_b[l * 6144 + j0 + jj]; }
        __syncthreads();
    }
}

template <bool IN_F32>
__device__ __forceinline__ void norm_rows(const GAS void* xin, GAS bf16* hout, const GAS float* gvec, const GAS float* cm  , int off_sh, int off_sc, int gw, int NGW, int lane) {
    const int WPB = NGW / NB;
    { const int bb = gw / WPB;
        const GAS float* cb = cm + (size_t)bb * 6144;
        float A[16], Bv[16];
#pragma unroll
        for (int hf = 0; hf < 2; ++hf)
#pragma unroll
            for (int q = 0; q < 2; ++q) { const int col = 512 * hf + 8 * lane + 4 * q;
                const f32x4 g4 = *(const GAS f32x4*)(gvec + col), sc4 = *(const GAS f32x4*)(cb + off_sc + col), sh4 = *(const GAS f32x4*)(cb + off_sh + col);
#pragma unroll
                for (int j = 0; j < 4; ++j) { A[8 * hf + 4 * q + j] = g4[j] * (sc4[j] + 1.0f); Bv[8 * hf + 4 * q + j] = sh4[j]; } }
        constexpr int RB = 4;
        auto finish_row = [&](const float (&v)[16], size_t m) {
            float ss = 0.f;
#pragma unroll
            for (int j = 0; j < 16; ++j) ss += v[j] * v[j];
            const float rr = __builtin_amdgcn_rsqf(wave_sum(ss) * (1.0f / DM) + EPS);
            GAS v4u* o16 = (GAS v4u*)(hout + m * DM);
#pragma unroll
            for (int hf = 0; hf < 2; ++hf) { float y[8];
#pragma unroll
                for (int j = 0; j < 8; ++j) y[j] = v[8 * hf + j] * rr * A[8 * hf + j] + Bv[8 * hf + j];
                v4u w; w.x = pk2(y[0], y[1]); w.y = pk2(y[2], y[3]); w.z = pk2(y[4], y[5]); w.w = pk2(y[6], y[7]); o16[64 * hf + lane] = w; } };
        int r = gw - bb * WPB;
#pragma unroll 1
        for (; r + (RB - 1) * WPB < SEQ; r += RB * WPB) {
            float v[RB][16];
#pragma unroll
            for (int k = 0; k < RB; ++k) { const size_t m = (size_t)bb * SEQ + r + k * WPB;
                if (IN_F32) { const GAS f32x4* xr = (const GAS f32x4*)((const GAS float*)xin + m * DM);
#pragma unroll
                    for (int hf = 0; hf < 2; ++hf)
#pragma unroll
                        for (int q = 0; q < 2; ++q) { const f32x4 t = xr[128 * hf + 2 * lane + q]; v[k][8 * hf + 4 * q] = t[0]; v[k][8 * hf + 4 * q + 1] = t[1]; v[k][8 * hf + 4 * q + 2] = t[2]; v[k][8 * hf + 4 * q + 3] = t[3]; } }
                else { const GAS v4u* xr = (const GAS v4u*)((const GAS bf16*)xin + m * DM);
#pragma unroll
                    for (int hf = 0; hf < 2; ++hf) { const v4u w = xr[64 * hf + lane];
                        v[k][8 * hf] = bflo(w.x); v[k][8 * hf + 1] = bfhi(w.x); v[k][8 * hf + 2] = bflo(w.y); v[k][8 * hf + 3] = bfhi(w.y); v[k][8 * hf + 4] = bflo(w.z); v[k][8 * hf + 5] = bfhi(w.z); v[k][8 * hf + 6] = bflo(w.w); v[k][8 * hf + 7] = bfhi(w.w); } } }
            asm volatile("" ::: "memory");
#pragma unroll
            for (int k = 0; k < RB; ++k) finish_row(v[k], (size_t)bb * SEQ + r + k * WPB);
        }
#pragma unroll 1
        for (; r < SEQ; r += WPB) {
            const size_t m = (size_t)bb * SEQ + r; float v[16];
            if (IN_F32) { const GAS f32x4* xr = (const GAS f32x4*)((const GAS float*)xin + m * DM);
#pragma unroll
                for (int hf = 0; hf < 2; ++hf)
#pragma unroll
                    for (int q = 0; q < 2; ++q) { const f32x4 t = xr[128 * hf + 2 * lane + q]; v[8 * hf + 4 * q] = t[0]; v[8 * hf + 4 * q + 1] = t[1]; v[8 * hf + 4 * q + 2] = t[2]; v[8 * hf + 4 * q + 3] = t[3]; } }
            else { const GAS v4u* xr = (const GAS v4u*)((const GAS bf16*)xin + m * DM);
#pragma unroll
                for (int hf = 0; hf < 2; ++hf) { const v4u w = xr[64 * hf + lane];
                    v[8 * hf] = bflo(w.x); v[8 * hf + 1] = bfhi(w.x); v[8 * hf + 2] = bflo(w.y); v[8 * hf + 3] = bfhi(w.y); v[8 * hf + 4] = bflo(w.z); v[8 * hf + 5] = bfhi(w.z); v[8 * hf + 6] = bflo(w.w); v[8 * hf + 7] = bfhi(w.w); } }
            finish_row(v, m);
        }
    }
}
__device__ __forceinline__ void final_norm_rows(const GAS bf16* xin, GAS float* xout, const GAS float* gvec, int gw, int NGW, int lane, float oscale) {
    float A[16];
#pragma unroll
    for (int hf = 0; hf < 2; ++hf)
#pragma unroll
        for (int q = 0; q < 2; ++q) { const f32x4 g4 = *(const GAS f32x4*)(gvec + 512 * hf + 8 * lane + 4 * q);
#pragma unroll
            for (int j = 0; j < 4; ++j) A[8 * hf + 4 * q + j] = g4[j]; }
    constexpr int RB = 4;
    auto finish_row = [&](const float (&v)[16], int m) {
        float ss = 0.f;
#pragma unroll
        for (int j = 0; j < 16; ++j) ss += v[j] * v[j];
        const float rr = __builtin_amdgcn_rsqf(wave_sum(ss) * (1.0f / DM) + EPS) * oscale;
        GAS f32x4* xo = (GAS f32x4*)(xout + (size_t)m * DM);
#pragma unroll
        for (int hf = 0; hf < 2; ++hf)
#pragma unroll
            for (int q = 0; q < 2; ++q) { f32x4 o;
#pragma unroll
                for (int j = 0; j < 4; ++j) o[j] = v[8 * hf + 4 * q + j] * rr * A[8 * hf + 4 * q + j];
                xo[128 * hf + 2 * lane + q] = o; } };
    auto load_row = [&](float (&v)[16], int m) { const GAS v4u* xr = (const GAS v4u*)(xin + (size_t)m * DM);
#pragma unroll
        for (int hf = 0; hf < 2; ++hf) { const v4u w = xr[64 * hf + lane];
            v[8 * hf] = bflo(w.x); v[8 * hf + 1] = bfhi(w.x); v[8 * hf + 2] = bflo(w.y); v[8 * hf + 3] = bfhi(w.y); v[8 * hf + 4] = bflo(w.z); v[8 * hf + 5] = bfhi(w.z); v[8 * hf + 6] = bflo(w.w); v[8 * hf + 7] = bfhi(w.w); } };
    int m = gw;
#pragma unroll 1
    for (; m + (RB - 1) * NGW < M_ALL; m += RB * NGW) { float v[RB][16];
#pragma unroll
        for (int k = 0; k < RB; ++k) load_row(v[k], m + k * NGW);
        asm volatile("" ::: "memory");
#pragma unroll
        for (int k = 0; k < RB; ++k) finish_row(v[k], m + k * NGW); }
#pragma unroll 1
    for (; m < M_ALL; m += NGW) { float v[16]; load_row(v, m); finish_row(v, m); }
}
__device__ __forceinline__ void copy_rows(const GAS float* xin, GAS bf16* xout, int gw, int NGW, int lane) {
    for (int m = gw; m < M_ALL; m += NGW) {
        const GAS f32x4* xr = (const GAS f32x4*)(xin + (size_t)m * DM) + lane; GAS v2u* xo = (GAS v2u*)(xout + (size_t)m * DM) + lane;
#pragma unroll
        for (int j = 0; j < 4; ++j) { const f32x4 t = xr[64 * j]; v2u w; w.x = pk2(t[0], t[1]); w.y = pk2(t[2], t[3]); xo[64 * j] = w; }
    }
}

__device__ __forceinline__ void rope_unit(GAS bf16* Z, GAS bf16* KIT, const GAS int* pos, const GAS float* T, int u, int tid) {
    const int blk = u / (MG / NTHREADS), row = (u % (MG / NTHREADS)) * NTHREADS + tid;
    int p = pos[row]; p = p < 0 ? 0 : (p > 16383 ? 16383 : p);
    const GAS f32x4* tp = (const GAS f32x4*)(T + (size_t)p * 16);
    const f32x4 c0 = tp[0], c1 = tp[1], s0 = tp[2], s1 = tp[3];
    const float cs[8] = {c0[0], c0[1], c0[2], c0[3], c1[0], c1[1], c1[2], c1[3]};
    const float sn[8] = {s0[0], s0[1], s0[2], s0[3], s1[0], s1[1], s1[2], s1[3]};
    const int col = (blk < 4) ? ZB_Q + 64 * blk : (blk == 4) ? ZB_K : (blk < 9) ? ZB_QI + 64 * (blk - 5) : ZB_KI;
    GAS v4u* ptr = (GAS v4u*)(Z + (size_t)row * ZLD + col);
    const v4u a = ptr[0], b = ptr[1];
    const unsigned aw[4] = {a.x, a.y, a.z, a.w}, bw[4] = {b.x, b.y, b.z, b.w};
    unsigned oa[4], ob[4];
#pragma unroll
    for (int q = 0; q < 4; ++q) {
        const float x1l = bflo(aw[q]), x1h = bfhi(aw[q]), x2l = bflo(bw[q]), x2h = bfhi(bw[q]);
        const float cl = cs[2 * q], ch = cs[2 * q + 1], sl = sn[2 * q], sh = sn[2 * q + 1];
        oa[q] = pk2(x1l * cl - x2l * sl, x1h * ch - x2h * sh);
        ob[q] = pk2(x1l * sl + x2l * cl, x1h * sh + x2h * ch);
    }
    if (blk == 9) {
        GAS v4u* kt = (GAS v4u*)((GAS unsigned char*)KIT + (size_t)(row >> 5) * 4096 + (row & 31) * 16);
        kt[0] = (v4u){oa[0], oa[1], oa[2], oa[3]}; kt[32] = (v4u){ob[0], ob[1], ob[2], ob[3]};
#pragma unroll
        for (int c = 2; c < 8; ++c) kt[(c >> 1) * 64 + (c & 1) * 32] = ptr[c];
    } else { ptr[0] = (v4u){oa[0], oa[1], oa[2], oa[3]}; ptr[1] = (v4u){ob[0], ob[1], ob[2], ob[3]}; }
}
__device__ __forceinline__ void conv_unit(const GAS bf16* Z, GAS bf16* YA, const GAS float* cw, const GAS float* cb, const GAS float* lng, const GAS float* lnb, LAS unsigned char* lds, int u, int tid, int wave, int lane) {
    LAS float* uL = (LAS float*)lds;
    LAS float* cv = (LAS float*)(lds + 62 * 256 * 4);
    const int b = u >> 8, blk = u & 255, t0 = blk * 32; const size_t growb = (size_t)b * SEQ;
    for (int e = tid; e < 62 * 256; e += NTHREADS) { const int tt = e >> 8, c = e & 255, t = t0 - 30 + tt; float val = 0.f;
        if (t >= 0) { const GAS bf16* zr = Z + (growb + t) * ZLD; val = bf2f(zr[ZA_VAL + c]) * sigm(bf2f(zr[ZA_GATE + c])); }
        uL[e] = val; }
    __syncthreads();
    { const int c = tid & 255, hf = tid >> 8; float w[31];
#pragma unroll
      for (int k = 0; k < 31; ++k) w[k] = cw[k * 256 + c];
      const float bias = cb[c];
#pragma unroll 1
      for (int tt = 0; tt < 16; ++tt) { const int tl = 16 * hf + tt; float acc = bias;
#pragma unroll
          for (int k = 0; k < 31; ++k) acc += uL[(tl + k) * 256 + c] * w[k];
          cv[tl * 256 + c] = acc; } }
    __syncthreads();
#pragma unroll
    for (int q = 0; q < 4; ++q) { const int tl = 4 * wave + q;
        const f32x4 x = *(const LAS f32x4*)(cv + tl * 256 + 4 * lane);
        const float mu = wave_sum((x[0] + x[1]) + (x[2] + x[3])) * (1.0f / 256.0f);
        const f32x4 d = x - mu;
        const float var = wave_sum((d[0] * d[0] + d[1] * d[1]) + (d[2] * d[2] + d[3] * d[3])) * (1.0f / 256.0f);
        const float rs = __builtin_amdgcn_rsqf(var + EPS);
        const f32x4 g4 = *(const GAS f32x4*)(lng + 4 * lane), b4 = *(const GAS f32x4*)(lnb + 4 * lane);
        f32x4 y = d * rs * g4 + b4;
        v2u o; o.x = pk2(siluf(y[0]), siluf(y[1])); o.y = pk2(siluf(y[2]), siluf(y[3]));
        *(GAS v2u*)(YA + (growb + t0 + tl) * 256 + 4 * lane) = o; }
    __syncthreads();
}

__device__ __forceinline__ void conv2_unit(const GAS bf16* Z, GAS bf16* YA, const GAS float* cw, const GAS float* cb, const GAS float* lng, const GAS float* lnb, LAS unsigned char* lds, int u, int wave) {
    unsigned ones_u = ~0u; asm volatile("" : "+s"(ones_u));
    const int lane = (int)__builtin_amdgcn_mbcnt_hi(ones_u, __builtin_amdgcn_mbcnt_lo(ones_u, 0u));
    const int tid = wave * 64 + lane;
    LAS bf16* uH = (LAS bf16*)lds;
    LAS unsigned* uW = (LAS unsigned*)lds;
    LAS float* cv = (LAS float*)(lds + 47 * 256 * 4);
    const int b = u >> 7, blk = u & 127, t0 = blk * 64; const size_t growb = (size_t)b * SEQ;
    for (int e = tid; e < 94 * 32; e += NTHREADS) { const int tt = e >> 5, ch = e & 31, t = t0 - 30 + tt;
        v4u vw = {0u, 0u, 0u, 0u}, gw = {0u, 0u, 0u, 0u};
        if (t >= 0) { const GAS bf16* zr = Z + (growb + t) * ZLD; vw = *(const GAS v4u*)(zr + ZA_VAL + 8 * ch); gw = *(const GAS v4u*)(zr + ZA_GATE + 8 * ch); }
        const unsigned va[4] = {vw.x, vw.y, vw.z, vw.w}, ga[4] = {gw.x, gw.y, gw.z, gw.w};
        LAS bf16* dst = uH + ((tt >> 1) * 256 + 8 * ch) * 2 + (tt & 1);
#pragma unroll
        for (int j = 0; j < 8; ++j) { const float v = (j & 1) ? bfhi(va[j >> 1]) : bflo(va[j >> 1]), g = (j & 1) ? bfhi(ga[j >> 1]) : bflo(ga[j >> 1]);
            dst[2 * j] = (bf16)f2bf((t >= 0) ? v * sigm(g) : 0.f); } }
    __syncthreads();
    { const int c = tid & 255, hf = tid >> 8; float w[31];
#pragma unroll
      for (int k = 0; k < 31; ++k) w[k] = cw[k * 256 + c];
      const float bias = cb[c];
#pragma unroll 1
      for (int gq = 0; gq < 4; ++gq) { const int o0 = 32 * hf + 8 * gq;
          float acc[8];
#pragma unroll
          for (int o = 0; o < 8; ++o) acc[o] = bias;
#pragma unroll
          for (int kp = 0; kp < 19; ++kp) { const unsigned xw = uW[((o0 >> 1) + kp) * 256 + c];
              const float x0 = bflo(xw), x1 = bfhi(xw);
#pragma unroll
              for (int o = 0; o < 8; ++o) { const int k0 = 2 * kp - o, k1 = 2 * kp + 1 - o;
                  if (k0 >= 0 && k0 <= 30) acc[o] += x0 * w[k0];
                  if (k1 >= 0 && k1 <= 30) acc[o] += x1 * w[k1]; } }
#pragma unroll
          for (int o = 0; o < 8; ++o) cv[(o0 + o) * 256 + c] = acc[o]; } }
    __syncthreads();
#pragma unroll 2
    for (int q = 0; q < 8; ++q) { const int tl = 8 * wave + q;
        const f32x4 x = *(const LAS f32x4*)(cv + tl * 256 + 4 * lane);
        const float mu = wave_sum((x[0] + x[1]) + (x[2] + x[3])) * (1.0f / 256.0f);
        const f32x4 d = x - mu;
        const float var = wave_sum((d[0] * d[0] + d[1] * d[1]) + (d[2] * d[2] + d[3] * d[3])) * (1.0f / 256.0f);
        const float rs = __builtin_amdgcn_rsqf(var + EPS);
        const f32x4 g4 = *(const GAS f32x4*)(lng + 4 * lane), b4 = *(const GAS f32x4*)(lnb + 4 * lane);
        f32x4 y = d * rs * g4 + b4;
        v2u o; o.x = pk2(siluf(y[0]), siluf(y[1])); o.y = pk2(siluf(y[2]), siluf(y[3]));
        *(GAS v2u*)(YA + (growb + t0 + tl) * 256 + 4 * lane) = o; }
    __syncthreads();
}

struct LinPar { const GAS bf16* Z; const GAS float* gate_w; const GAS float* gate_b; const GAS float* lb_logits; int layer; };
constexpr int L_LF = 0, L_Q = 16384, L_K = 32768, L_V = 49152, L_QT = 65536, L_KT = 82944, L_QH = 100352, L_AT = 117760, L_S = 135168;
constexpr int TS = 68;
template <int DK>
__device__ __forceinline__ void lin_load(const LinPar& P, LAS unsigned char* lds, int b, int c, int h, int tid) {
    LAS float* gL = (LAS float*)(lds + L_LF); LAS float* qL = (LAS float*)(lds + L_Q); LAS float* kL = (LAS float*)(lds + L_K); LAS float* vL = (LAS float*)(lds + L_V);
    const int t = tid >> 3, part = tid & 7;
    const GAS bf16* zr = P.Z + ((size_t)b * SEQ + c * 64 + t) * ZLD;
    if (DK == 32) {
        const v2u qw = *(const GAS v2u*)(zr + ZC_Q + h * 32 + 4 * part), kw = *(const GAS v2u*)(zr + ZC_K + h * 32 + 4 * part);
        const float qs = 0.17677669529663687f;
        const float qv[4] = {bflo(qw.x) * qs, bfhi(qw.x) * qs, bflo(qw.y) * qs, bfhi(qw.y) * qs};
        const float kv[4] = {bflo(kw.x), bfhi(kw.x), bflo(kw.y), bfhi(kw.y)};
        const v4u g0 = *(const GAS v4u*)(zr + ZC_GLR), g1 = *(const GAS v4u*)(zr + ZC_GLR + 8);
        const unsigned gw[8] = {g0.x, g0.y, g0.z, g0.w, g1.x, g1.y, g1.z, g1.w};
        float a[4];
#pragma unroll
        for (int j = 0; j < 4; ++j) a[j] = P.gate_b[h * 32 + 4 * part + j];
#pragma unroll
        for (int r2 = 0; r2 < 8; ++r2) { const float x0 = bflo(gw[r2]), x1 = bfhi(gw[r2]);
            const f32x4 w0 = *(const GAS f32x4*)(P.gate_w + (2 * r2) * 128 + h * 32 + 4 * part), w1 = *(const GAS f32x4*)(P.gate_w + (2 * r2 + 1) * 128 + h * 32 + 4 * part);
#pragma unroll
            for (int j = 0; j < 4; ++j) a[j] += x0 * w0[j] + x1 * w1[j]; }
#pragma unroll
        for (int j = 0; j < 4; ++j) { const int d = 4 * part + j; gL[t * DK + d] = logsigm(a[j]) * (1.0f / 16.0f); qL[t * DK + d] = qv[j]; kL[t * DK + d] = kv[j]; }
        const v4u vw = *(const GAS v4u*)(zr + ZC_V + h * 64 + 8 * part);
        const unsigned vv[4] = {vw.x, vw.y, vw.z, vw.w};
#pragma unroll
        for (int j = 0; j < 4; ++j) { vL[t * 64 + 8 * part + 2 * j] = bflo(vv[j]); vL[t * 64 + 8 * part + 2 * j + 1] = bfhi(vv[j]); }
    } else {
        const v4u fw = *(const GAS v4u*)(zr + ZD_F + h * 64 + 8 * part), qw = *(const GAS v4u*)(zr + ZD_Q + h * 64 + 8 * part), iw = *(const GAS v4u*)(zr + ZD_I + h * 64 + 8 * part);
        const unsigned fa[4] = {fw.x, fw.y, fw.z, fw.w}, qa[4] = {qw.x, qw.y, qw.z, qw.w}, ia[4] = {iw.x, iw.y, iw.z, iw.w};
#pragma unroll
        for (int j = 0; j < 8; ++j) { const int d = 8 * part + j;
            const float zf = (j & 1) ? bfhi(fa[j >> 1]) : bflo(fa[j >> 1]), zq = (j & 1) ? bfhi(qa[j >> 1]) : bflo(qa[j >> 1]), zi = (j & 1) ? bfhi(ia[j >> 1]) : bflo(ia[j >> 1]);
            float lbv = 0.f;
            if (P.layer == 1) lbv = sigm(P.lb_logits[256 + h * 64 + d] - P.lb_logits[h * 64 + d]);
            const float sg = sigm(zf);
            const float f = lbv + (1.0f - lbv) * sg;
            gL[t * DK + d] = (P.layer == 0) ? logsigm(zf) : __logf(f);
            kL[t * DK + d] = (1.0f - lbv) * sigm(-zf);
            qL[t * DK + d] = siluf(zq);
            vL[t * 64 + d] = zi; }
    }
    __syncthreads();
    if (tid < DK) { float run = 0.f;
#pragma unroll 4
        for (int tt = 0; tt < 64; ++tt) { run += gL[tt * DK + tid]; gL[tt * DK + tid] = run; } }
    __syncthreads();
}
template <int DK>
__device__ __forceinline__ void lin_local_unit(const LinPar& P, GAS float* ST, GAS float* DEC, LAS unsigned char* lds, int u, int tid) {
    const int b = u / (NCH * 4), c = (u / 4) % NCH, h = u & 3;
    lin_load<DK>(P, lds, b, c, h, tid);
    LAS float* gL = (LAS float*)(lds + L_LF); LAS float* kL = (LAS float*)(lds + L_K); LAS float* vL = (LAS float*)(lds + L_V);
    for (int e = tid; e < 64 * DK; e += NTHREADS) { const int d = e % DK; kL[e] = kL[e] * __expf(gL[63 * DK + d] - gL[e]); }
    __syncthreads();
    constexpr int VPT = DK / 8, NVO = 64 / VPT;
    const int d = tid / NVO, vo = tid % NVO;
    float acc[VPT];
#pragma unroll
    for (int j = 0; j < VPT; ++j) acc[j] = 0.f;
#pragma unroll 4
    for (int t = 0; t < 64; ++t) { const float kk = kL[t * DK + d];
#pragma unroll
        for (int j = 0; j < VPT; ++j) acc[j] += kk * vL[t * 64 + vo * VPT + j]; }
    GAS float* so = ST + ((size_t)(b * NCH + c) * 4 + h) * DK * 64 + d * 64 + vo * VPT;
#pragma unroll
    for (int j = 0; j < VPT; ++j) so[j] = acc[j];
    if (tid < DK) DEC[(size_t)(b * NCH + c) * 4 * DK + h * DK + tid] = __expf(gL[63 * DK + tid]);
    __syncthreads();
}
__device__ __forceinline__ void scan_unit(GAS bf16* STC, GAS bf16* STD, const GAS float* DECC, const GAS float* DECD, int u, int tid) {
    if (tid >= 192) return;
    const int e = u * 192 + tid;
    GAS unsigned* sp; const GAS float* dp; size_t sstride, dstride;
    if (e < GB * 4096) { const int b = e / 4096, rem = e % 4096; sp = (GAS unsigned*)STC + (size_t)b * NCH * 4096 + rem; sstride = 4096; dp = DECC + (size_t)b * NCH * 128 + rem / 32; dstride = 128; }
    else { const int e2 = e - GB * 4096; const int b = e2 / 8192, rem = e2 % 8192; sp = (GAS unsigned*)STD + (size_t)b * NCH * 8192 + rem; sstride = 8192; dp = DECD + (size_t)b * NCH * 256 + rem / 32; dstride = 256; }
    float s0 = 0.f, s1 = 0.f;
#pragma unroll 1
    for (int c0 = 0; c0 < NCH; c0 += 16) {
        unsigned uu[16]; float dd[16];
#pragma unroll
        for (int i = 0; i < 16; ++i) { uu[i] = sp[(size_t)(c0 + i) * sstride]; dd[i] = dp[(size_t)(c0 + i) * dstride]; }
#pragma unroll
        for (int i = 0; i < 16; ++i) { sp[(size_t)(c0 + i) * sstride] = pk2(s0, s1); s0 = dd[i] * s0 + bflo(uu[i]); s1 = dd[i] * s1 + bfhi(uu[i]); }
    }
}
template <int DK>
__device__ __forceinline__ void lin_out_unit(const LinPar& P, const GAS float* ST, const GAS float* normg, GAS bf16* YS, LAS unsigned char* lds, int u, int tid) {
    const int b = u / (NCH * 4), c = (u / 4) % NCH, h = u & 3;
    lin_load<DK>(P, lds, b, c, h, tid);
    LAS float* gL = (LAS float*)(lds + L_LF); LAS float* qL = (LAS float*)(lds + L_Q); LAS float* kL = (LAS float*)(lds + L_K); LAS float* vL = (LAS float*)(lds + L_V);
    LAS float* qT = (LAS float*)(lds + L_QT); LAS float* kT = (LAS float*)(lds + L_KT); LAS float* qH = (LAS float*)(lds + L_QH); LAS float* aT = (LAS float*)(lds + L_AT); LAS float* sM = (LAS float*)(lds + L_S);
    for (int e = tid; e < 64 * DK; e += NTHREADS) { const int t = e / DK, d = e % DK;
        const float g = gL[e], r = gL[31 * DK + d], q = qL[e], k = kL[e];
        qT[d * TS + t] = q * __expf(fminf(g - r, 80.f)); kT[d * TS + t] = k * __expf(fminf(r - g, 80.f)); qH[d * TS + t] = q * __expf(g); }
    { const GAS float* sp = ST + ((size_t)(b * NCH + c) * 4 + h) * DK * 64;
      for (int e = tid; e < DK * 64; e += NTHREADS) sM[e] = sp[e]; }
    __syncthreads();
    const int i = tid >> 3, jo = tid & 7;
    { float a[8];
#pragma unroll
      for (int j = 0; j < 8; ++j) a[j] = 0.f;
#pragma unroll 4
      for (int d = 0; d < DK; ++d) { const float qv = qT[d * TS + i];
          const f32x4 k0 = *(const LAS f32x4*)(kT + d * TS + 8 * jo), k1 = *(const LAS f32x4*)(kT + d * TS + 8 * jo + 4);
          a[0] += qv * k0[0]; a[1] += qv * k0[1]; a[2] += qv * k0[2]; a[3] += qv * k0[3]; a[4] += qv * k1[0]; a[5] += qv * k1[1]; a[6] += qv * k1[2]; a[7] += qv * k1[3]; }
#pragma unroll
      for (int j = 0; j < 8; ++j) { const int jj = 8 * jo + j; aT[jj * TS + i] = (jj <= i) ? a[j] : 0.f; } }
    __syncthreads();
    { float o[8];
#pragma unroll
      for (int j = 0; j < 8; ++j) o[j] = 0.f;
#pragma unroll 4
      for (int j = 0; j < 64; ++j) { const float av = aT[j * TS + i];
          const f32x4 v0 = *(const LAS f32x4*)(vL + j * 64 + 8 * jo), v1 = *(const LAS f32x4*)(vL + j * 64 + 8 * jo + 4);
          o[0] += av * v0[0]; o[1] += av * v0[1]; o[2] += av * v0[2]; o[3] += av * v0[3]; o[4] += av * v1[0]; o[5] += av * v1[1]; o[6] += av * v1[2]; o[7] += av * v1[3]; }
#pragma unroll 4
      for (int d = 0; d < DK; ++d) { const float qv = qH[d * TS + i];
          const f32x4 s0 = *(const LAS f32x4*)(sM + d * 64 + 8 * jo), s1 = *(const LAS f32x4*)(sM + d * 64 + 8 * jo + 4);
          o[0] += qv * s0[0]; o[1] += qv * s0[1]; o[2] += qv * s0[2]; o[3] += qv * s0[3]; o[4] += qv * s1[0]; o[5] += qv * s1[1]; o[6] += qv * s1[2]; o[7] += qv * s1[3]; }
      float ss = 0.f;
#pragma unroll
      for (int j = 0; j < 8; ++j) ss += o[j] * o[j];
      ss += swz_xor<1>(ss); ss += swz_xor<2>(ss); ss += swz_xor<4>(ss);
      const float rs = __builtin_amdgcn_rsqf(ss * (1.0f / 64.0f) + EPS);
      const size_t grow = (size_t)b * SEQ + c * 64 + i;
      const v4u ogw = *(const GAS v4u*)(P.Z + grow * ZLD + (DK == 32 ? ZC_OG : ZD_OG) + h * 64 + 8 * jo);
      const unsigned oga[4] = {ogw.x, ogw.y, ogw.z, ogw.w};
      const f32x4 n0 = *(const GAS f32x4*)(normg + 8 * jo), n1 = *(const GAS f32x4*)(normg + 8 * jo + 4);
      const float ng[8] = {n0[0], n0[1], n0[2], n0[3], n1[0], n1[1], n1[2], n1[3]};
      float y[8];
#pragma unroll
      for (int j = 0; j < 8; ++j) { const float og = (j & 1) ? bfhi(oga[j >> 1]) : bflo(oga[j >> 1]); y[j] = o[j] * rs * ng[j] * siluf(og); }
      v4u w; w.x = pk2(y[0], y[1]); w.y = pk2(y[2], y[3]); w.z = pk2(y[4], y[5]); w.w = pk2(y[6], y[7]);
      *(GAS v4u*)(YS + grow * 256 + h * 64 + 8 * jo) = w; }
    __syncthreads();
}

constexpr int L2_RS = 72;
constexpr int L2_QT = 0, L2_KT = 9216, L2_QH = 18432, L2_VT = 27648, L2_ST = 36864, L2_KH = 46080, L2_HEAD = 55296;
template <int CTRL, int RM> __device__ __forceinline__ float dpp_add(float v) { return v + __builtin_bit_cast(float, __builtin_amdgcn_update_dpp(0, __builtin_bit_cast(int, v), CTRL, RM, 0xF, false)); }
__device__ __forceinline__ float wave_incl_scan(float x) {
    x = dpp_add<0x111, 0xF>(x); x = dpp_add<0x112, 0xF>(x); x = dpp_add<0x114, 0xF>(x); x = dpp_add<0x118, 0xF>(x);
    x = dpp_add<0x142, 0xA>(x); x = dpp_add<0x143, 0xC>(x);
    return x;
}
__device__ __forceinline__ float lane_bcast(float v, int l) { return __builtin_bit_cast(float, __builtin_amdgcn_readlane(__builtin_bit_cast(int, v), l)); }
template <int CTRL, int RM> __device__ __forceinline__ unsigned dpp_umax(unsigned v) { return max(v, (unsigned)__builtin_amdgcn_update_dpp(0, (int)v, CTRL, RM, 0xF, false)); }
template <int CTRL, int RM> __device__ __forceinline__ unsigned dpp_umin(unsigned v) { return min(v, (unsigned)__builtin_amdgcn_update_dpp(-1, (int)v, CTRL, RM, 0xF, false)); }
__device__ __forceinline__ unsigned wave_umax(unsigned x) { x = dpp_umax<0x111, 0xF>(x); x = dpp_umax<0x112, 0xF>(x); x = dpp_umax<0x114, 0xF>(x); x = dpp_umax<0x118, 0xF>(x);
    x = dpp_umax<0x142, 0xA>(x); x = dpp_umax<0x143, 0xC>(x); return (unsigned)__builtin_amdgcn_readlane((int)x, 63); }
__device__ __forceinline__ unsigned wave_umin(unsigned x) { x = dpp_umin<0x111, 0xF>(x); x = dpp_umin<0x112, 0xF>(x); x = dpp_umin<0x114, 0xF>(x); x = dpp_umin<0x118, 0xF>(x);
    x = dpp_umin<0x142, 0xA>(x); x = dpp_umin<0x143, 0xC>(x); return (unsigned)__builtin_amdgcn_readlane((int)x, 63); }
template <int DK, int PHASE>
__device__ __forceinline__ void lin2_unit(const LinPar& P, GAS bf16* ST, GAS float* DEC, const GAS float* normg, GAS bf16* YS, LAS unsigned char* lds, int u, int wave) {
    unsigned ones_u = ~0u; asm volatile("" : "+s"(ones_u));
    const int lane = (int)__builtin_amdgcn_mbcnt_hi(ones_u, __builtin_amdgcn_mbcnt_lo(ones_u, 0u));
    const int hg = wave >> 2, wl = wave & 3;
    const int b = u / (NCH * 2), c = (u >> 1) % NCH, h = 2 * (u & 1) + hg;
    LAS unsigned char* hb = lds + hg * L2_HEAD;
    LAS bf16* QT = (LAS bf16*)(hb + L2_QT); LAS bf16* KT = (LAS bf16*)(hb + L2_KT); LAS bf16* QH = (LAS bf16*)(hb + L2_QH);
    LAS bf16* VT = (LAS bf16*)(hb + L2_VT); LAS bf16* SS = (LAS bf16*)(hb + L2_ST); LAS bf16* KH = (LAS bf16*)(hb + L2_KH);
    constexpr int ND = DK / 4;
    const int d0 = wl * ND;
    const size_t crow = (size_t)b * SEQ + c * 64;
    const GAS bf16* zr = P.Z + (crow + lane) * ZLD;
    float lf[ND], qv[ND], kv[ND], vv[16];
    if constexpr (DK == 32) {
        const v4u qw = *(const GAS v4u*)(zr + ZC_Q + h * 32 + d0), kw = *(const GAS v4u*)(zr + ZC_K + h * 32 + d0);
        const unsigned qa[4] = {qw.x, qw.y, qw.z, qw.w}, ka[4] = {kw.x, kw.y, kw.z, kw.w};
        const v4u g0 = *(const GAS v4u*)(zr + ZC_GLR), g1 = *(const GAS v4u*)(zr + ZC_GLR + 8);
        const unsigned gw[8] = {g0.x, g0.y, g0.z, g0.w, g1.x, g1.y, g1.z, g1.w};
        float a[ND];
#pragma unroll
        for (int j = 0; j < ND; ++j) a[j] = P.gate_b[h * 32 + d0 + j];
#pragma unroll
        for (int r2 = 0; r2 < 8; ++r2) { const float x0 = bflo(gw[r2]), x1 = bfhi(gw[r2]);
#pragma unroll
            for (int j = 0; j < ND; ++j) a[j] += x0 * P.gate_w[(2 * r2) * 128 + h * 32 + d0 + j] + x1 * P.gate_w[(2 * r2 + 1) * 128 + h * 32 + d0 + j]; }
#pragma unroll
        for (int j = 0; j < ND; ++j) { lf[j] = logsigm(a[j]) * (1.0f / 16.0f);
            qv[j] = ((j & 1) ? bfhi(qa[j >> 1]) : bflo(qa[j >> 1])) * 0.17677669529663687f; kv[j] = (j & 1) ? bfhi(ka[j >> 1]) : bflo(ka[j >> 1]); }
        const v4u v0 = *(const GAS v4u*)(zr + ZC_V + h * 64 + 16 * wl), v1 = *(const GAS v4u*)(zr + ZC_V + h * 64 + 16 * wl + 8);
        const unsigned va[8] = {v0.x, v0.y, v0.z, v0.w, v1.x, v1.y, v1.z, v1.w};
#pragma unroll
        for (int j = 0; j < 16; ++j) vv[j] = (j & 1) ? bfhi(va[j >> 1]) : bflo(va[j >> 1]);
    } else {
        const v4u f0 = *(const GAS v4u*)(zr + ZD_F + h * 64 + d0), f1 = *(const GAS v4u*)(zr + ZD_F + h * 64 + d0 + 8);
        const v4u q0 = *(const GAS v4u*)(zr + ZD_Q + h * 64 + d0), q1 = *(const GAS v4u*)(zr + ZD_Q + h * 64 + d0 + 8);
        const v4u i0 = *(const GAS v4u*)(zr + ZD_I + h * 64 + d0), i1 = *(const GAS v4u*)(zr + ZD_I + h * 64 + d0 + 8);
        const unsigned fa[8] = {f0.x, f0.y, f0.z, f0.w, f1.x, f1.y, f1.z, f1.w}, qa[8] = {q0.x, q0.y, q0.z, q0.w, q1.x, q1.y, q1.z, q1.w}, ia[8] = {i0.x, i0.y, i0.z, i0.w, i1.x, i1.y, i1.z, i1.w};
        if (P.layer == 0) {
#pragma unroll
            for (int j = 0; j < 16; ++j) {
                const float zf = (j & 1) ? bfhi(fa[j >> 1]) : bflo(fa[j >> 1]), zq = (j & 1) ? bfhi(qa[j >> 1]) : bflo(qa[j >> 1]);
                const float t = __expf(-fabsf(zf)), r = __builtin_amdgcn_rcpf(1.0f + t), tr = t * r;
                lf[j % ND] = fminf(zf, 0.f) - __logf(1.0f + t);
                kv[j % ND] = (zf >= 0.f) ? tr : r;
                qv[j % ND] = siluf(zq);
                vv[j] = (j & 1) ? bfhi(ia[j >> 1]) : bflo(ia[j >> 1]); }
        } else {
#pragma unroll
            for (int j = 0; j < 16; ++j) {
                const float zf = (j & 1) ? bfhi(fa[j >> 1]) : bflo(fa[j >> 1]), zq = (j & 1) ? bfhi(qa[j >> 1]) : bflo(qa[j >> 1]);
                const float lbv = sigm(P.lb_logits[256 + h * 64 + d0 + j] - P.lb_logits[h * 64 + d0 + j]);
                const float t = __expf(-fabsf(zf)), r = __builtin_amdgcn_rcpf(1.0f + t), tr = t * r;
                const float sp = (zf >= 0.f) ? r : tr, sn = (zf >= 0.f) ? tr : r;
                lf[j % ND] = __logf(lbv + (1.0f - lbv) * sp);
                kv[j % ND] = (1.0f - lbv) * sn;
                qv[j % ND] = siluf(zq);
                vv[j] = (j & 1) ? bfhi(ia[j >> 1]) : bflo(ia[j >> 1]); }
        }
    }
    const int fr = lane & 15, fg = lane >> 4;
    unsigned sreg[PHASE == 1 ? DK / 4 : 1]; unsigned ogr[PHASE == 1 ? 16 : 1];
    if constexpr (PHASE == 1) {
        const GAS bf16* sp = ST + ((size_t)(b * NCH + c) * 4 + h) * DK * 64;
#pragma unroll
        for (int i = 0; i < DK / 4; ++i) sreg[i] = sp[wl * 64 + lane + 256 * i];
#pragma unroll
        for (int tv = 0; tv < 4; ++tv)
#pragma unroll
            for (int r = 0; r < 4; ++r) ogr[tv * 4 + r] = P.Z[(crow + 16 * wl + 4 * fg + r) * ZLD + (DK == 32 ? ZC_OG : ZD_OG) + h * 64 + 16 * tv + fr];
    }
    float g[ND], gl[ND];
#pragma unroll
    for (int j = 0; j < ND; ++j) { g[j] = wave_incl_scan(lf[j]); gl[j] = lane_bcast(g[j], 63); }
#pragma unroll
    for (int j = 0; j < 16; ++j) VT[(16 * wl + j) * L2_RS + lane] = (bf16)f2bf(vv[j]);
    if (PHASE == 0) {
#pragma unroll
        for (int j = 0; j < ND; ++j) KH[(d0 + j) * L2_RS + lane] = (bf16)f2bf(kv[j] * __expf(gl[j] - g[j]));
        if (lane == 63) {
#pragma unroll
            for (int j = 0; j < ND; ++j) DEC[(size_t)(b * NCH + c) * 4 * DK + h * DK + d0 + j] = __expf(gl[j]);
        }
        __syncthreads();
        GAS bf16* so = ST + ((size_t)(b * NCH + c) * 4 + h) * DK * 64;
#pragma unroll
        for (int td = 0; td < DK / 16; ++td) { f32x4 acc = {0.f, 0.f, 0.f, 0.f};
#pragma unroll
            for (int ks = 0; ks < 2; ++ks) { const bf16x8 af = *(const LAS bf16x8*)(KH + (16 * td + fr) * L2_RS + 32 * ks + 8 * fg), bfv = *(const LAS bf16x8*)(VT + (16 * wl + fr) * L2_RS + 32 * ks + 8 * fg);
                acc = __builtin_amdgcn_mfma_f32_16x16x32_bf16(af, bfv, acc, 0, 0, 0); }
#pragma unroll
            for (int r = 0; r < 4; ++r) so[(16 * td + 4 * fg + r) * 64 + 16 * wl + fr] = (bf16)f2bf(acc[r]); }
        __syncthreads();
    } else {
        {
            unsigned qtw[ND / 2], ktw[ND / 2], qhw[ND / 2];
#pragma unroll
            for (int j = 0; j < ND; j += 2) { const float r0 = lane_bcast(g[j], 31), r1 = lane_bcast(g[j + 1], 31);
                qtw[j >> 1] = pk2(qv[j] * __expf(fminf(g[j] - r0, 80.f)), qv[j + 1] * __expf(fminf(g[j + 1] - r1, 80.f)));
                ktw[j >> 1] = pk2(kv[j] * __expf(fminf(r0 - g[j], 80.f)), kv[j + 1] * __expf(fminf(r1 - g[j + 1], 80.f)));
                qhw[j >> 1] = pk2(qv[j] * __expf(g[j]), qv[j + 1] * __expf(g[j + 1])); }
#pragma unroll
            for (int q4 = 0; q4 < ND / 8; ++q4) {
                *(LAS v4u*)(QT + lane * L2_RS + d0 + 8 * q4) = (v4u){qtw[4 * q4], qtw[4 * q4 + 1], qtw[4 * q4 + 2], qtw[4 * q4 + 3]};
                *(LAS v4u*)(KT + lane * L2_RS + d0 + 8 * q4) = (v4u){ktw[4 * q4], ktw[4 * q4 + 1], ktw[4 * q4 + 2], ktw[4 * q4 + 3]};
                *(LAS v4u*)(QH + lane * L2_RS + d0 + 8 * q4) = (v4u){qhw[4 * q4], qhw[4 * q4 + 1], qhw[4 * q4 + 2], qhw[4 * q4 + 3]}; }
        }
        {
#pragma unroll
            for (int i = 0; i < DK / 4; ++i) { const int idx = wl * 64 + lane + 256 * i; SS[(idx & 63) * L2_RS + (idx >> 6)] = (bf16)sreg[i]; }
        }
        __syncthreads();
        const int ti = wl;
        bf16x8 qf[DK / 32];
#pragma unroll
        for (int ks = 0; ks < DK / 32; ++ks) qf[ks] = *(const LAS bf16x8*)(QT + (16 * ti + fr) * L2_RS + 32 * ks + 8 * fg);
        bf16x8 pa[2];
#pragma unroll
        for (int tj = 0; tj < 4; ++tj) { f32x4 at = {0.f, 0.f, 0.f, 0.f};
            if (tj <= ti) {
#pragma unroll
                for (int ks = 0; ks < DK / 32; ++ks) { const bf16x8 kf = *(const LAS bf16x8*)(KT + (16 * tj + fr) * L2_RS + 32 * ks + 8 * fg);
                    at = __builtin_amdgcn_mfma_f32_16x16x32_bf16(kf, qf[ks], at, 0, 0, 0); } }
#pragma unroll
            for (int r = 0; r < 4; ++r) { const float v = (tj <= ti && (16 * tj + 4 * fg + r) <= (16 * ti + fr)) ? at[r] : 0.f; pa[tj >> 1][(tj & 1) * 4 + r] = (short)f2bf(v); } }
        f32x4 oacc[4];
#pragma unroll
        for (int tv = 0; tv < 4; ++tv) { f32x4 acc = {0.f, 0.f, 0.f, 0.f};
#pragma unroll
            for (int k2 = 0; k2 < 2; ++k2) { const v2u lo = *(const LAS v2u*)(VT + (16 * tv + fr) * L2_RS + 32 * k2 + 4 * fg), hi = *(const LAS v2u*)(VT + (16 * tv + fr) * L2_RS + 32 * k2 + 16 + 4 * fg);
                const v4u vb4 = (v4u){lo.x, lo.y, hi.x, hi.y};
                acc = __builtin_amdgcn_mfma_f32_16x16x32_bf16(pa[k2], __builtin_bit_cast(bf16x8, vb4), acc, 0, 0, 0); }
#pragma unroll
            for (int ks = 0; ks < DK / 32; ++ks) { const bf16x8 qh = *(const LAS bf16x8*)(QH + (16 * ti + fr) * L2_RS + 32 * ks + 8 * fg), sf = *(const LAS bf16x8*)(SS + (16 * tv + fr) * L2_RS + 32 * ks + 8 * fg);
                acc = __builtin_amdgcn_mfma_f32_16x16x32_bf16(qh, sf, acc, 0, 0, 0); }
            oacc[tv] = acc; }
        float rs[4];
#pragma unroll
        for (int r = 0; r < 4; ++r) { float ss = (oacc[0][r] * oacc[0][r] + oacc[1][r] * oacc[1][r]) + (oacc[2][r] * oacc[2][r] + oacc[3][r] * oacc[3][r]);
            ss += swz_xor<1>(ss); ss += swz_xor<2>(ss); ss += swz_xor<4>(ss); ss += swz_xor<8>(ss);
            rs[r] = __builtin_amdgcn_rsqf(ss * (1.0f / 64.0f) + EPS); }
#pragma unroll
        for (int tv = 0; tv < 4; ++tv) { const float ng = normg[16 * tv + fr];
#pragma unroll
            for (int r = 0; r < 4; ++r) { const size_t row = crow + 16 * ti + 4 * fg + r;
                const float og = bf2f(ogr[tv * 4 + r]);
                YS[row * 256 + h * 64 + 16 * tv + fr] = (bf16)f2bf(oacc[tv][r] * rs[r] * ng * siluf(og)); } }
        __syncthreads();
    }
}

constexpr int TK_CAP = 576, TK_TRIG = TK_CAP - 32, TK_K = 256, TK_SLACK = 32;
constexpr int TKW_BUF = 0, TKW_CT = 8 * TK_CAP * 4, TKW_TRASH = TKW_CT + 64, TKW_BYTES = TKW_TRASH + 256;
static_assert(TKW_BYTES * 8 <= MISC_OFF, "top-k LDS");
__device__ __forceinline__ unsigned tk_compact(LAS unsigned* bufq, LAS unsigned* trash, int n, unsigned lo_in, int slack, int lane, int& nkeep) {
    constexpr int NR = TK_CAP / 64; unsigned e[NR];
#pragma unroll
    for (int r = 0; r < NR; ++r) { const int idx = lane + 64 * r; const unsigned raw = bufq[idx]; e[r] = (idx < n) ? raw : 0u; }
    unsigned lmx = max(max(max(e[0], e[1]), max(e[2], e[3])), max(max(e[4], e[5]), max(e[6], e[7])));
    unsigned lmn = min(min(min(e[0] - 1u, e[1] - 1u), min(e[2] - 1u, e[3] - 1u)), min(min(e[4] - 1u, e[5] - 1u), min(e[6] - 1u, e[7] - 1u)));
#pragma unroll
    for (int r = 8; r < NR; ++r) { lmx = max(lmx, e[r]); lmn = min(lmn, e[r] - 1u); }
    const bool has = lmx != 0u;
    unsigned lo = lo_in + 1u, hi = wave_umax(lmx) + 1u;
    int clo = n;
    auto count_ge = [&](unsigned mid) { int c = 0;
#pragma unroll
        for (int r4 = 0; r4 < 8; r4 += 4) {
            unsigned long long m0 = __builtin_amdgcn_uicmp(e[r4], mid, 35  ), m1 = __builtin_amdgcn_uicmp(e[r4 + 1], mid, 35), m2 = __builtin_amdgcn_uicmp(e[r4 + 2], mid, 35), m3 = __builtin_amdgcn_uicmp(e[r4 + 3], mid, 35);
            asm volatile("" : "+s"(m0), "+s"(m1), "+s"(m2), "+s"(m3));
            c += __popcll(m0) + __popcll(m1) + __popcll(m2) + __popcll(m3); }
#pragma unroll
        for (int r = 8; r < NR; ++r) c += __popcll(__builtin_amdgcn_uicmp(e[r], mid, 35));
        return c; };
    { const unsigned p0 = wave_umax(has ? lmn + 1u : 0u), p1 = wave_umin(has ? lmx : 0xFFFFFFFFu);
#pragma unroll
      for (int k = 0; k < 2; ++k) { const unsigned mid = k ? p1 : p0;
          if (mid > lo && mid < hi && clo > TK_K + slack) { const int c = count_ge(mid); if (c >= TK_K) { lo = mid; clo = c; } else hi = mid; } } }
#pragma unroll 1
    while (hi - lo > 1u && clo > TK_K + slack) {
        const unsigned mid = lo + ((hi - lo) >> 1); const int c = count_ge(mid);
        if (c >= TK_K) { lo = mid; clo = c; } else hi = mid;
    }
    LDS_WAIT();
    int base = 0;
#pragma unroll
    for (int r = 0; r < NR; ++r) { const bool keep = e[r] >= lo; const unsigned long long m = __ballot(keep);
        const unsigned pre = __builtin_amdgcn_mbcnt_hi((unsigned)(m >> 32), __builtin_amdgcn_mbcnt_lo((unsigned)m, 0u));
        LAS unsigned* dst = keep ? bufq + base + pre : trash + lane;
        *dst = e[r];
        base += __popcll(m); }
    LDS_WAIT();
    nkeep = base;
    return lo - 1u;
}
__device__ __forceinline__ void tk_compact_all(LAS unsigned* buf, LAS unsigned* ct, int limit, int slack, int lane) {
#pragma unroll 1
    for (int ql = 0; ql < 8; ++ql) { const int n = __builtin_amdgcn_readfirstlane(ct[ql]);
        if (n > limit) { int nk; const unsigned T = tk_compact(buf + ql * TK_CAP, buf + TKW_TRASH / 4, n, __builtin_amdgcn_readfirstlane(ct[8 + ql]), slack, lane, nk); if (lane == 0) { ct[ql] = (unsigned)nk; ct[8 + ql] = T; } } }
    LDS_WAIT();
}
__device__ __forceinline__ void topk_attn_unit(const GAS bf16* Z, const GAS bf16* KIT, GAS bf16* YB, LAS unsigned char* lds, int b, int qb, int wave, int lane_in, unsigned long long& pr_acc) {
    unsigned long long pr_t0 = (MK_PROBE >= 20) ? __builtin_amdgcn_s_memrealtime() : 0ull; unsigned long long pr_c = 0ull;
    (void)lane_in; unsigned ones_u = ~0u; asm volatile("" : "+s"(ones_u));
    const int lane = (int)__builtin_amdgcn_mbcnt_hi(ones_u, __builtin_amdgcn_mbcnt_lo(ones_u, 0u));
    LAS unsigned char* wl = lds + wave * TKW_BYTES;
    LAS unsigned* buf = (LAS unsigned*)(wl + TKW_BUF); LAS unsigned* ct = (LAS unsigned*)(wl + TKW_CT);
    const int half = lane >> 5, l31 = lane & 31;
    const size_t growb = (size_t)b * SEQ;
    const int tq0 = qb * 64 + wave * 8;
    if (lane < 16) ct[lane] = 0u;
    bf16x8 aq[4];
    { const GAS bf16* qr = Z + (growb + tq0 + (l31 >> 2)) * ZLD + ZB_QI + (l31 & 3) * 64 + 8 * half;
#pragma unroll
      for (int ks = 0; ks < 4; ++ks) aq[ks] = *(const GAS bf16x8*)(qr + 16 * ks); }
    float wv[4][4];
#pragma unroll
    for (int g = 0; g < 4; ++g) { const v2u ww = *(const GAS v2u*)(Z + (growb + tq0 + 2 * g + half) * ZLD + ZB_WI);
        wv[g][0] = bflo(ww.x) * 0.0625f; wv[g][1] = bfhi(ww.x) * 0.0625f; wv[g][2] = bflo(ww.y) * 0.0625f; wv[g][3] = bfhi(ww.y) * 0.0625f; }
    unsigned thr[4] = {0u, 0u, 0u, 0u};
    constexpr unsigned OVB1 = (unsigned)(0x8000 - TK_TRIG - 1), OVB = OVB1 * 0x00010001u;
    unsigned cpk[4] = {OVB, OVB, OVB, OVB};
    unsigned sh16 = (unsigned)half << 4, hmask = half ? 0u : ~0u; asm volatile("" : "+v"(sh16), "+v"(hmask));
    LAS unsigned* hb = buf + half * TK_CAP - OVB1;
    LAS unsigned* tr0 = buf + TKW_TRASH / 4 + lane;
    LDS_WAIT();
    const int ktmax = (tq0 + 7) >> 5;
    const __amdgpu_buffer_rsrc_t krs = __builtin_amdgcn_make_buffer_rsrc((void*)KIT, 0, MG * 128, 0x00020000);
    const unsigned kio = (unsigned)(growb >> 5) * 4096u + (unsigned)lane * 16u;
#define TK_GLD(dst, KT) do { const unsigned ko_ = kio + (unsigned)(KT) * 4096u; _Pragma("unroll") for (int i_ = 0; i_ < 4; ++i_) dst[i_] = __builtin_bit_cast(bf16x8, __builtin_amdgcn_raw_buffer_load_b128(krs, (int)(ko_ + i_ * 1024), 0, 16)); } while (0)
    bf16x8 bk[4];
    TK_GLD(bk, 0);
#pragma unroll 1
    for (int kt = 0; kt <= ktmax; ++kt) {
        bf16x8 bkn[4];
        { const int ktn = (kt < ktmax) ? kt + 1 : kt; TK_GLD(bkn, ktn); }
        f32x16 acc;
#pragma unroll
        for (int r = 0; r < 16; ++r) acc[r] = 0.f;
#pragma unroll
        for (int ks = 0; ks < 4; ++ks) acc = __builtin_amdgcn_mfma_f32_32x32x16_bf16(aq[ks], bk[ks], acc, 0, 0, 0);
        const int key = 32 * kt + l31;
#pragma unroll
        for (int g = 0; g < 4; ++g) {
            const int tq = tq0 + 2 * g + half;
            float s = 0.f;
#pragma unroll
            for (int h = 0; h < 4; ++h) { const float av = acc[4 * g + h]; const int ib = __float_as_int(av); s = fmaf(wv[g][h], __builtin_bit_cast(float, ib > 0 ? ib : 0), s); }
            const unsigned bb = __float_as_uint(s);
            const unsigned ord = bb ^ ((unsigned)((int)bb >> 31) | 0x80000000u);
            const unsigned packed = (ord & 0xFFFFE000u) | (0x1FFFu - (unsigned)key);
            const bool pass = (key <= tq) && (packed > thr[g]);
            const unsigned long long mask = __builtin_amdgcn_sicmp(key, tq, 41  ) & __builtin_amdgcn_uicmp(packed, thr[g], 34  );
            {
                const unsigned mlo = (unsigned)mask, mhi = (unsigned)(mask >> 32);
                const unsigned pos = __builtin_amdgcn_mbcnt_hi(mhi, __builtin_amdgcn_mbcnt_lo(mlo & hmask, __builtin_amdgcn_ubfe(cpk[g], sh16, 16u)));
                LAS unsigned* d1 = hb + pos; asm volatile("" : "+v"(d1));
                LAS unsigned* dst = pass ? d1 : tr0 - 2 * g * TK_CAP;
                dst[2 * g * TK_CAP] = packed;
                cpk[g] += (unsigned)__popc(mlo) + ((unsigned)__popc(mhi) << 16);
            }
        }
        if (((cpk[0] | cpk[1] | cpk[2] | cpk[3]) & 0x80008000u) != 0u) {
#pragma unroll
            for (int g = 0; g < 4; ++g) if (l31 == 0) ct[2 * g + half] = __builtin_amdgcn_ubfe(cpk[g], sh16, 16u) - OVB1;
            LDS_WAIT();
            { const unsigned long long c0_ = (MK_PROBE >= 20) ? __builtin_amdgcn_s_memrealtime() : 0ull;
            tk_compact_all(buf, ct, TK_TRIG, TK_SLACK, lane);
            if (MK_PROBE >= 20) pr_c += __builtin_amdgcn_s_memrealtime() - c0_; }
#pragma unroll
            for (int g = 0; g < 4; ++g) { cpk[g] = ((unsigned)__builtin_amdgcn_readfirstlane(ct[2 * g]) | ((unsigned)__builtin_amdgcn_readfirstlane(ct[2 * g + 1]) << 16)) + OVB; thr[g] = ct[8 + 2 * g + half]; }
        }
#pragma unroll
        for (int ks = 0; ks < 4; ++ks) bk[ks] = bkn[ks];
    }
#pragma unroll
    for (int g = 0; g < 4; ++g) if (l31 == 0) ct[2 * g + half] = __builtin_amdgcn_ubfe(cpk[g], sh16, 16u) - OVB1;
    LDS_WAIT();
    { const unsigned long long c0_ = (MK_PROBE >= 20) ? __builtin_amdgcn_s_memrealtime() : 0ull;
    tk_compact_all(buf, ct, TK_K, 0, lane);
    if (MK_PROBE >= 20) pr_c += __builtin_amdgcn_s_memrealtime() - c0_; }
#pragma unroll 1
    for (int ql = 0; ql < 8; ++ql) { const int nq = __builtin_amdgcn_readfirstlane(ct[ql]); LAS unsigned* bq_ = buf + ql * TK_CAP;
#pragma unroll
        for (int r = 0; r < 4; ++r) { const int idx = lane + 64 * r; const unsigned e_ = bq_[idx]; const unsigned key_ = (idx < nq) ? 0x1FFFu - (e_ & 0x1FFFu) : 0u; bq_[idx] = ((unsigned)growb + key_) * (unsigned)(ZLD * 2); } }
    LDS_WAIT();
    const unsigned long long pr_t1 = (MK_PROBE >= 20) ? __builtin_amdgcn_s_memrealtime() : 0ull;
    unsigned ones_v = ~0u; asm volatile("" : "+s"(ones_v)); const int lane2 = (int)__builtin_amdgcn_mbcnt_hi(ones_v, __builtin_amdgcn_mbcnt_lo(ones_v, 0u));
    const GAS bf16* Z2 = Z; GAS bf16* YB2 = YB; int tq02 = tq0, b2 = b, wv2 = wave; asm volatile("" : "+s"(Z2), "+s"(YB2), "+s"(tq02), "+s"(b2), "+s"(wv2));
    const size_t growb2 = (size_t)b2 * SEQ;
    LAS unsigned char* wl2 = lds + wv2 * TKW_BYTES;
    LAS unsigned* buf2 = (LAS unsigned*)(wl2 + TKW_BUF); LAS float* ps2 = (LAS float*)buf2; LAS unsigned* ct2 = (LAS unsigned*)(wl2 + TKW_CT);
    const int fr = lane2 & 15, fg = lane2 >> 4;
    const int jj = lane2 >> 3, ch = lane2 & 7;
    const int q4 = fr >> 2, p4 = fr & 3;
    LAS unsigned char* vt = (LAS unsigned char*)buf2;
#define TK_LDK(dst, BQ, NN, bt) do { _Pragma("unroll") for (int t4_ = 0; t4_ < 4; ++t4_) { const unsigned o_ = (BQ)[16 * (4 * (bt) + t4_) + fr] + kl; \
        dst[t4_][0] = *(const GAS bf16x8*)(zk + o_); dst[t4_][1] = *(const GAS bf16x8*)(zk + o_ + 64); } } while (0)
#define TK_LDQ(dst, QROW) do { _Pragma("unroll") for (int ks_ = 0; ks_ < 2; ++ks_) { bf16x8 t_ = {0, 0, 0, 0, 0, 0, 0, 0}; \
        if (fr < 4) t_ = *(const GAS bf16x8*)(Z2 + (QROW) * ZLD + ZB_Q + fr * 64 + 32 * ks_ + 8 * fg); dst[ks_] = t_; } } while (0)
#define TK_MMA(src, bt) do { _Pragma("unroll") for (int t4_ = 0; t4_ < 4; ++t4_) { f32x4 c_ = {0.f, 0.f, 0.f, 0.f}; \
        c_ = __builtin_amdgcn_mfma_f32_16x16x32_bf16(src[t4_][0], bqf[0], c_, 0, 0, 0); c_ = __builtin_amdgcn_mfma_f32_16x16x32_bf16(src[t4_][1], bqf[1], c_, 0, 0, 0); sacc[4 * (bt) + t4_] = c_; } } while (0)
#define TK_LDV(dst, ks) do { _Pragma("unroll") for (int i_ = 0; i_ < 4; ++i_) { const unsigned o_ = bq[32 * (ks) + 16 * (jj >> 2) + 4 * i_ + (jj & 3)] + vl; dst[i_] = *(const GAS v4u*)(zv + o_); } } while (0)
    const GAS unsigned char* zk = (const GAS unsigned char*)Z2 + ZB_K * 2; const GAS unsigned char* zv = (const GAS unsigned char*)Z2 + ZB_V * 2;
    const unsigned kl = 16u * (unsigned)fg, vl = 16u * (unsigned)ch;
    bf16x8 kan[4][2], bqn[2];
    { const int n0 = __builtin_amdgcn_readfirstlane(ct2[0]); TK_LDK(kan, buf2, n0, 0); TK_LDQ(bqn, growb2 + tq02); }
#pragma unroll 1
    for (int ql = 0; ql < 8; ++ql) {
        const int n = __builtin_amdgcn_readfirstlane(ct2[ql]);
        const size_t qrow = growb2 + tq02 + ql;
        LAS unsigned* bq = buf2 + ql * TK_CAP;
        bf16x8 bqf[2], kaA[4][2], kaB[4][2];
#pragma unroll
        for (int ks = 0; ks < 2; ++ks) bqf[ks] = bqn[ks];
#pragma unroll
        for (int t4 = 0; t4 < 4; ++t4) { kaA[t4][0] = kan[t4][0]; kaA[t4][1] = kan[t4][1]; }
        f32x4 sacc[16];
        v4u vr[4][4];
        TK_LDK(kaB, bq, n, 1);
        TK_MMA(kaA, 0);
        TK_LDK(kaA, bq, n, 2);
        TK_MMA(kaB, 1);
        TK_LDK(kaB, bq, n, 3);
        TK_MMA(kaA, 2);
        TK_LDV(vr[0], 0); TK_LDV(vr[1], 1); TK_LDV(vr[2], 2);
        TK_MMA(kaB, 3);
        const int nfg = n - 4 * fg;
        float mx = -INFINITY;
#pragma unroll
        for (int kt = 0; kt < 16; ++kt)
#pragma unroll
            for (int r = 0; r < 4; ++r) { const float v = (16 * kt + r < nfg) ? sacc[kt][r] * 0.125f : -INFINITY; sacc[kt][r] = v; mx = fmaxf(mx, v); }
        mx = fmaxf(mx, swz_xor<16>(mx)); mx = half_max(mx);
        float sm = 0.f;
#pragma unroll
        for (int kt = 0; kt < 16; ++kt)
#pragma unroll
            for (int r = 0; r < 4; ++r) { const float e = __expf(sacc[kt][r] - mx); sacc[kt][r] = e; sm += e; }
        sm += swz_xor<16>(sm); sm = half_sum(sm);
        const float inv = __builtin_amdgcn_rcpf(sm);
        bf16x8 pa[8];
#pragma unroll
        for (int ks = 0; ks < 8; ++ks) {
            v4u w; w.x = pk2(sacc[2 * ks][0] * inv, sacc[2 * ks][1] * inv); w.y = pk2(sacc[2 * ks][2] * inv, sacc[2 * ks][3] * inv);
            w.z = pk2(sacc[2 * ks + 1][0] * inv, sacc[2 * ks + 1][1] * inv); w.w = pk2(sacc[2 * ks + 1][2] * inv, sacc[2 * ks + 1][3] * inv);
            pa[ks] = __builtin_bit_cast(bf16x8, w); }
        f32x4 oacc[4];
#pragma unroll
        for (int nt = 0; nt < 4; ++nt) oacc[nt] = (f32x4){0.f, 0.f, 0.f, 0.f};
#pragma unroll
        for (int ks = 0; ks < 8; ++ks) {
            if (ks + 3 < 8) TK_LDV(vr[(ks + 3) & 3], ks + 3);
            if (ks == 5) { const int qn = (ql < 7) ? ql + 1 : 7; const int nn = __builtin_amdgcn_readfirstlane(ct2[qn]); TK_LDK(kan, buf2 + qn * TK_CAP, nn, 0); TK_LDQ(bqn, growb2 + tq02 + qn); }
#pragma unroll
            for (int i = 0; i < 4; ++i) *(LAS v4u*)(vt + i * (TK_CAP * 4) + 1024 + jj * 128 + ch * 16) = vr[ks & 3][i];
            LDS_WAIT();
#pragma unroll
            for (int nt = 0; nt < 4; ++nt) {
                typedef short s4v __attribute__((ext_vector_type(4)));
                const s4v lo = __builtin_amdgcn_ds_read_tr16_b64_v4i16((LAS s4v*)(vt + fg * (TK_CAP * 4) + 1024 + q4 * 128 + (16 * nt + 4 * p4) * 2));
                const s4v hi = __builtin_amdgcn_ds_read_tr16_b64_v4i16((LAS s4v*)(vt + fg * (TK_CAP * 4) + 1024 + (4 + q4) * 128 + (16 * nt + 4 * p4) * 2));
                const bf16x8 vb = {lo[0], lo[1], lo[2], lo[3], hi[0], hi[1], hi[2], hi[3]};
                oacc[nt] = __builtin_amdgcn_mfma_f32_16x16x32_bf16(pa[ks], vb, oacc[nt], 0, 0, 0); }
            LDS_WAIT();
        }
        if (fg == 0) {
#pragma unroll
            for (int nt = 0; nt < 4; ++nt)
#pragma unroll
                for (int h = 0; h < 4; ++h) YB2[qrow * 256 + h * 64 + 16 * nt + fr] = (bf16)f2bf(oacc[nt][h]);
        }
    }
#undef TK_GLD
#undef TK_LDK
#undef TK_LDQ
#undef TK_MMA
#undef TK_LDV
    if (MK_PROBE >= 20) { const unsigned long long pr_t2 = __builtin_amdgcn_s_memrealtime(); pr_acc += (MK_PROBE == 20) ? (pr_t1 - pr_t0 - pr_c) : (MK_PROBE == 21) ? pr_c : (pr_t2 - pr_t1); }
}

__device__ __forceinline__ void zero_ys(GAS bf16* Y, int gtid, int gstride) { for (size_t i = gtid; i < (size_t)MG * 256 / 8; i += gstride) ((GAS v4u*)Y)[i] = (v4u){0u, 0u, 0u, 0u}; }

__device__ __forceinline__ const void* ld_arg(LAS unsigned char* lds, int k) {
    unsigned off = MISC_OFF + 128 + 8 * k; asm volatile("" : "+v"(off));
    const LAS unsigned* p = (const LAS unsigned*)(lds + off);
    const unsigned lo = __builtin_amdgcn_readfirstlane(p[0]), hi = __builtin_amdgcn_readfirstlane(p[1]);
    return (const void*)(((unsigned long long)hi << 32) | lo);
}
__device__ __forceinline__ bool run_step(int lo, int hi, int s) {
    asm volatile("" : "+s"(lo), "+s"(hi));
    return s >= lo && s < hi;
}
struct GatedOrder {
    int G, c;
    __device__ __forceinline__ void init(int G_, int c_) { G = G_; c = c_; }
    __device__ __forceinline__ bool next(int i, pg8::Unit& u) const {
        const int nb = i & 3, t = (i >> 2) * G + c; if (t >= (MG / 256) * 4) return false;
        u.pm = nb * (MG / 256) + (t >> 2); u.pn = nb * 4 + (t & 3); return true;
    }
    __device__ __forceinline__ void a_ready(const pg8::Unit&) const {}
    __device__ __forceinline__ void done(const pg8::Unit&) const {}
};
struct KArgs { const void* in[22]; float* out; unsigned char* ws; int step_lo, step_hi, li, pad; };
constexpr int N_STEPS = 32;

__global__ void __launch_bounds__(NTHREADS, 2) mega_fwd(KArgs a) {
    extern __shared__ __attribute__((aligned(16))) unsigned char lds_raw[];
    LAS unsigned char* lds = (LAS unsigned char*)lds_raw;
    volatile LAS unsigned* MISC = (volatile LAS unsigned*)(lds + MISC_OFF);
    const int G = gridDim.x; const int bx = blockIdx.x; const int vcu = (G % 8 == 0) ? (bx % 8) * (G / 8) + bx / 8 : bx;
    const int NGW = G * NWAVES, gstride = G * NTHREADS;
    if (threadIdx.x < 16) MISC[threadIdx.x] = 0u;
    const int wave_s = __builtin_amdgcn_readfirstlane(threadIdx.x >> 6);
    if (threadIdx.x < 22) ((volatile LAS unsigned long long*)(lds + MISC_OFF + 128))[threadIdx.x] = (unsigned long long)a.in[threadIdx.x];
    __syncthreads();
#define IN(k) ((const GAS float*)ld_arg(lds, (k)))
    GAS unsigned char* const ws_k = (GAS unsigned char*)a.ws;
    const bool use_bar = (a.step_hi - a.step_lo) > 1;
    XcdBarrier bar; bar.bar = (unsigned*)(ws_k + WS_CTL) + CW_BAR + a.li * XCD_BAR_WORDS; bar.x = 0; bar.st = nullptr;
    if (use_bar) bar = xcd_barrier_post((unsigned*)(ws_k + WS_CTL) + CW_BAR + a.li * XCD_BAR_WORDS, MISC + 8);
#define RUN(s) run_step(a.step_lo, a.step_hi, (s))
    unsigned long long pr_acc = 0ull, pr_prev = MK_PROBE ? __builtin_amdgcn_s_memrealtime() : 0ull; const unsigned long long pr_start = pr_prev;
#define SEAM(s) do { if (RUN(s) && RUN((s) + 1)) xcd_barrier(bar); if (MK_PROBE > 0 && MK_PROBE < 20) { const unsigned long long tn_ = __builtin_amdgcn_s_memrealtime(); \
        const int s_ = (s); const int ty_ = (s_ == 0) ? 1 : (s_ == 31) ? 12 : (((s_ - 1) % 15) == 0) ? 2 : (((s_ - 1) % 15) >= 11) ? (((s_ - 1) % 15) - 3) : ((((s_ - 1) % 15) - 1) % 5 + 3); \
        if (ty_ == MK_PROBE) pr_acc += tn_ - pr_prev; pr_prev = tn_; } } while (0)
#define STEP_IDS unsigned ones_ = ~0u; asm volatile("" : "+s"(ones_)); GAS unsigned char* ws = ws_k; asm volatile("" : "+s"(ws)); const int lane = (int)__builtin_amdgcn_mbcnt_hi(ones_, __builtin_amdgcn_mbcnt_lo(ones_, 0u)); int wave = wave_s; asm volatile("" : "+s"(wave)); \
    const int tid = wave * 64 + lane; const int gw = vcu * NWAVES + wave, gtid = vcu * NTHREADS + tid; (void)gw; (void)gtid;
#define STEP_L int l = l0; asm volatile("" : "+s"(l));
#define STEP_G int g = g0; asm volatile("" : "+s"(g));
#define P_CMOD ((GAS float*)(ws + WS_CMOD))
#define P_ROPE ((GAS float*)(ws + WS_ROPE))
#define P_H ((GAS bf16*)(ws + WS_H))
#define P_Z ((GAS bf16*)(ws + WS_Z))
#define P_GT ((GAS bf16*)(ws + WS_GATES))
#define P_YS ((GAS bf16*)(ws + WS_YS))
#define P_XR ((GAS bf16*)(ws + WS_MF32))
#define P_KIT ((GAS bf16*)(ws + WS_KIT))
#define P_STC ((GAS bf16*)(ws + WS_STC))
#define P_STD ((GAS bf16*)(ws + WS_STD))
#define P_DECC ((GAS float*)(ws + WS_DECC))
#define P_DECD ((GAS float*)(ws + WS_DECD))
#define P_U ((GAS bf16*)(ws + WS_U))

    if (RUN(0)) { STEP_IDS
        p0_weights(IN(7), IN(17), IN(18), IN(19), IN(20), ws, lds, gw, NGW, wave, lane);
        __syncthreads();
        p0_rope(P_ROPE, gtid, gstride);
        p0_cmod(IN(1), IN(3), IN(4), P_CMOD, lds, vcu, G, tid, wave, lane);
    }
    SEAM(0);

    for (int l0 = 0; l0 < NL; ++l0) {
        const int sb = 1 + l0 * 15;
        if (RUN(sb)) { STEP_IDS STEP_L
            if (MK_SKIP & 1) { if (l == 0) copy_rows(IN(0), P_XR, gw, NGW, lane); }
            else if (l == 0) norm_rows<true>(IN(0), P_H, IN(5) + l * DM, P_CMOD + (size_t)l * NB * 6144, 0, 1024, gw, NGW, lane);
            else norm_rows<false>(P_XR, P_H, IN(5) + l * DM, P_CMOD + (size_t)l * NB * 6144, 0, 1024, gw, NGW, lane);
        }
        SEAM(sb);
        for (int g0 = 0; g0 < NGRP; ++g0) {
            const int sg = sb + 1 + g0 * 5;
            if (RUN(sg) && !(MK_SKIP & 1)) { STEP_IDS STEP_L STEP_G
                pg8::Gemm gm{(const bf16*)(P_H + (size_t)g * MG * DM), (const bf16*)((const GAS bf16*)(ws + WS_WIN) + (size_t)l * NV * 1024), MG, NV, 1024};
                pg8::StaticOrder S; S.init(MG, NV, G, bx);
                EpiZ E{P_Z, P_GT};
                for (int rp = 0; rp < ((MK_REPEAT & 8) ? 2 : 1); ++rp) pg8::gemm_phase<EpiZ, pg8::StaticOrder, true, true>(lds, gm, S, E, tid);
            }
            SEAM(sg);
            if (RUN(sg + 1) && !(MK_SKIP & 1)) { STEP_IDS STEP_L STEP_G
                LinPar LP{P_Z, IN(12) + l * 16 * 128, IN(13) + l * 128, IN(15), l};
                constexpr int U_ROPE = 10 * (MG / NTHREADS), U_CONV = GB * 128, U_LIN = GB * NCH * 2;
                for (int u = vcu; u < U_ROPE + U_CONV + 2 * U_LIN; u += G) {
                    int r = u;
                    if (r < U_LIN) { if (!(MK_SKIP & 32)) lin2_unit<64, 0>(LP, P_STD, P_DECD, nullptr, nullptr, lds, r, wave); continue; } r -= U_LIN;
                    if (r < U_LIN) { if (!(MK_SKIP & 16)) lin2_unit<32, 0>(LP, P_STC, P_DECC, nullptr, nullptr, lds, r, wave); continue; } r -= U_LIN;
                    if (r < U_CONV) { if (!(MK_SKIP & 4)) conv2_unit(P_Z, P_YS, IN(8) + l * 31 * 256, IN(9) + l * 256, IN(10) + l * 256, IN(11) + l * 256, lds, r, wave); continue; } r -= U_CONV;
                    if (!(MK_SKIP & 8)) rope_unit(P_Z, P_KIT, (const GAS int*)IN(2) + (size_t)g * MG, P_ROPE, r, tid);
                }
                if (MK_SKIP & 4) zero_ys(P_YS, gtid, gstride);
                if (MK_SKIP & 8) zero_ys(P_YS + (size_t)MG * 256, gtid, gstride);
                if (MK_SKIP & 16) zero_ys(P_YS + (size_t)2 * MG * 256, gtid, gstride);
                if (MK_SKIP & 32) zero_ys(P_YS + (size_t)3 * MG * 256, gtid, gstride);
            }
            SEAM(sg + 1);
            if (RUN(sg + 2) && !(MK_SKIP & 1)) { STEP_IDS STEP_L STEP_G
                constexpr int U_SCAN = (GB * 4096 + GB * 8192) / 192;
                if (!(MK_SKIP & 48)) for (int u = vcu; u < U_SCAN; u += G) scan_unit(P_STC, P_STD, P_DECC, P_DECD, u, tid);
                if (!(MK_SKIP & 8)) for (int rp = 0; rp < ((MK_REPEAT & 1) ? 2 : 1); ++rp) {
                    const int W = G / GB;
                    if (W > 0 && vcu < W * GB) { const int b = vcu / W, j = vcu % W;
                        for (int p2 = 2 * j; p2 < 128; p2 += 2 * W) for (int it = 0; it < 2; ++it) { const int p = p2 >> 1; topk_attn_unit(P_Z, P_KIT, P_YS + (size_t)MG * 256, lds, b, it ? p : 127 - p, wave, lane, pr_acc); } }
                }
            }
            SEAM(sg + 2);
            if (RUN(sg + 3) && !(MK_SKIP & 1)) { STEP_IDS STEP_L STEP_G
                LinPar LP{P_Z, IN(12) + l * 16 * 128, IN(13) + l * 128, IN(15), l};
                constexpr int U_LIN = GB * NCH * 2;
                for (int rp = 0; rp < ((MK_REPEAT & 2) ? 2 : 1); ++rp)
                for (int u = vcu; u < 2 * U_LIN; u += G) {
                    if (u < U_LIN) { if (!(MK_SKIP & 16)) lin2_unit<32, 1>(LP, P_STC, nullptr, IN(14) + l * 64, P_YS + (size_t)2 * MG * 256, lds, u, wave); }
                    else { if (!(MK_SKIP & 32)) lin2_unit<64, 1>(LP, P_STD, nullptr, IN(16) + l * 64, P_YS + (size_t)3 * MG * 256, lds, u - U_LIN, wave); }
                }
            }
            SEAM(sg + 3);
            if (RUN(sg + 4) && !(MK_SKIP & 1)) { STEP_IDS STEP_L STEP_G
                pg8::Gemm gm{(const bf16*)(P_YS), (const bf16*)((const GAS bf16*)(ws + WS_WBO) + (size_t)l * 4 * 1024 * 256), 4 * MG, 4 * 1024, 256};
                GatedOrder S; S.init(G, bx);
                EpiGated E{P_GT, P_H + (size_t)g * MG * DM};
                for (int rp = 0; rp < ((MK_REPEAT & 32) ? 2 : 1); ++rp) pg8::gemm_phase<EpiGated, GatedOrder, true, true>(lds, gm, S, E, tid);
            }
            SEAM(sg + 4);
        }
        if (RUN(sb + 11) && !(MK_SKIP & 1)) { STEP_IDS STEP_L
            pg8::Gemm gm{(const bf16*)(P_H), (const bf16*)((const GAS bf16*)(ws + WS_WO) + (size_t)l * 1024 * 1024), M_ALL, 1024, 1024};
            pg8::StaticOrder S; S.init(M_ALL, 1024, G, bx);
            if (l == 0) { EpiResid<true> E{IN(0), P_XR, P_CMOD + (size_t)l * NB * 6144 + 2048}; pg8::gemm_phase<EpiResid<true>, pg8::StaticOrder, true, true>(lds, gm, S, E, tid); }
            else { EpiResid<false> E{P_XR, P_XR, P_CMOD + (size_t)l * NB * 6144 + 2048}; pg8::gemm_phase<EpiResid<false>, pg8::StaticOrder, true, true>(lds, gm, S, E, tid); }
        }
        SEAM(sb + 11);
        if (RUN(sb + 12) && !(MK_SKIP & 2)) { STEP_IDS STEP_L
            norm_rows<false>(P_XR, P_H, IN(6) + l * DM, P_CMOD + (size_t)l * NB * 6144, 3072, 4096, gw, NGW, lane); }
        SEAM(sb + 12);
        if (RUN(sb + 13) && !(MK_SKIP & 2)) { STEP_IDS STEP_L
            pg8::Gemm gm{(const bf16*)(P_H), (const bf16*)((const GAS bf16*)(ws + WS_W1) + (size_t)l * DFF * 1024), M_ALL, DFF, 1024};
            pg8::StaticOrder S; S.init(M_ALL, DFF, G, bx);
            EpiRelu2 E{P_U};
            for (int rp = 0; rp < ((MK_REPEAT & 16) ? 2 : 1); ++rp) pg8::gemm_phase<EpiRelu2, pg8::StaticOrder, true, true>(lds, gm, S, E, tid);
        }
        SEAM(sb + 13);
        if (RUN(sb + 14) && !(MK_SKIP & 2)) { STEP_IDS STEP_L
            pg8::Gemm gm{(const bf16*)(P_U), (const bf16*)((const GAS bf16*)(ws + WS_W2) + (size_t)l * 1024 * DFF), M_ALL, 1024, DFF};
            pg8::StaticOrder S; S.init(M_ALL, 1024, G, bx);
            EpiResid<false> E{P_XR, P_XR, P_CMOD + (size_t)l * NB * 6144 + 5120};
            pg8::gemm_phase<EpiResid<false>, pg8::StaticOrder, true, true>(lds, gm, S, E, tid);
        }
        SEAM(sb + 14);
    }
    if (RUN(31)) { STEP_IDS
        float oscale = 1.0f;
        if (MK_PROBE) { const unsigned long long tt_ = __builtin_amdgcn_s_memrealtime() - pr_start; oscale = 1.0f + (float)pr_acc / ((float)tt_ * (float)MK_PROBE_DIV); }
        final_norm_rows(P_XR, ((GAS float*)a.out), IN(21), gw, NGW, lane, oscale); }
#undef RUN
#undef SEAM
}

extern "C" void kernel_launch(void* const* d_in, const int* in_sizes, int n_in, void* d_out, int out_size, void* d_ws, size_t ws_size, hipStream_t stream) {
    static int grid = 0;
    if (grid == 0) {
        if (n_in != 22 || out_size != M_ALL * DM || ws_size < WS_END) { fprintf(stderr, "kernel_launch: unexpected problem shape (n_in %d out %d ws %zu)\n", n_in, out_size, ws_size); grid = -1; return; }
        int dev = 0, cus = 0, per_cu = 0;
        if (hipGetDevice(&dev) != hipSuccess || hipDeviceGetAttribute(&cus, hipDeviceAttributeMultiprocessorCount, dev) != hipSuccess) { grid = -1; return; }
        if (hipFuncSetAttribute((const void*)mega_fwd, hipFuncAttributeMaxDynamicSharedMemorySize, LDS_BYTES) != hipSuccess) { fprintf(stderr, "kernel_launch: hipFuncSetAttribute failed\n"); grid = -1; return; }
        if (hipOccupancyMaxActiveBlocksPerMultiprocessor(&per_cu, (const void*)mega_fwd, NTHREADS, LDS_BYTES) != hipSuccess || per_cu < 1) fprintf(stderr, "kernel_launch: occupancy query reports %d\n", per_cu);
        (void)hipGetLastError();
        grid = cus;
    }
    if (grid < 0) return;
    (void)hipMemsetAsync((char*)d_ws + WS_CTL, 0, CTL_ZERO_BYTES, stream);
    KArgs a{};
    for (int i = 0; i < 22; ++i) a.in[i] = d_in[i];
    a.out = (float*)d_out; a.ws = (unsigned char*)d_ws; a.pad = 0;
#if MK_N_LAUNCHES == 1
    a.step_lo = 0; a.step_hi = N_STEPS; a.li = 0;
    hipLaunchKernelGGL(mega_fwd, dim3(grid), dim3(NTHREADS), LDS_BYTES, stream, a);
#else
    for (int s = 0; s < N_STEPS; ++s) { a.step_lo = s; a.step_hi = s + 1; a.li = s;
        hipLaunchKernelGGL(mega_fwd, dim3(grid), dim3(NTHREADS), LDS_BYTES, stream, a); }
#endif
}
```

```cpp
#include <hip/hip_runtime.h>
#include <cstdio>
#include <cstdint>

namespace pg8 {
#define PG8_LAS __attribute__((address_space(3)))
typedef unsigned short bf16_t;
typedef short bf16x8 __attribute__((ext_vector_type(8)));
typedef float f32x4 __attribute__((ext_vector_type(4)));
typedef unsigned u32x4 __attribute__((ext_vector_type(4)));
constexpr int BM = 256, BK = 64, HALF = 128, HTB = HALF * BK * 2  , STAGE_BYTES = 8 * HTB, NXCD = 8, WGM = 8;

__host__ __device__ __forceinline__ int lds_byte(int r, int c) { const int st = (r >> 4) * 2 + (c >> 5), rr = r & 15, cc = c & 31, ob = rr * 64 + cc * 2; return st * 1024 + (ob ^ (((ob >> 9) & 1) << 5)); }
__host__ __device__ __forceinline__ void stage_rc(int b, int& R, int& C) { const int st = b / 1024, sb = b % 1024, swz = sb ^ (((sb >> 9) & 1) << 5); R = (st >> 1) * 16 + swz / 64; C = (st & 1) * 32 + (swz % 64) / 2; }
__host__ __device__ __forceinline__ int perm32(int rho) { const int n = rho >> 4, i = rho & 15; return 8 * (i >> 2) + 4 * n + (i & 3); }

struct Unit { int pm, pn; };
struct Gemm { const bf16_t* A; const bf16_t* Bt; int M, N, K; };

struct StaticOrder {
    int nM, nN, nwg, G, c;
    __host__ __device__ void init(int M, int N, int G_, int c_) { nM = M / BM; nN = N / BM; nwg = nM * nN; G = G_; c = c_; }
    __host__ __device__ bool next(int i, Unit& u) const {
        const long L = (long)i * G + c; if (L >= nwg) return false;
        int wgid = (int)L; { const int q = nwg / NXCD, r = nwg % NXCD, xcd = wgid % NXCD, off = wgid / NXCD; wgid = (xcd < r ? xcd * (q + 1) : r * (q + 1) + (xcd - r) * q) + off; }
        const int nig = WGM * nN, gid = wgid / nig, fm = gid * WGM, gsz = (nM - fm) < WGM ? (nM - fm) : WGM;
        u.pm = fm + ((wgid % nig) % gsz); u.pn = (wgid % nig) / gsz; return true;
    }
    __device__ __forceinline__ void a_ready(const Unit&) const {}
    __device__ __forceinline__ void done(const Unit&) const {}
};
__device__ __forceinline__ unsigned cvt_pk_bf16(float lo, float hi) { typedef __bf16 bf16pair_ __attribute__((ext_vector_type(2))); const bf16pair_ v = {(__bf16)lo, (__bf16)hi}; return __builtin_bit_cast(unsigned, v); }
typedef float f32x2 __attribute__((ext_vector_type(2)));
template <class Epi, class Sched, bool ALIGN_EPI = false, bool SP2 = false>
__device__ __forceinline__ void gemm_phase(PG8_LAS unsigned char* lds, const Gemm g, const Sched& S, const Epi& E, int tid_in) {
    int tid_l = tid_in; asm volatile("" : "+v"(tid_l));
    const int tid = tid_l, wid = __builtin_amdgcn_readfirstlane(tid >> 6), lane = tid & 63, wr = wid >> 2, wc = wid & 3, fr = lane & 15, fq = lane >> 4;
    const int K = g.K, nt = K / BK;
    unsigned voffA[2], voffB[2];
#pragma unroll
    for (int i = 0; i < 2; ++i) { int R, C; stage_rc(tid * 16 + i * 8192, R, C); const int Rb = Epi::PERM ? ((R & ~31) + perm32(R & 31)) : R;
        voffA[i] = (unsigned)(R * K + C) * 2u; voffB[i] = (unsigned)(Rb * K + C) * 2u; }
    const size_t kstep = (size_t)(BK * 2);
    const size_t hstep = (size_t)HALF * K * 2;
    const size_t tstep = 2 * hstep;
    const unsigned ldsw = (unsigned)wid * 1024u;
    const int aoff = lds_byte(wr * 64 + fr, fq * 8), boff = lds_byte(wc * 32 + fr, fq * 8);
#define PG8_SA(b, h) (((b) * 2 + (h)) * HTB)
#define PG8_SB(b, h) ((4 + (b) * 2 + (h)) * HTB)
#define PG8_STAGE(bufoff, gbase, voff) do { _Pragma("unroll") for (int _i = 0; _i < 2; ++_i) \
        __builtin_amdgcn_global_load_lds((const unsigned*)((const char*)(gbase) + (voff)[_i]), (PG8_LAS unsigned*)(lds + (bufoff) + ldsw + _i * 8192), 16, 0, 0); } while (0)
#define PG8_LDA(dst, b, h) do { _Pragma("unroll") for (int m = 0; m < 4; ++m) _Pragma("unroll") for (int k = 0; k < 2; ++k) dst[m][k] = *(const PG8_LAS bf16x8*)(lds + PG8_SA(b, h) + aoff + m * 2048 + k * 1024); } while (0)
#define PG8_LDB(dst, b, h) do { _Pragma("unroll") for (int n = 0; n < 2; ++n) _Pragma("unroll") for (int k = 0; k < 2; ++k) dst[n][k] = *(const PG8_LAS bf16x8*)(lds + PG8_SB(b, h) + boff + n * 2048 + k * 1024); } while (0)
#define PG8_MMA(ai, bj, At, Bt) do { __builtin_amdgcn_s_setprio(1); _Pragma("unroll") for (int m = 0; m < 4; ++m) _Pragma("unroll") for (int n = 0; n < 2; ++n) _Pragma("unroll") for (int k = 0; k < 2; ++k) \
        acc[ai][bj][m][n] = __builtin_amdgcn_mfma_f32_16x16x32_bf16(Bt[n][k], At[m][k], acc[ai][bj][m][n], 0, 0, 0); __builtin_amdgcn_s_setprio(0); } while (0)
#define PG8_WAIT_V(n) asm volatile("s_waitcnt vmcnt(" #n ")" ::: "memory")
#define PG8_WAIT_L(n) asm volatile("s_waitcnt lgkmcnt(" #n ")" ::: "memory")
#define PG8_BAR __builtin_amdgcn_s_barrier()
#define PG8_SCHED __builtin_amdgcn_sched_barrier(0)
    Unit cur, nxt; int ui = 0;
    if (!S.next(0, cur)) return;
    f32x4 acc[2][2][4][2];
#pragma unroll
    for (int a = 0; a < 2; ++a)
#pragma unroll
        for (int b = 0; b < 2; ++b)
#pragma unroll
            for (int m = 0; m < 4; ++m)
#pragma unroll
                for (int n = 0; n < 2; ++n) acc[a][b][m][n] = (f32x4){0.f, 0.f, 0.f, 0.f};
    bf16x8 At[4][2], B0[2][2], B1[2][2];
    const char* cA = (const char*)g.A + (size_t)cur.pm * tstep; const char* cB = (const char*)g.Bt + (size_t)cur.pn * tstep;
    S.a_ready(cur);
    if constexpr (SP2) {
        PG8_STAGE(PG8_SB(0, 0), cB, voffB); PG8_STAGE(PG8_SB(0, 1), cB + hstep, voffB); PG8_STAGE(PG8_SA(0, 0), cA, voffA); PG8_STAGE(PG8_SA(0, 1), cA + hstep, voffA);
        if (wr == 1) PG8_BAR;
        PG8_WAIT_V(2); PG8_BAR;
        PG8_STAGE(PG8_SB(1, 0), cB + kstep, voffB); PG8_STAGE(PG8_SA(1, 0), cA + kstep, voffA); PG8_STAGE(PG8_SB(1, 1), cB + hstep + kstep, voffB);
        PG8_WAIT_V(6); PG8_BAR;
    } else {
        PG8_STAGE(PG8_SB(0, 0), cB, voffB); PG8_STAGE(PG8_SA(0, 0), cA, voffA); PG8_STAGE(PG8_SB(0, 1), cB + hstep, voffB); PG8_STAGE(PG8_SA(0, 1), cA + hstep, voffA);
        if (wr == 1) PG8_BAR;
        PG8_WAIT_V(4); PG8_BAR;
        PG8_STAGE(PG8_SB(1, 0), cB + kstep, voffB); PG8_STAGE(PG8_SA(1, 0), cA + kstep, voffA); PG8_STAGE(PG8_SB(1, 1), cB + hstep + kstep, voffB);
        PG8_WAIT_V(6); PG8_BAR;
    }
    for (;;) {
        const bool has_next = S.next(ui + 1, nxt);
        const char* nA = has_next ? (const char*)g.A + (size_t)nxt.pm * tstep : cA; const char* nB = has_next ? (const char*)g.Bt + (size_t)nxt.pn * tstep : cB;
        for (int t = 0; t < nt; t += 2) {
            const bool last = (t == nt - 2);
            const char* a1 = cA + (size_t)(t + 1) * kstep;
            const char* a2 = last ? nA : cA + (size_t)(t + 2) * kstep; const char* b2 = last ? nB : cB + (size_t)(t + 2) * kstep;
            const char* a3 = a2 + kstep; const char* b3 = b2 + kstep;
            if (last && has_next) S.a_ready(nxt);
            if constexpr (SP2) {
            PG8_LDB(B0, 0, 0); PG8_LDB(B1, 0, 1); PG8_SCHED; PG8_LDA(At, 0, 0); PG8_STAGE(PG8_SA(1, 1), a1 + hstep, voffA);
            PG8_WAIT_V(8); PG8_WAIT_L(0); PG8_BAR; PG8_MMA(0, 0, At, B0); PG8_MMA(0, 1, At, B1); PG8_BAR; PG8_SCHED;
            PG8_LDA(At, 0, 1); PG8_STAGE(PG8_SB(0, 0), b2, voffB); PG8_STAGE(PG8_SB(0, 1), b2 + hstep, voffB); PG8_STAGE(PG8_SA(0, 0), a2, voffA);
            PG8_WAIT_V(8); PG8_WAIT_L(0); PG8_BAR; PG8_MMA(1, 0, At, B0); PG8_MMA(1, 1, At, B1); PG8_BAR; PG8_SCHED;
            PG8_LDB(B0, 1, 0); PG8_LDB(B1, 1, 1); PG8_SCHED; PG8_LDA(At, 1, 0); PG8_STAGE(PG8_SA(0, 1), a2 + hstep, voffA);
            PG8_WAIT_V(8); PG8_WAIT_L(0); PG8_BAR; PG8_MMA(0, 0, At, B0); PG8_MMA(0, 1, At, B1); PG8_BAR; PG8_SCHED;
            PG8_LDA(At, 1, 1); PG8_STAGE(PG8_SB(1, 0), b3, voffB); PG8_STAGE(PG8_SB(1, 1), b3 + hstep, voffB); PG8_STAGE(PG8_SA(1, 0), a3, voffA);
            PG8_WAIT_V(8); PG8_WAIT_L(0); PG8_BAR; PG8_MMA(1, 0, At, B0); PG8_MMA(1, 1, At, B1); PG8_BAR; PG8_SCHED;
            } else {
            PG8_LDB(B0, 0, 0); PG8_SCHED; PG8_LDA(At, 0, 0); PG8_STAGE(PG8_SA(1, 1), a1 + hstep, voffA);
            PG8_WAIT_L(8); PG8_BAR; PG8_WAIT_L(0); PG8_MMA(0, 0, At, B0); PG8_BAR; PG8_SCHED;
            PG8_LDB(B1, 0, 1); PG8_STAGE(PG8_SB(0, 0), b2, voffB);
            PG8_BAR; PG8_WAIT_L(0); PG8_MMA(0, 1, At, B1); PG8_BAR;
            PG8_LDA(At, 0, 1); PG8_STAGE(PG8_SA(0, 0), a2, voffA);
            PG8_BAR; PG8_WAIT_L(0); PG8_MMA(1, 0, At, B0); PG8_BAR; PG8_SCHED;
            PG8_STAGE(PG8_SB(0, 1), b2 + hstep, voffB);
            PG8_WAIT_V(6); PG8_BAR; PG8_MMA(1, 1, At, B1); PG8_BAR;
            PG8_LDB(B0, 1, 0); PG8_SCHED; PG8_LDA(At, 1, 0); PG8_STAGE(PG8_SA(0, 1), a2 + hstep, voffA);
            PG8_WAIT_L(8); PG8_BAR; PG8_WAIT_L(0); PG8_MMA(0, 0, At, B0); PG8_BAR; PG8_SCHED;
            PG8_LDB(B1, 1, 1); PG8_STAGE(PG8_SB(1, 0), b3, voffB);
            PG8_BAR; PG8_WAIT_L(0); PG8_MMA(0, 1, At, B1); PG8_BAR;
            PG8_LDA(At, 1, 1); PG8_STAGE(PG8_SA(1, 0), a3, voffA);
            PG8_BAR; PG8_WAIT_L(0); PG8_MMA(1, 0, At, B0); PG8_BAR; PG8_SCHED;
            PG8_STAGE(PG8_SB(1, 1), b3 + hstep, voffB);
            PG8_WAIT_V(6); PG8_BAR; PG8_MMA(1, 1, At, B1); PG8_BAR;
            }
        }
        if constexpr (ALIGN_EPI) { if (wr == 0) PG8_BAR; }
        if constexpr (!Epi::AFTER_DRAIN) { unsigned o_ = ~0u; asm volatile("" : "+s"(o_)); const int l_ = (int)__builtin_amdgcn_mbcnt_hi(o_, __builtin_amdgcn_mbcnt_lo(o_, 0u));
            E(acc, cur, wr, wc, l_ & 15, l_ >> 4); S.done(cur); }
        if (!has_next) break;
        if (!E.keep_acc(cur)) {
#pragma unroll
        for (int a = 0; a < 2; ++a)
#pragma unroll
            for (int b = 0; b < 2; ++b)
#pragma unroll
                for (int m = 0; m < 4; ++m)
#pragma unroll
                    for (int n = 0; n < 2; ++n) acc[a][b][m][n] = (f32x4){0.f, 0.f, 0.f, 0.f};
        }
        cur = nxt; cA = nA; cB = nB; ++ui;
        if constexpr (ALIGN_EPI) { if (wr == 1) PG8_BAR; }
    }
    PG8_WAIT_V(0);
    if constexpr (!ALIGN_EPI) { if (wr == 0) PG8_BAR; }
    PG8_BAR;
    if constexpr (Epi::AFTER_DRAIN) { E.fused(acc, cur, wr, wc, fr, fq, lds, wid, lane); S.done(cur); }
#undef PG8_SA
#undef PG8_SB
#undef PG8_STAGE
#undef PG8_LDA
#undef PG8_LDB
#undef PG8_MMA
#undef PG8_WAIT_V
#undef PG8_WAIT_L
#undef PG8_BAR
#undef PG8_SCHED
}
}

#ifndef MK_N_LAUNCHES
#define MK_N_LAUNCHES 1
#endif
#ifndef MK_REPEAT
#define MK_REPEAT 0
#endif
#ifndef MK_PROBE
#define MK_PROBE 0
#endif
#ifndef MK_PROBE_DIV
#define MK_PROBE_DIV 1
#endif
#ifndef MK_SKIP
#define MK_SKIP 0
#endif
constexpr int NB = 8, SEQ = 8192, DM = 1024, NL = 2, BW = 256, DFF = 4096;
constexpr int M_ALL = NB * SEQ;
constexpr int NGRP = 2, GB = NB / NGRP;
constexpr int MG = GB * SEQ;
constexpr int N_IN = 7124, NV = 7168, ZLD = 3072, GLD = 4096;
constexpr int NCH = SEQ / 64;
constexpr float EPS = 1e-6f;
constexpr int ZA_VAL = 0, ZA_GATE = 256, ZB_Q = 512, ZB_K = 768, ZB_V = 832, ZB_QI = 896, ZB_KI = 1152, ZB_WI = 1216;
constexpr int ZC_Q = 1224, ZC_K = 1352, ZC_V = 1480, ZC_OG = 1736, ZC_GLR = 1992, ZD_F = 2008, ZD_Q = 2264, ZD_I = 2520, ZD_OG = 2776;
__host__ __device__ __forceinline__ int win_src(int j) { if (j < 1220) return j; if (j < 1224) return -1; if (j < 3032) return j - 4; if (j < 3072) return -1;
    const int gi = j - 3072, q = gi >> 8, t = gi & 255; const int nbr = 2 * (t >> 7) + ((t >> 2) & 1), x = ((t >> 5) & 3) * 16 + ((t >> 3) & 3) * 4 + (t & 3);
    return 3028 + nbr * 1024 + 64 * q + x; }

constexpr size_t MiB = 1u << 20;
constexpr size_t WS_CTL = 0, CTL_ZERO_BYTES = 1 * MiB;
constexpr size_t WS_CMOD = 1 * MiB;
constexpr size_t WS_ROPE = 1 * MiB + 512 * 1024;
constexpr size_t WS_WIN = 4 * MiB;
constexpr size_t WS_WBO = 32 * MiB;
constexpr size_t WS_WO = 36 * MiB;
constexpr size_t WS_W1 = 40 * MiB;
constexpr size_t WS_W2 = 56 * MiB;
constexpr size_t WS_H = 76 * MiB;
constexpr size_t WS_Z = 204 * MiB;
constexpr size_t WS_GATES = 396 * MiB;
constexpr size_t WS_YS = 652 * MiB;
constexpr size_t WS_MF32 = 716 * MiB;
constexpr size_t WS_STC = 844 * MiB;
constexpr size_t WS_STD = 860 * MiB;
constexpr size_t WS_DECC = 892 * MiB;
constexpr size_t WS_DECD = 893 * MiB;
constexpr size_t WS_U = 204 * MiB;
constexpr size_t WS_KIT = 896 * MiB;
constexpr size_t WS_END = 900 * MiB;
constexpr int CW_BAR = 4096;

constexpr int NWAVES = 8, NTHREADS = 512;
constexpr int LDS_BYTES = 163840, MISC_OFF = LDS_BYTES - 512;

#define GAS __attribute__((address_space(1)))
#define LAS __attribute__((address_space(3)))
typedef unsigned short bf16;
typedef unsigned v4u __attribute__((ext_vector_type(4)));
typedef unsigned v2u __attribute__((ext_vector_type(2)));
typedef float f32x4 __attribute__((ext_vector_type(4)));
typedef short bf16x8 __attribute__((ext_vector_type(8)));
typedef float f32x16 __attribute__((ext_vector_type(16)));
#define LDS_WAIT() asm volatile("s_waitcnt lgkmcnt(0)" ::: "memory")
#define VM_WAIT() asm volatile("s_waitcnt vmcnt(0)" ::: "memory")
__device__ __forceinline__ float bf2f(unsigned v) { return __uint_as_float(v << 16); }
__device__ __forceinline__ float bflo(unsigned w) { return __uint_as_float(w << 16); }
__device__ __forceinline__ float bfhi(unsigned w) { return __uint_as_float(w & 0xffff0000u); }
typedef __bf16 bf16pair_t __attribute__((ext_vector_type(2)));
__device__ __forceinline__ unsigned pk2(float lo, float hi) { const bf16pair_t v = {(__bf16)lo, (__bf16)hi}; return __builtin_bit_cast(unsigned, v); }
__device__ __forceinline__ unsigned f2bf(float f) { return (unsigned)__builtin_bit_cast(unsigned short, (__bf16)f); }
template <int M> __device__ __forceinline__ float swz_xor(float v) { return __builtin_bit_cast(float, __builtin_amdgcn_ds_swizzle(__builtin_bit_cast(int, v), 0x1F | (M << 10))); }
__device__ __forceinline__ float half_sum(float v) { const unsigned u = __builtin_bit_cast(unsigned, v); auto r = __builtin_amdgcn_permlane32_swap(u, u, false, false);
    return __builtin_bit_cast(float, (unsigned)r[0]) + __builtin_bit_cast(float, (unsigned)r[1]); }
__device__ __forceinline__ float half_max(float v) { const unsigned u = __builtin_bit_cast(unsigned, v); auto r = __builtin_amdgcn_permlane32_swap(u, u, false, false);
    return fmaxf(__builtin_bit_cast(float, (unsigned)r[0]), __builtin_bit_cast(float, (unsigned)r[1])); }
__device__ __forceinline__ float wave_sum(float v) { v += swz_xor<1>(v); v += swz_xor<2>(v); v += swz_xor<4>(v); v += swz_xor<8>(v); v += swz_xor<16>(v); return half_sum(v); }
__device__ __forceinline__ float wave_max(float v) { v = fmaxf(v, swz_xor<1>(v)); v = fmaxf(v, swz_xor<2>(v)); v = fmaxf(v, swz_xor<4>(v)); v = fmaxf(v, swz_xor<8>(v)); v = fmaxf(v, swz_xor<16>(v)); return half_max(v); }
__device__ __forceinline__ float sigm(float x) { return __builtin_amdgcn_rcpf(1.0f + __expf(-x)); }
__device__ __forceinline__ float siluf(float x) { return x * sigm(x); }
__device__ __forceinline__ float logsigm(float x) { return fminf(x, 0.f) - __logf(1.0f + __expf(-fabsf(x))); }

#define XB_TMO      128
#define XB_XCNT(j)  (256  + 64 * (j))
#define XB_XSUB(j)  (1280 + 64 * (j))
#define XB_XGEN(j)  (2304 + 64 * (j))
#define XB_TOP      3328
#define XB_TOPGEN   3392
#define XCD_BAR_WORDS 3456
#define XB_SPIN_CAP (1u << 18)
__device__ __forceinline__ unsigned xb_ld(unsigned* p)              { return __hip_atomic_load(p, __ATOMIC_RELAXED, __HIP_MEMORY_SCOPE_AGENT); }
__device__ __forceinline__ unsigned xb_add(unsigned* p, unsigned v) { return __hip_atomic_fetch_add(p, v, __ATOMIC_RELAXED, __HIP_MEMORY_SCOPE_AGENT); }
__device__ __forceinline__ unsigned xb_xcc_id() { return (unsigned)__builtin_amdgcn_s_getreg((3 << 11) | 20) & 0xFu; }
#define XB_SPIN(cond, bar) do { unsigned _sp = 0; while (cond) { __builtin_amdgcn_s_sleep(1); \
    if ((++_sp & 255u) == 0u) { if (xb_ld(&(bar)[XB_TMO])) break; if (_sp > XB_SPIN_CAP) { atomicAdd(&(bar)[XB_TMO], 1u); break; } } } } while (0)
struct XcdBarrier { unsigned* bar; unsigned x; volatile LAS unsigned* st; };
__device__ __forceinline__ XcdBarrier xcd_barrier_post(unsigned* bar, volatile LAS unsigned* st) {
    XcdBarrier b; b.bar = bar; b.x = xb_xcc_id(); b.st = st;
    if (threadIdx.x == 0) (void)xb_add(&bar[XB_XCNT(b.x)], 1u);
    return b;
}
__device__ __forceinline__ void xcd_barrier_complete(unsigned* bar, unsigned x, unsigned& nloc, unsigned& nx) {
    const unsigned G = gridDim.x * gridDim.y * gridDim.z;
    unsigned sum, cnt, mine, sp = 0u;
    for (;;) {
        sum = 0u; cnt = 0u; mine = 0u;
#pragma unroll
        for (unsigned j = 0; j < 16; ++j) { const unsigned c = xb_ld(&bar[XB_XCNT(j)]); sum += c; cnt += (c > 0u) ? 1u : 0u; mine = (j == x) ? c : mine; }
        if (sum == G) break;
        __builtin_amdgcn_s_sleep(1);
        if ((++sp & 255u) == 0u) { if (xb_ld(&bar[XB_TMO])) break; if (sp > XB_SPIN_CAP) { atomicAdd(&bar[XB_TMO], 1u); break; } }
    }
    nloc = mine > 0u ? mine : 1u; nx = cnt > 0u ? cnt : 1u;
}
__device__ __forceinline__ void xcd_barrier(const XcdBarrier& b) {
    asm volatile("s_waitcnt vmcnt(0)" ::: "memory");
    __syncthreads();
    if (threadIdx.x == 0) {
        unsigned* bar = b.bar;
        __builtin_amdgcn_s_waitcnt(0);
        unsigned nloc = b.st[0], nx = b.st[1];
        if (nloc == 0u) { xcd_barrier_complete(bar, b.x, nloc, nx); b.st[0] = nloc; b.st[1] = nx; }
        const unsigned old = xb_add(&bar[XB_XSUB(b.x)], 1u);
        const unsigned gen = old / nloc;
        if (old + 1u == (gen + 1u) * nloc) {
            __builtin_amdgcn_fence(__ATOMIC_RELEASE, "agent");
            asm volatile("s_waitcnt vmcnt(0)" ::: "memory");
            const unsigned og = xb_add(&bar[XB_TOP], 1u);
            const unsigned tg = og / nx;
            if (og + 1u == (tg + 1u) * nx) xb_add(&bar[XB_TOPGEN], 1u);
            else XB_SPIN(xb_ld(&bar[XB_TOPGEN]) == tg, bar);
            __builtin_amdgcn_fence(__ATOMIC_ACQUIRE, "agent");
            xb_add(&bar[XB_XGEN(b.x)], 1u);
            asm volatile("s_waitcnt vmcnt(0)" ::: "memory");
        } else {
            XB_SPIN(xb_ld(&bar[XB_XGEN(b.x)]) == gen, bar);
            __builtin_amdgcn_fence(__ATOMIC_ACQUIRE, "agent");
            asm volatile("s_waitcnt vmcnt(0)" ::: "memory");
        }
    }
    __syncthreads();
}

struct EpiZ {
    static constexpr bool PERM = true, AFTER_DRAIN = false;
    __device__ __forceinline__ bool keep_acc(const pg8::Unit&) const { return false; }
    GAS bf16* Z; GAS bf16* Gt;
    __device__ __forceinline__ void operator()(const pg8::f32x4 (&acc)[2][2][4][2], const pg8::Unit& u, int wr, int wc, int fr_, int fq_) const {
        int fr = fr_, fq = fq_; asm volatile("" : "+v"(fr), "+v"(fq));
        if (u.pn < 12) {
            const int row0 = u.pm * 256 + wr * 64 + fr, col0 = u.pn * 256 + wc * 32 + 8 * fq;
#pragma unroll
            for (int ai = 0; ai < 2; ++ai)
#pragma unroll
                for (int m = 0; m < 4; ++m) { GAS bf16* rowp = Z + (size_t)(row0 + ai * 128 + m * 16) * ZLD + col0;
#pragma unroll
                    for (int bj = 0; bj < 2; ++bj) { const pg8::f32x4 v0 = acc[ai][bj][m][0], v1 = acc[ai][bj][m][1];
                        pg8::u32x4 w; w.x = pg8::cvt_pk_bf16(v0[0], v0[1]); w.y = pg8::cvt_pk_bf16(v0[2], v0[3]); w.z = pg8::cvt_pk_bf16(v1[0], v1[1]); w.w = pg8::cvt_pk_bf16(v1[2], v1[3]);
                        __builtin_nontemporal_store(w, (GAS pg8::u32x4*)(rowp + bj * 128)); } }
        } else {
            const int tid = (wr * 4 + wc) * 64 + fq * 16 + fr;
            GAS unsigned char* tb = (GAS unsigned char*)Gt + (size_t)(u.pm * 16 + (u.pn - 12)) * 131072 + tid * 8;
#pragma unroll
            for (int ai = 0; ai < 2; ++ai)
#pragma unroll
                for (int m = 0; m < 4; ++m) { float p0[4], p1[4], p2[4], p3[4];
#pragma unroll
                    for (int j = 0; j < 4; ++j) {
                        const float d0 = fminf(1.0f + __expf(-acc[ai][0][m][0][j]), 1e30f), d1 = fminf(1.0f + __expf(-acc[ai][0][m][1][j]), 1e30f);
                        const float d2 = fminf(1.0f + __expf(-acc[ai][1][m][0][j]), 1e30f), d3 = fminf(1.0f + __expf(-acc[ai][1][m][1][j]), 1e30f);
                        const float i0 = __builtin_amdgcn_rcpf(d0), i1 = __builtin_amdgcn_rcpf(d1), i2 = __builtin_amdgcn_rcpf(d2), i3 = __builtin_amdgcn_rcpf(d3);
                        p0[j] = d1 * i0; p1[j] = d2 * i1; p2[j] = d3 * i2; p3[j] = i3; }
                    GAS unsigned char* cb = tb + (ai * 4 + m) * 4096;
                    __builtin_nontemporal_store((v2u){pg8::cvt_pk_bf16(p0[0], p0[1]), pg8::cvt_pk_bf16(p0[2], p0[3])}, (GAS v2u*)(cb));
                    __builtin_nontemporal_store((v2u){pg8::cvt_pk_bf16(p1[0], p1[1]), pg8::cvt_pk_bf16(p1[2], p1[3])}, (GAS v2u*)(cb + 32768));
                    __builtin_nontemporal_store((v2u){pg8::cvt_pk_bf16(p2[0], p2[1]), pg8::cvt_pk_bf16(p2[2], p2[3])}, (GAS v2u*)(cb + 2 * 32768));
                    __builtin_nontemporal_store((v2u){pg8::cvt_pk_bf16(p3[0], p3[1]), pg8::cvt_pk_bf16(p3[2], p3[3])}, (GAS v2u*)(cb + 3 * 32768)); }
        }
    }
};
struct EpiGated {
    static constexpr bool PERM = true, AFTER_DRAIN = false;
    const GAS bf16* Gt; GAS bf16* Mo;
    __device__ __forceinline__ bool keep_acc(const pg8::Unit& u) const { return (u.pn >> 2) < 3; }
    __device__ __forceinline__ void operator()(pg8::f32x4 (&acc)[2][2][4][2], const pg8::Unit& u, int wr, int wc, int fr_, int fq_) const {
        int fr = fr_, fq = fq_; asm volatile("" : "+v"(fr), "+v"(fq));
        const int nb = u.pn >> 2;
        const int row0 = (u.pm - nb * (MG / 256)) * 256 + wr * 64 + fr, col0 = (u.pn & 3) * 256 + wc * 32 + 8 * fq;
        const int tz = (wr * 4 + 2 * (wc & 1) + (fq >> 1)) * 64 + (2 * (fq & 1)) * 16 + fr;
        const GAS unsigned char* tb = (const GAS unsigned char*)Gt + ((size_t)((u.pm - nb * (MG / 256)) * 16 + 4 * (u.pn & 3) + (wc >> 1)) * 4 + nb) * 32768 + tz * 8;
        v2u gf[2][4][2][2];
#pragma unroll
        for (int ai = 0; ai < 2; ++ai)
#pragma unroll
            for (int m = 0; m < 4; ++m)
#pragma unroll
                for (int bj = 0; bj < 2; ++bj)
#pragma unroll
                    for (int n = 0; n < 2; ++n) gf[ai][m][bj][n] = *(const GAS v2u*)(tb + (unsigned)(bj * (2 * 131072) + (ai * 4 + m) * 4096 + n * 128));
#pragma unroll
        for (int ai = 0; ai < 2; ++ai)
#pragma unroll
            for (int m = 0; m < 4; ++m) { const unsigned r = (unsigned)(row0 + ai * 128 + m * 16);
#pragma unroll
                for (int bj = 0; bj < 2; ++bj) {
                    pg8::f32x4 v0 = acc[ai][bj][m][0], v1 = acc[ai][bj][m][1];
                    const v2u a0 = gf[ai][m][bj][0], a1 = gf[ai][m][bj][1];
                    v0[0] *= bflo(a0.x); v0[1] *= bfhi(a0.x); v0[2] *= bflo(a0.y); v0[3] *= bfhi(a0.y); v1[0] *= bflo(a1.x); v1[1] *= bfhi(a1.x); v1[2] *= bflo(a1.y); v1[3] *= bfhi(a1.y);
                    if (nb < 3) { acc[ai][bj][m][0] = v0; acc[ai][bj][m][1] = v1; }
                    else { const unsigned c = (unsigned)(col0 + bj * 128); v4u o; o.x = pg8::cvt_pk_bf16(v0[0], v0[1]); o.y = pg8::cvt_pk_bf16(v0[2], v0[3]); o.z = pg8::cvt_pk_bf16(v1[0], v1[1]); o.w = pg8::cvt_pk_bf16(v1[2], v1[3]);
                        *(GAS v4u*)(Mo + (r * 1024u + c)) = o; } } }
    }
};
template <bool BASE_F32> struct EpiResid {
    static constexpr bool PERM = true, AFTER_DRAIN = false;
    __device__ __forceinline__ bool keep_acc(const pg8::Unit&) const { return false; }
    const GAS void* base; GAS bf16* out; const GAS float* gv;
    __device__ __forceinline__ void operator()(const pg8::f32x4 (&acc)[2][2][4][2], const pg8::Unit& u, int wr, int wc, int fr_, int fq_) const {
        int fr = fr_, fq = fq_; asm volatile("" : "+v"(fr), "+v"(fq));
        const int row0 = u.pm * 256 + wr * 64 + fr, col0 = u.pn * 256 + wc * 32 + 8 * fq;
        const GAS float* gb = gv + (size_t)((u.pm * 256) / SEQ) * 6144 + col0;
        pg8::f32x4 g4[2][2];
#pragma unroll
        for (int bj = 0; bj < 2; ++bj)
#pragma unroll
            for (int n = 0; n < 2; ++n) g4[bj][n] = *(const GAS pg8::f32x4*)(gb + bj * 128 + n * 4);
        if constexpr (BASE_F32) {
#pragma unroll
            for (int ai = 0; ai < 2; ++ai) { pg8::f32x4 bs[4][2][2];
#pragma unroll
                for (int m = 0; m < 4; ++m) { const size_t off = (size_t)(row0 + ai * 128 + m * 16) * 1024 + col0;
#pragma unroll
                    for (int bj = 0; bj < 2; ++bj) { bs[m][bj][0] = *(const GAS pg8::f32x4*)((const GAS float*)base + off + bj * 128); bs[m][bj][1] = *(const GAS pg8::f32x4*)((const GAS float*)base + off + bj * 128 + 4); } }
                asm volatile("" ::: "memory");
#pragma unroll
                for (int m = 0; m < 4; ++m) { const size_t off = (size_t)(row0 + ai * 128 + m * 16) * 1024 + col0;
#pragma unroll
                    for (int bj = 0; bj < 2; ++bj) { const pg8::f32x4 v0 = bs[m][bj][0] + g4[bj][0] * acc[ai][bj][m][0], v1 = bs[m][bj][1] + g4[bj][1] * acc[ai][bj][m][1];
                        v4u o; o.x = pg8::cvt_pk_bf16(v0[0], v0[1]); o.y = pg8::cvt_pk_bf16(v0[2], v0[3]); o.z = pg8::cvt_pk_bf16(v1[0], v1[1]); o.w = pg8::cvt_pk_bf16(v1[2], v1[3]);
                        *(GAS v4u*)(out + off + bj * 128) = o; } }
                asm volatile("" ::: "memory"); }
        } else {
#pragma unroll
            for (int ai = 0; ai < 2; ++ai) { v4u bw[4][2];
#pragma unroll
                for (int m = 0; m < 4; ++m) { const size_t off = (size_t)(row0 + ai * 128 + m * 16) * 1024 + col0;
#pragma unroll
                    for (int bj = 0; bj < 2; ++bj) bw[m][bj] = *(const GAS v4u*)((const GAS bf16*)base + off + bj * 128); }
                asm volatile("" ::: "memory");
#pragma unroll
                for (int m = 0; m < 4; ++m) { const size_t off = (size_t)(row0 + ai * 128 + m * 16) * 1024 + col0;
#pragma unroll
                    for (int bj = 0; bj < 2; ++bj) { const v4u w = bw[m][bj];
                        const pg8::f32x4 b0 = (pg8::f32x4){bflo(w.x), bfhi(w.x), bflo(w.y), bfhi(w.y)}, b1 = (pg8::f32x4){bflo(w.z), bfhi(w.z), bflo(w.w), bfhi(w.w)};
                        const pg8::f32x4 v0 = b0 + g4[bj][0] * acc[ai][bj][m][0], v1 = b1 + g4[bj][1] * acc[ai][bj][m][1];
                        v4u o; o.x = pg8::cvt_pk_bf16(v0[0], v0[1]); o.y = pg8::cvt_pk_bf16(v0[2], v0[3]); o.z = pg8::cvt_pk_bf16(v1[0], v1[1]); o.w = pg8::cvt_pk_bf16(v1[2], v1[3]);
                        *(GAS v4u*)(out + off + bj * 128) = o; } }
                asm volatile("" ::: "memory"); }
        }
    }
};
struct EpiRelu2 {
    static constexpr bool PERM = true, AFTER_DRAIN = false;
    __device__ __forceinline__ bool keep_acc(const pg8::Unit&) const { return false; }
    GAS bf16* O;
    __device__ __forceinline__ void operator()(const pg8::f32x4 (&acc)[2][2][4][2], const pg8::Unit& u, int wr, int wc, int fr_, int fq_) const {
        int fr = fr_, fq = fq_; asm volatile("" : "+v"(fr), "+v"(fq));
        const int row0 = u.pm * 256 + wr * 64 + fr, col0 = u.pn * 256 + wc * 32 + 8 * fq;
#pragma unroll
        for (int ai = 0; ai < 2; ++ai)
#pragma unroll
            for (int m = 0; m < 4; ++m) { GAS bf16* rowp = O + (size_t)(row0 + ai * 128 + m * 16) * DFF + col0;
#pragma unroll
                for (int bj = 0; bj < 2; ++bj) { pg8::f32x4 v0 = acc[ai][bj][m][0], v1 = acc[ai][bj][m][1];
#pragma unroll
                    for (int j = 0; j < 4; ++j) { const float a = fmaxf(v0[j], 0.f), b = fmaxf(v1[j], 0.f); v0[j] = a * a; v1[j] = b * b; }
                    pg8::u32x4 w; w.x = pg8::cvt_pk_bf16(v0[0], v0[1]); w.y = pg8::cvt_pk_bf16(v0[2], v0[3]); w.z = pg8::cvt_pk_bf16(v1[0], v1[1]); w.w = pg8::cvt_pk_bf16(v1[2], v1[3]);
                    __builtin_nontemporal_store(w, (GAS pg8::u32x4*)(rowp + bj * 128)); } }
    }
};

template <bool MAPPED>
__device__ __forceinline__ void p0_item(const GAS float* W, int K, int ldw, GAS bf16* WT, LAS float* scr, int nblk, int item, int lane) {
    const int kb = item / nblk, nb = item % nblk, k0 = 64 * kb, n0 = 32 * nb;
    const int nv = n0 + (lane & 31); const int src = MAPPED ? win_src(nv) : nv;
    float wv_[32];
#pragma unroll
    for (int i = 0; i < 32; ++i) { const int kk = 2 * i + (lane >> 5); wv_[i] = (src >= 0) ? W[(size_t)(k0 + kk) * ldw + src] : 0.f; }
#pragma unroll
    for (int i = 0; i < 32; ++i) { const int kk = 2 * i + (lane >> 5); scr[kk * 33 + (lane & 31)] = wv_[i]; }
    LDS_WAIT(); asm volatile("" ::: "memory");
    const int c = lane & 7;
#pragma unroll
    for (int j = 0; j < 4; ++j) { const int n = (lane >> 3) + 8 * j; const LAS float* s = scr + (8 * c) * 33 + n;
        v4u o; o.x = pk2(s[0 * 33], s[1 * 33]); o.y = pk2(s[2 * 33], s[3 * 33]); o.z = pk2(s[4 * 33], s[5 * 33]); o.w = pk2(s[6 * 33], s[7 * 33]);
        *(GAS v4u*)(WT + (size_t)(n0 + n) * K + k0 + 8 * c) = o; }
    LDS_WAIT(); asm volatile("" ::: "memory");
}
__device__ __forceinline__ void p0_weights(const GAS float* w_in, const GAS float* w_bo, const GAS float* w_o, const GAS float* w1, const GAS float* w2, GAS unsigned char* ws, LAS unsigned char* lds, int gw, int NGW, int wave, int lane) {
    LAS float* scr = (LAS float*)(lds + wave * 8704);
    constexpr int I_IN = 16 * (NV / 32), I_BO = 4 * 32, I_O = 16 * 32, I_1 = 16 * 128, I_2 = 64 * 32;
    constexpr int NITEMS = NL * (I_IN + 4 * I_BO + I_O + I_1 + I_2);
    for (int it = gw; it < NITEMS; it += NGW) {
        int r = it;
        if (r < NL * I_IN) { const int l = r / I_IN; r -= l * I_IN; p0_item<true>(w_in + (size_t)l * 1024 * N_IN, 1024, N_IN, (GAS bf16*)(ws + WS_WIN) + (size_t)l * NV * 1024, scr, NV / 32, r, lane); continue; } r -= NL * I_IN;
        if (r < NL * 4 * I_BO) { const int ln = r / I_BO; r -= ln * I_BO; p0_item<false>(w_bo + (size_t)ln * 256 * 1024, 256, 1024, (GAS bf16*)(ws + WS_WBO) + (size_t)ln * 1024 * 256, scr, 32, r, lane); continue; } r -= NL * 4 * I_BO;
        if (r < NL * I_O) { const int l = r / I_O; r -= l * I_O; p0_item<false>(w_o + (size_t)l * 1024 * 1024, 1024, 1024, (GAS bf16*)(ws + WS_WO) + (size_t)l * 1024 * 1024, scr, 32, r, lane); continue; } r -= NL * I_O;
        if (r < NL * I_1) { const int l = r / I_1; r -= l * I_1; p0_item<false>(w1 + (size_t)l * 1024 * DFF, 1024, DFF, (GAS bf16*)(ws + WS_W1) + (size_t)l * DFF * 1024, scr, 128, r, lane); continue; } r -= NL * I_1;
        { const int l = r / I_2; r -= l * I_2; p0_item<false>(w2 + (size_t)l * DFF * 1024, DFF, 1024, (GAS bf16*)(ws + WS_W2) + (size_t)l * 1024 * DFF, scr, 32, r, lane); }
    }
}
__device__ __forceinline__ void p0_rope(GAS float* T, int gtid, int gstride) {
    for (int idx = gtid; idx < 16384 * 8; idx += gstride) {
        const int p = idx >> 3, j = idx & 7;
        const double inv = (j == 0) ? 1.0 : (j == 1) ? 0.19392274474868576 : (j == 2) ? 0.03760603093086393 : (j == 3) ? 0.007292664737217109 : (j == 4) ? 0.001414213562373095 :
                           (j == 5) ? 0.0002742481756762073 : (j == 6) ? 5.318295896944988e-05 : 1.031338537721246e-05;
        const double ang = (double)p * inv;
        const double n = __builtin_rint(ang * 0.15915494309189535);
        double r = __builtin_fma(-n, 6.283185307179586, ang); r = __builtin_fma(-n, 2.4492935982947064e-16, r);
        const double r2 = r * r;
        double s = 1.0, c = 1.0;
#pragma unroll
        for (int k = 14; k >= 1; --k) { s = 1.0 - r2 * s / (double)((2 * k) * (2 * k + 1)); c = 1.0 - r2 * c / (double)((2 * k - 1) * (2 * k)); }
        T[p * 16 + j] = (float)c; T[p * 16 + 8 + j] = (float)(r * s);
    }
}
__device__ __forceinline__ void p0_cmod(const GAS float* cin, const GAS float* ada_w, const GAS float* ada_b, GAS float* cmod, LAS unsigned char* lds, int vcu, int G, int tid, int wave, int lane) {
    LAS float* ca = (LAS float*)lds;
    LAS float* red = (LAS float*)(lds + 32768);
    for (int i = tid; i < 8192; i += NTHREADS) { const int b = i >> 10, k = i & 1023; const float v = cin[i]; ca[k * 8 + b] = siluf(v); }
    __syncthreads();
    for (int u = vcu; u < NL * 96; u += G) {
        const int l = u / 96, j0 = (u % 96) * 64;
        const GAS float* W = ada_w + (size_t)l * 1024 * 6144 + j0 + lane;
        float acc[8];
#pragma unroll
        for (int b = 0; b < 8; ++b) acc[b] = 0.f;
#pragma unroll 16
        for (int k = wave * 128; k < wave * 128 + 128; ++k) {
            const float wv = W[(size_t)k * 6144];
            const f32x4 c0 = *(const LAS f32x4*)(ca + k * 8), c1 = *(const LAS f32x4*)(ca + k * 8 + 4);
            acc[0] += c0[0] * wv; acc[1] += c0[1] * wv; acc[2] += c0[2] * wv; acc[3] += c0[3] * wv;
            acc[4] += c1[0] * wv; acc[5] += c1[1] * wv; acc[6] += c1[2] * wv; acc[7] += c1[3] * wv;
        }
#pragma unroll
        for (int b = 0; b < 8; ++b) red[(wave * 8 + b) * 64 + lane] = acc[b];
        __syncthreads();
        { const int b = tid >> 6, jj = tid & 63; float s = 0.f;
#pragma unroll
          for (int w = 0; w < 8; ++w) s += red[(w * 8 + b) * 64 + jj];
          cmod[((size_t)l * NB + b) * 6144 + j0 + jj] = s + ada_b[l * 6144 + j0 + jj]; }
        __syncthreads();
    }
}

template <bool IN_F32>
__device__ __forceinline__ void norm_rows(const GAS void* xin, GAS bf16* hout, const GAS float* gvec, const GAS float* cm  , int off_sh, int off_sc, int gw, int NGW, int lane) {
    const int WPB = NGW / NB;
    { const int bb = gw / WPB;
        const GAS float* cb = cm + (size_t)bb * 6144;
        float A[16], Bv[16];
#pragma unroll
        for (int hf = 0; hf < 2; ++hf)
#pragma unroll
            for (int q = 0; q < 2; ++q) { const int col = 512 * hf + 8 * lane + 4 * q;
                const f32x4 g4 = *(const GAS f32x4*)(gvec + col), sc4 = *(const GAS f32x4*)(cb + off_sc + col), sh4 = *(const GAS f32x4*)(cb + off_sh + col);
#pragma unroll
                for (int j = 0; j < 4; ++j) { A[8 * hf + 4 * q + j] = g4[j] * (sc4[j] + 1.0f); Bv[8 * hf + 4 * q + j] = sh4[j]; } }
        constexpr int RB = 4;
        auto finish_row = [&](const float (&v)[16], size_t m) {
            float ss = 0.f;
#pragma unroll
            for (int j = 0; j < 16; ++j) ss += v[j] * v[j];
            const float rr = __builtin_amdgcn_rsqf(wave_sum(ss) * (1.0f / DM) + EPS);
            GAS v4u* o16 = (GAS v4u*)(hout + m * DM);
#pragma unroll
            for (int hf = 0; hf < 2; ++hf) { float y[8];
#pragma unroll
                for (int j = 0; j < 8; ++j) y[j] = v[8 * hf + j] * rr * A[8 * hf + j] + Bv[8 * hf + j];
                v4u w; w.x = pk2(y[0], y[1]); w.y = pk2(y[2], y[3]); w.z = pk2(y[4], y[5]); w.w = pk2(y[6], y[7]); o16[64 * hf + lane] = w; } };
        int r = gw - bb * WPB;
#pragma unroll 1
        for (; r + (RB - 1) * WPB < SEQ; r += RB * WPB) {
            float v[RB][16];
#pragma unroll
            for (int k = 0; k < RB; ++k) { const size_t m = (size_t)bb * SEQ + r + k * WPB;
                if (IN_F32) { const GAS f32x4* xr = (const GAS f32x4*)((const GAS float*)xin + m * DM);
#pragma unroll
                    for (int hf = 0; hf < 2; ++hf)
#pragma unroll
                        for (int q = 0; q < 2; ++q) { const f32x4 t = xr[128 * hf + 2 * lane + q]; v[k][8 * hf + 4 * q] = t[0]; v[k][8 * hf + 4 * q + 1] = t[1]; v[k][8 * hf + 4 * q + 2] = t[2]; v[k][8 * hf + 4 * q + 3] = t[3]; } }
                else { const GAS v4u* xr = (const GAS v4u*)((const GAS bf16*)xin + m * DM);
#pragma unroll
                    for (int hf = 0; hf < 2; ++hf) { const v4u w = xr[64 * hf + lane];
                        v[k][8 * hf] = bflo(w.x); v[k][8 * hf + 1] = bfhi(w.x); v[k][8 * hf + 2] = bflo(w.y); v[k][8 * hf + 3] = bfhi(w.y); v[k][8 * hf + 4] = bflo(w.z); v[k][8 * hf + 5] = bfhi(w.z); v[k][8 * hf + 6] = bflo(w.w); v[k][8 * hf + 7] = bfhi(w.w); } } }
            asm volatile("" ::: "memory");
#pragma unroll
            for (int k = 0; k < RB; ++k) finish_row(v[k], (size_t)bb * SEQ + r + k * WPB);
        }
#pragma unroll 1
        for (; r < SEQ; r += WPB) {
            const size_t m = (size_t)bb * SEQ + r; float v[16];
            if (IN_F32) { const GAS f32x4* xr = (const GAS f32x4*)((const GAS float*)xin + m * DM);
#pragma unroll
                for (int hf = 0; hf < 2; ++hf)
#pragma unroll
                    for (int q = 0; q < 2; ++q) { const f32x4 t = xr[128 * hf + 2 * lane + q]; v[8 * hf + 4 * q] = t[0]; v[8 * hf + 4 * q + 1] = t[1]; v[8 * hf + 4 * q + 2] = t[2]; v[8 * hf + 4 * q + 3] = t[3]; } }
            else { const GAS v4u* xr = (const GAS v4u*)((const GAS bf16*)xin + m * DM);
#pragma unroll
                for (int hf = 0; hf < 2; ++hf) { const v4u w = xr[64 * hf + lane];
                    v[8 * hf] = bflo(w.x); v[8 * hf + 1] = bfhi(w.x); v[8 * hf + 2] = bflo(w.y); v[8 * hf + 3] = bfhi(w.y); v[8 * hf + 4] = bflo(w.z); v[8 * hf + 5] = bfhi(w.z); v[8 * hf + 6] = bflo(w.w); v[8 * hf + 7] = bfhi(w.w); } }
            finish_row(v, m);
        }
    }
}
__device__ __forceinline__ void final_norm_rows(const GAS bf16* xin, GAS float* xout, const GAS float* gvec, int gw, int NGW, int lane, float oscale) {
    float A[16];
#pragma unroll
    for (int hf = 0; hf < 2; ++hf)
#pragma unroll
        for (int q = 0; q < 2; ++q) { const f32x4 g4 = *(const GAS f32x4*)(gvec + 512 * hf + 8 * lane + 4 * q);
#pragma unroll
            for (int j = 0; j < 4; ++j) A[8 * hf + 4 * q + j] = g4[j]; }
    constexpr int RB = 4;
    auto finish_row = [&](const float (&v)[16], int m) {
        float ss = 0.f;
#pragma unroll
        for (int j = 0; j < 16; ++j) ss += v[j] * v[j];
        const float rr = __builtin_amdgcn_rsqf(wave_sum(ss) * (1.0f / DM) + EPS) * oscale;
        GAS f32x4* xo = (GAS f32x4*)(xout + (size_t)m * DM);
#pragma unroll
        for (int hf = 0; hf < 2; ++hf)
#pragma unroll
            for (int q = 0; q < 2; ++q) { f32x4 o;
#pragma unroll
                for (int j = 0; j < 4; ++j) o[j] = v[8 * hf + 4 * q + j] * rr * A[8 * hf + 4 * q + j];
                xo[128 * hf + 2 * lane + q] = o; } };
    auto load_row = [&](float (&v)[16], int m) { const GAS v4u* xr = (const GAS v4u*)(xin + (size_t)m * DM);
#pragma unroll
        for (int hf = 0; hf < 2; ++hf) { const v4u w = xr[64 * hf + lane];
            v[8 * hf] = bflo(w.x); v[8 * hf + 1] = bfhi(w.x); v[8 * hf + 2] = bflo(w.y); v[8 * hf + 3] = bfhi(w.y); v[8 * hf + 4] = bflo(w.z); v[8 * hf + 5] = bfhi(w.z); v[8 * hf + 6] = bflo(w.w); v[8 * hf + 7] = bfhi(w.w); } };
    int m = gw;
#pragma unroll 1
    for (; m + (RB - 1) * NGW < M_ALL; m += RB * NGW) { float v[RB][16];
#pragma unroll
        for (int k = 0; k < RB; ++k) load_row(v[k], m + k * NGW);
        asm volatile("" ::: "memory");
#pragma unroll
        for (int k = 0; k < RB; ++k) finish_row(v[k], m + k * NGW); }
#pragma unroll 1
    for (; m < M_ALL; m += NGW) { float v[16]; load_row(v, m); finish_row(v, m); }
}
__device__ __forceinline__ void copy_rows(const GAS float* xin, GAS bf16* xout, int gw, int NGW, int lane) {
    for (int m = gw; m < M_ALL; m += NGW) {
        const GAS f32x4* xr = (const GAS f32x4*)(xin + (size_t)m * DM) + lane; GAS v2u* xo = (GAS v2u*)(xout + (size_t)m * DM) + lane;
#pragma unroll
        for (int j = 0; j < 4; ++j) { const f32x4 t = xr[64 * j]; v2u w; w.x = pk2(t[0], t[1]); w.y = pk2(t[2], t[3]); xo[64 * j] = w; }
    }
}

__device__ __forceinline__ void rope_unit(GAS bf16* Z, GAS bf16* KIT, const GAS int* pos, const GAS float* T, int u, int tid) {
    const int blk = u / (MG / NTHREADS), row = (u % (MG / NTHREADS)) * NTHREADS + tid;
    int p = pos[row]; p = p < 0 ? 0 : (p > 16383 ? 16383 : p);
    const GAS f32x4* tp = (const GAS f32x4*)(T + (size_t)p * 16);
    const f32x4 c0 = tp[0], c1 = tp[1], s0 = tp[2], s1 = tp[3];
    const float cs[8] = {c0[0], c0[1], c0[2], c0[3], c1[0], c1[1], c1[2], c1[3]};
    const float sn[8] = {s0[0], s0[1], s0[2], s0[3], s1[0], s1[1], s1[2], s1[3]};
    const int col = (blk < 4) ? ZB_Q + 64 * blk : (blk == 4) ? ZB_K : (blk < 9) ? ZB_QI + 64 * (blk - 5) : ZB_KI;
    GAS v4u* ptr = (GAS v4u*)(Z + (size_t)row * ZLD + col);
    const v4u a = ptr[0], b = ptr[1];
    const unsigned aw[4] = {a.x, a.y, a.z, a.w}, bw[4] = {b.x, b.y, b.z, b.w};
    unsigned oa[4], ob[4];
#pragma unroll
    for (int q = 0; q < 4; ++q) {
        const float x1l = bflo(aw[q]), x1h = bfhi(aw[q]), x2l = bflo(bw[q]), x2h = bfhi(bw[q]);
        const float cl = cs[2 * q], ch = cs[2 * q + 1], sl = sn[2 * q], sh = sn[2 * q + 1];
        oa[q] = pk2(x1l * cl - x2l * sl, x1h * ch - x2h * sh);
        ob[q] = pk2(x1l * sl + x2l * cl, x1h * sh + x2h * ch);
    }
    if (blk == 9) {
        GAS v4u* kt = (GAS v4u*)((GAS unsigned char*)KIT + (size_t)(row >> 5) * 4096 + (row & 31) * 16);
        kt[0] = (v4u){oa[0], oa[1], oa[2], oa[3]}; kt[32] = (v4u){ob[0], ob[1], ob[2], ob[3]};
#pragma unroll
        for (int c = 2; c < 8; ++c) kt[(c >> 1) * 64 + (c & 1) * 32] = ptr[c];
    } else { ptr[0] = (v4u){oa[0], oa[1], oa[2], oa[3]}; ptr[1] = (v4u){ob[0], ob[1], ob[2], ob[3]}; }
}
__device__ __forceinline__ void conv_unit(const GAS bf16* Z, GAS bf16* YA, const GAS float* cw, const GAS float* cb, const GAS float* lng, const GAS float* lnb, LAS unsigned char* lds, int u, int tid, int wave, int lane) {
    LAS float* uL = (LAS float*)lds;
    LAS float* cv = (LAS float*)(lds + 62 * 256 * 4);
    const int b = u >> 8, blk = u & 255, t0 = blk * 32; const size_t growb = (size_t)b * SEQ;
    for (int e = tid; e < 62 * 256; e += NTHREADS) { const int tt = e >> 8, c = e & 255, t = t0 - 30 + tt; float val = 0.f;
        if (t >= 0) { const GAS bf16* zr = Z + (growb + t) * ZLD; val = bf2f(zr[ZA_VAL + c]) * sigm(bf2f(zr[ZA_GATE + c])); }
        uL[e] = val; }
    __syncthreads();
    { const int c = tid & 255, hf = tid >> 8; float w[31];
#pragma unroll
      for (int k = 0; k < 31; ++k) w[k] = cw[k * 256 + c];
      const float bias = cb[c];
#pragma unroll 1
      for (int tt = 0; tt < 16; ++tt) { const int tl = 16 * hf + tt; float acc = bias;
#pragma unroll
          for (int k = 0; k < 31; ++k) acc += uL[(tl + k) * 256 + c] * w[k];
          cv[tl * 256 + c] = acc; } }
    __syncthreads();
#pragma unroll
    for (int q = 0; q < 4; ++q) { const int tl = 4 * wave + q;
        const f32x4 x = *(const LAS f32x4*)(cv + tl * 256 + 4 * lane);
        const float mu = wave_sum((x[0] + x[1]) + (x[2] + x[3])) * (1.0f / 256.0f);
        const f32x4 d = x - mu;
        const float var = wave_sum((d[0] * d[0] + d[1] * d[1]) + (d[2] * d[2] + d[3] * d[3])) * (1.0f / 256.0f);
        const float rs = __builtin_amdgcn_rsqf(var + EPS);
        const f32x4 g4 = *(const GAS f32x4*)(lng + 4 * lane), b4 = *(const GAS f32x4*)(lnb + 4 * lane);
        f32x4 y = d * rs * g4 + b4;
        v2u o; o.x = pk2(siluf(y[0]), siluf(y[1])); o.y = pk2(siluf(y[2]), siluf(y[3]));
        *(GAS v2u*)(YA + (growb + t0 + tl) * 256 + 4 * lane) = o; }
    __syncthreads();
}

__device__ __forceinline__ void conv2_unit(const GAS bf16* Z, GAS bf16* YA, const GAS float* cw, const GAS float* cb, const GAS float* lng, const GAS float* lnb, LAS unsigned char* lds, int u, int wave) {
    unsigned ones_u = ~0u; asm volatile("" : "+s"(ones_u));
    const int lane = (int)__builtin_amdgcn_mbcnt_hi(ones_u, __builtin_amdgcn_mbcnt_lo(ones_u, 0u));
    const int tid = wave * 64 + lane;
    LAS bf16* uH = (LAS bf16*)lds;
    LAS unsigned* uW = (LAS unsigned*)lds;
    LAS float* cv = (LAS float*)(lds + 47 * 256 * 4);
    const int b = u >> 7, blk = u & 127, t0 = blk * 64; const size_t growb = (size_t)b * SEQ;
    for (int e = tid; e < 94 * 32; e += NTHREADS) { const int tt = e >> 5, ch = e & 31, t = t0 - 30 + tt;
        v4u vw = {0u, 0u, 0u, 0u}, gw = {0u, 0u, 0u, 0u};
        if (t >= 0) { const GAS bf16* zr = Z + (growb + t) * ZLD; vw = *(const GAS v4u*)(zr + ZA_VAL + 8 * ch); gw = *(const GAS v4u*)(zr + ZA_GATE + 8 * ch); }
        const unsigned va[4] = {vw.x, vw.y, vw.z, vw.w}, ga[4] = {gw.x, gw.y, gw.z, gw.w};
        LAS bf16* dst = uH + ((tt >> 1) * 256 + 8 * ch) * 2 + (tt & 1);
#pragma unroll
        for (int j = 0; j < 8; ++j) { const float v = (j & 1) ? bfhi(va[j >> 1]) : bflo(va[j >> 1]), g = (j & 1) ? bfhi(ga[j >> 1]) : bflo(ga[j >> 1]);
            dst[2 * j] = (bf16)f2bf((t >= 0) ? v * sigm(g) : 0.f); } }
    __syncthreads();
    { const int c = tid & 255, hf = tid >> 8; float w[31];
#pragma unroll
      for (int k = 0; k < 31; ++k) w[k] = cw[k * 256 + c];
      const float bias = cb[c];
#pragma unroll 1
      for (int gq = 0; gq < 4; ++gq) { const int o0 = 32 * hf + 8 * gq;
          float acc[8];
#pragma unroll
          for (int o = 0; o < 8; ++o) acc[o] = bias;
#pragma unroll
          for (int kp = 0; kp < 19; ++kp) { const unsigned xw = uW[((o0 >> 1) + kp) * 256 + c];
              const float x0 = bflo(xw), x1 = bfhi(xw);
#pragma unroll
              for (int o = 0; o < 8; ++o) { const int k0 = 2 * kp - o, k1 = 2 * kp + 1 - o;
                  if (k0 >= 0 && k0 <= 30) acc[o] += x0 * w[k0];
                  if (k1 >= 0 && k1 <= 30) acc[o] += x1 * w[k1]; } }
#pragma unroll
          for (int o = 0; o < 8; ++o) cv[(o0 + o) * 256 + c] = acc[o]; } }
    __syncthreads();
#pragma unroll 2
    for (int q = 0; q < 8; ++q) { const int tl = 8 * wave + q;
        const f32x4 x = *(const LAS f32x4*)(cv + tl * 256 + 4 * lane);
        const float mu = wave_sum((x[0] + x[1]) + (x[2] + x[3])) * (1.0f / 256.0f);
        const f32x4 d = x - mu;
        const float var = wave_sum((d[0] * d[0] + d[1] * d[1]) + (d[2] * d[2] + d[3] * d[3])) * (1.0f / 256.0f);
        const float rs = __builtin_amdgcn_rsqf(var + EPS);
        const f32x4 g4 = *(const GAS f32x4*)(lng + 4 * lane), b4 = *(const GAS f32x4*)(lnb + 4 * lane);
        f32x4 y = d * rs * g4 + b4;
        v2u o; o.x = pk2(siluf(y[0]), siluf(y[1])); o.y = pk2(siluf(y[2]), siluf(y[3]));
        *(GAS v2u*)(YA + (growb + t0 + tl) * 256 + 4 * lane) = o; }
    __syncthreads();
}

struct LinPar { const GAS bf16* Z; const GAS float* gate_w; const GAS float* gate_b; const GAS float* lb_logits; int layer; };
constexpr int L_LF = 0, L_Q = 16384, L_K = 32768, L_V = 49152, L_QT = 65536, L_KT = 82944, L_QH = 100352, L_AT = 117760, L_S = 135168;
constexpr int TS = 68;
template <int DK>
__device__ __forceinline__ void lin_load(const LinPar& P, LAS unsigned char* lds, int b, int c, int h, int tid) {
    LAS float* gL = (LAS float*)(lds + L_LF); LAS float* qL = (LAS float*)(lds + L_Q); LAS float* kL = (LAS float*)(lds + L_K); LAS float* vL = (LAS float*)(lds + L_V);
    const int t = tid >> 3, part = tid & 7;
    const GAS bf16* zr = P.Z + ((size_t)b * SEQ + c * 64 + t) * ZLD;
    if (DK == 32) {
        const v2u qw = *(const GAS v2u*)(zr + ZC_Q + h * 32 + 4 * part), kw = *(const GAS v2u*)(zr + ZC_K + h * 32 + 4 * part);
        const float qs = 0.17677669529663687f;
        const float qv[4] = {bflo(qw.x) * qs, bfhi(qw.x) * qs, bflo(qw.y) * qs, bfhi(qw.y) * qs};
        const float kv[4] = {bflo(kw.x), bfhi(kw.x), bflo(kw.y), bfhi(kw.y)};
        const v4u g0 = *(const GAS v4u*)(zr + ZC_GLR), g1 = *(const GAS v4u*)(zr + ZC_GLR + 8);
        const unsigned gw[8] = {g0.x, g0.y, g0.z, g0.w, g1.x, g1.y, g1.z, g1.w};
        float a[4];
#pragma unroll
        for (int j = 0; j < 4; ++j) a[j] = P.gate_b[h * 32 + 4 * part + j];
#pragma unroll
        for (int r2 = 0; r2 < 8; ++r2) { const float x0 = bflo(gw[r2]), x1 = bfhi(gw[r2]);
            const f32x4 w0 = *(const GAS f32x4*)(P.gate_w + (2 * r2) * 128 + h * 32 + 4 * part), w1 = *(const GAS f32x4*)(P.gate_w + (2 * r2 + 1) * 128 + h * 32 + 4 * part);
#pragma unroll
            for (int j = 0; j < 4; ++j) a[j] += x0 * w0[j] + x1 * w1[j]; }
#pragma unroll
        for (int j = 0; j < 4; ++j) { const int d = 4 * part + j; gL[t * DK + d] = logsigm(a[j]) * (1.0f / 16.0f); qL[t * DK + d] = qv[j]; kL[t * DK + d] = kv[j]; }
        const v4u vw = *(const GAS v4u*)(zr + ZC_V + h * 64 + 8 * part);
        const unsigned vv[4] = {vw.x, vw.y, vw.z, vw.w};
#pragma unroll
        for (int j = 0; j < 4; ++j) { vL[t * 64 + 8 * part + 2 * j] = bflo(vv[j]); vL[t * 64 + 8 * part + 2 * j + 1] = bfhi(vv[j]); }
    } else {
        const v4u fw = *(const GAS v4u*)(zr + ZD_F + h * 64 + 8 * part), qw = *(const GAS v4u*)(zr + ZD_Q + h * 64 + 8 * part), iw = *(const GAS v4u*)(zr + ZD_I + h * 64 + 8 * part);
        const unsigned fa[4] = {fw.x, fw.y, fw.z, fw.w}, qa[4] = {qw.x, qw.y, qw.z, qw.w}, ia[4] = {iw.x, iw.y, iw.z, iw.w};
#pragma unroll
        for (int j = 0; j < 8; ++j) { const int d = 8 * part + j;
            const float zf = (j & 1) ? bfhi(fa[j >> 1]) : bflo(fa[j >> 1]), zq = (j & 1) ? bfhi(qa[j >> 1]) : bflo(qa[j >> 1]), zi = (j & 1) ? bfhi(ia[j >> 1]) : bflo(ia[j >> 1]);
            float lbv = 0.f;
            if (P.layer == 1) lbv = sigm(P.lb_logits[256 + h * 64 + d] - P.lb_logits[h * 64 + d]);
            const float sg = sigm(zf);
            const float f = lbv + (1.0f - lbv) * sg;
            gL[t * DK + d] = (P.layer == 0) ? logsigm(zf) : __logf(f);
            kL[t * DK + d] = (1.0f - lbv) * sigm(-zf);
            qL[t * DK + d] = siluf(zq);
            vL[t * 64 + d] = zi; }
    }
    __syncthreads();
    if (tid < DK) { float run = 0.f;
#pragma unroll 4
        for (int tt = 0; tt < 64; ++tt) { run += gL[tt * DK + tid]; gL[tt * DK + tid] = run; } }
    __syncthreads();
}
template <int DK>
__device__ __forceinline__ void lin_local_unit(const LinPar& P, GAS float* ST, GAS float* DEC, LAS unsigned char* lds, int u, int tid) {
    const int b = u / (NCH * 4), c = (u / 4) % NCH, h = u & 3;
    lin_load<DK>(P, lds, b, c, h, tid);
    LAS float* gL = (LAS float*)(lds + L_LF); LAS float* kL = (LAS float*)(lds + L_K); LAS float* vL = (LAS float*)(lds + L_V);
    for (int e = tid; e < 64 * DK; e += NTHREADS) { const int d = e % DK; kL[e] = kL[e] * __expf(gL[63 * DK + d] - gL[e]); }
    __syncthreads();
    constexpr int VPT = DK / 8, NVO = 64 / VPT;
    const int d = tid / NVO, vo = tid % NVO;
    float acc[VPT];
#pragma unroll
    for (int j = 0; j < VPT; ++j) acc[j] = 0.f;
#pragma unroll 4
    for (int t = 0; t < 64; ++t) { const float kk = kL[t * DK + d];
#pragma unroll
        for (int j = 0; j < VPT; ++j) acc[j] += kk * vL[t * 64 + vo * VPT + j]; }
    GAS float* so = ST + ((size_t)(b * NCH + c) * 4 + h) * DK * 64 + d * 64 + vo * VPT;
#pragma unroll
    for (int j = 0; j < VPT; ++j) so[j] = acc[j];
    if (tid < DK) DEC[(size_t)(b * NCH + c) * 4 * DK + h * DK + tid] = __expf(gL[63 * DK + tid]);
    __syncthreads();
}
__device__ __forceinline__ void scan_unit(GAS bf16* STC, GAS bf16* STD, const GAS float* DECC, const GAS float* DECD, int u, int tid) {
    if (tid >= 192) return;
    const int e = u * 192 + tid;
    GAS unsigned* sp; const GAS float* dp; size_t sstride, dstride;
    if (e < GB * 4096) { const int b = e / 4096, rem = e % 4096; sp = (GAS unsigned*)STC + (size_t)b * NCH * 4096 + rem; sstride = 4096; dp = DECC + (size_t)b * NCH * 128 + rem / 32; dstride = 128; }
    else { const int e2 = e - GB * 4096; const int b = e2 / 8192, rem = e2 % 8192; sp = (GAS unsigned*)STD + (size_t)b * NCH * 8192 + rem; sstride = 8192; dp = DECD + (size_t)b * NCH * 256 + rem / 32; dstride = 256; }
    float s0 = 0.f, s1 = 0.f;
#pragma unroll 1
    for (int c0 = 0; c0 < NCH; c0 += 16) {
        unsigned uu[16]; float dd[16];
#pragma unroll
        for (int i = 0; i < 16; ++i) { uu[i] = sp[(size_t)(c0 + i) * sstride]; dd[i] = dp[(size_t)(c0 + i) * dstride]; }
#pragma unroll
        for (int i = 0; i < 16; ++i) { sp[(size_t)(c0 + i) * sstride] = pk2(s0, s1); s0 = dd[i] * s0 + bflo(uu[i]); s1 = dd[i] * s1 + bfhi(uu[i]); }
    }
}
template <int DK>
__device__ __forceinline__ void lin_out_unit(const LinPar& P, const GAS float* ST, const GAS float* normg, GAS bf16* YS, LAS unsigned char* lds, int u, int tid) {
    const int b = u / (NCH * 4), c = (u / 4) % NCH, h = u & 3;
    lin_load<DK>(P, lds, b, c, h, tid);
    LAS float* gL = (LAS float*)(lds + L_LF); LAS float* qL = (LAS float*)(lds + L_Q); LAS float* kL = (LAS float*)(lds + L_K); LAS float* vL = (LAS float*)(lds + L_V);
    LAS float* qT = (LAS float*)(lds + L_QT); LAS float* kT = (LAS float*)(lds + L_KT); LAS float* qH = (LAS float*)(lds + L_QH); LAS float* aT = (LAS float*)(lds + L_AT); LAS float* sM = (LAS float*)(lds + L_S);
    for (int e = tid; e < 64 * DK; e += NTHREADS) { const int t = e / DK, d = e % DK;
        const float g = gL[e], r = gL[31 * DK + d], q = qL[e], k = kL[e];
        qT[d * TS + t] = q * __expf(fminf(g - r, 80.f)); kT[d * TS + t] = k * __expf(fminf(r - g, 80.f)); qH[d * TS + t] = q * __expf(g); }
    { const GAS float* sp = ST + ((size_t)(b * NCH + c) * 4 + h) * DK * 64;
      for (int e = tid; e < DK * 64; e += NTHREADS) sM[e] = sp[e]; }
    __syncthreads();
    const int i = tid >> 3, jo = tid & 7;
    { float a[8];
#pragma unroll
      for (int j = 0; j < 8; ++j) a[j] = 0.f;
#pragma unroll 4
      for (int d = 0; d < DK; ++d) { const float qv = qT[d * TS + i];
          const f32x4 k0 = *(const LAS f32x4*)(kT + d * TS + 8 * jo), k1 = *(const LAS f32x4*)(kT + d * TS + 8 * jo + 4);
          a[0] += qv * k0[0]; a[1] += qv * k0[1]; a[2] += qv * k0[2]; a[3] += qv * k0[3]; a[4] += qv * k1[0]; a[5] += qv * k1[1]; a[6] += qv * k1[2]; a[7] += qv * k1[3]; }
#pragma unroll
      for (int j = 0; j < 8; ++j) { const int jj = 8 * jo + j; aT[jj * TS + i] = (jj <= i) ? a[j] : 0.f; } }
    __syncthreads();
    { float o[8];
#pragma unroll
      for (int j = 0; j < 8; ++j) o[j] = 0.f;
#pragma unroll 4
      for (int j = 0; j < 64; ++j) { const float av = aT[j * TS + i];
          const f32x4 v0 = *(const LAS f32x4*)(vL + j * 64 + 8 * jo), v1 = *(const LAS f32x4*)(vL + j * 64 + 8 * jo + 4);
          o[0] += av * v0[0]; o[1] += av * v0[1]; o[2] += av * v0[2]; o[3] += av * v0[3]; o[4] += av * v1[0]; o[5] += av * v1[1]; o[6] += av * v1[2]; o[7] += av * v1[3]; }
#pragma unroll 4
      for (int d = 0; d < DK; ++d) { const float qv = qH[d * TS + i];
          const f32x4 s0 = *(const LAS f32x4*)(sM + d * 64 + 8 * jo), s1 = *(const LAS f32x4*)(sM + d * 64 + 8 * jo + 4);
          o[0] += qv * s0[0]; o[1] += qv * s0[1]; o[2] += qv * s0[2]; o[3] += qv * s0[3]; o[4] += qv * s1[0]; o[5] += qv * s1[1]; o[6] += qv * s1[2]; o[7] += qv * s1[3]; }
      float ss = 0.f;
#pragma unroll
      for (int j = 0; j < 8; ++j) ss += o[j] * o[j];
      ss += swz_xor<1>(ss); ss += swz_xor<2>(ss); ss += swz_xor<4>(ss);
      const float rs = __builtin_amdgcn_rsqf(ss * (1.0f / 64.0f) + EPS);
      const size_t grow = (size_t)b * SEQ + c * 64 + i;
      const v4u ogw = *(const GAS v4u*)(P.Z + grow * ZLD + (DK == 32 ? ZC_OG : ZD_OG) + h * 64 + 8 * jo);
      const unsigned oga[4] = {ogw.x, ogw.y, ogw.z, ogw.w};
      const f32x4 n0 = *(const GAS f32x4*)(normg + 8 * jo), n1 = *(const GAS f32x4*)(normg + 8 * jo + 4);
      const float ng[8] = {n0[0], n0[1], n0[2], n0[3], n1[0], n1[1], n1[2], n1[3]};
      float y[8];
#pragma unroll
      for (int j = 0; j < 8; ++j) { const float og = (j & 1) ? bfhi(oga[j >> 1]) : bflo(oga[j >> 1]); y[j] = o[j] * rs * ng[j] * siluf(og); }
      v4u w; w.x = pk2(y[0], y[1]); w.y = pk2(y[2], y[3]); w.z = pk2(y[4], y[5]); w.w = pk2(y[6], y[7]);
      *(GAS v4u*)(YS + grow * 256 + h * 64 + 8 * jo) = w; }
    __syncthreads();
}

constexpr int L2_RS = 72;
constexpr int L2_QT = 0, L2_KT = 9216, L2_QH = 18432, L2_VT = 27648, L2_ST = 36864, L2_KH = 46080, L2_HEAD = 55296;
template <int CTRL, int RM> __device__ __forceinline__ float dpp_add(float v) { return v + __builtin_bit_cast(float, __builtin_amdgcn_update_dpp(0, __builtin_bit_cast(int, v), CTRL, RM, 0xF, false)); }
__device__ __forceinline__ float wave_incl_scan(float x) {
    x = dpp_add<0x111, 0xF>(x); x = dpp_add<0x112, 0xF>(x); x = dpp_add<0x114, 0xF>(x); x = dpp_add<0x118, 0xF>(x);
    x = dpp_add<0x142, 0xA>(x); x = dpp_add<0x143, 0xC>(x);
    return x;
}
__device__ __forceinline__ float lane_bcast(float v, int l) { return __builtin_bit_cast(float, __builtin_amdgcn_readlane(__builtin_bit_cast(int, v), l)); }
template <int CTRL, int RM> __device__ __forceinline__ unsigned dpp_umax(unsigned v) { return max(v, (unsigned)__builtin_amdgcn_update_dpp(0, (int)v, CTRL, RM, 0xF, false)); }
template <int CTRL, int RM> __device__ __forceinline__ unsigned dpp_umin(unsigned v) { return min(v, (unsigned)__builtin_amdgcn_update_dpp(-1, (int)v, CTRL, RM, 0xF, false)); }
__device__ __forceinline__ unsigned wave_umax(unsigned x) { x = dpp_umax<0x111, 0xF>(x); x = dpp_umax<0x112, 0xF>(x); x = dpp_umax<0x114, 0xF>(x); x = dpp_umax<0x118, 0xF>(x);
    x = dpp_umax<0x142, 0xA>(x); x = dpp_umax<0x143, 0xC>(x); return (unsigned)__builtin_amdgcn_readlane((int)x, 63); }
__device__ __forceinline__ unsigned wave_umin(unsigned x) { x = dpp_umin<0x111, 0xF>(x); x = dpp_umin<0x112, 0xF>(x); x = dpp_umin<0x114, 0xF>(x); x = dpp_umin<0x118, 0xF>(x);
    x = dpp_umin<0x142, 0xA>(x); x = dpp_umin<0x143, 0xC>(x); return (unsigned)__builtin_amdgcn_readlane((int)x, 63); }
template <int DK, int PHASE>
__device__ __forceinline__ void lin2_unit(const LinPar& P, GAS bf16* ST, GAS float* DEC, const GAS float* normg, GAS bf16* YS, LAS unsigned char* lds, int u, int wave) {
    unsigned ones_u = ~0u; asm volatile("" : "+s"(ones_u));
    const int lane = (int)__builtin_amdgcn_mbcnt_hi(ones_u, __builtin_amdgcn_mbcnt_lo(ones_u, 0u));
    const int hg = wave >> 2, wl = wave & 3;
    const int b = u / (NCH * 2), c = (u >> 1) % NCH, h = 2 * (u & 1) + hg;
    LAS unsigned char* hb = lds + hg * L2_HEAD;
    LAS bf16* QT = (LAS bf16*)(hb + L2_QT); LAS bf16* KT = (LAS bf16*)(hb + L2_KT); LAS bf16* QH = (LAS bf16*)(hb + L2_QH);
    LAS bf16* VT = (LAS bf16*)(hb + L2_VT); LAS bf16* SS = (LAS bf16*)(hb + L2_ST); LAS bf16* KH = (LAS bf16*)(hb + L2_KH);
    constexpr int ND = DK / 4;
    const int d0 = wl * ND;
    const size_t crow = (size_t)b * SEQ + c * 64;
    const GAS bf16* zr = P.Z + (crow + lane) * ZLD;
    float lf[ND], qv[ND], kv[ND], vv[16];
    if constexpr (DK == 32) {
        const v4u qw = *(const GAS v4u*)(zr + ZC_Q + h * 32 + d0), kw = *(const GAS v4u*)(zr + ZC_K + h * 32 + d0);
        const unsigned qa[4] = {qw.x, qw.y, qw.z, qw.w}, ka[4] = {kw.x, kw.y, kw.z, kw.w};
        const v4u g0 = *(const GAS v4u*)(zr + ZC_GLR), g1 = *(const GAS v4u*)(zr + ZC_GLR + 8);
        const unsigned gw[8] = {g0.x, g0.y, g0.z, g0.w, g1.x, g1.y, g1.z, g1.w};
        float a[ND];
#pragma unroll
        for (int j = 0; j < ND; ++j) a[j] = P.gate_b[h * 32 + d0 + j];
#pragma unroll
        for (int r2 = 0; r2 < 8; ++r2) { const float x0 = bflo(gw[r2]), x1 = bfhi(gw[r2]);
#pragma unroll
            for (int j = 0; j < ND; ++j) a[j] += x0 * P.gate_w[(2 * r2) * 128 + h * 32 + d0 + j] + x1 * P.gate_w[(2 * r2 + 1) * 128 + h * 32 + d0 + j]; }
#pragma unroll
        for (int j = 0; j < ND; ++j) { lf[j] = logsigm(a[j]) * (1.0f / 16.0f);
            qv[j] = ((j & 1) ? bfhi(qa[j >> 1]) : bflo(qa[j >> 1])) * 0.17677669529663687f; kv[j] = (j & 1) ? bfhi(ka[j >> 1]) : bflo(ka[j >> 1]); }
        const v4u v0 = *(const GAS v4u*)(zr + ZC_V + h * 64 + 16 * wl), v1 = *(const GAS v4u*)(zr + ZC_V + h * 64 + 16 * wl + 8);
        const unsigned va[8] = {v0.x, v0.y, v0.z, v0.w, v1.x, v1.y, v1.z, v1.w};
#pragma unroll
        for (int j = 0; j < 16; ++j) vv[j] = (j & 1) ? bfhi(va[j >> 1]) : bflo(va[j >> 1]);
    } else {
        const v4u f0 = *(const GAS v4u*)(zr + ZD_F + h * 64 + d0), f1 = *(const GAS v4u*)(zr + ZD_F + h * 64 + d0 + 8);
        const v4u q0 = *(const GAS v4u*)(zr + ZD_Q + h * 64 + d0), q1 = *(const GAS v4u*)(zr + ZD_Q + h * 64 + d0 + 8);
        const v4u i0 = *(const GAS v4u*)(zr + ZD_I + h * 64 + d0), i1 = *(const GAS v4u*)(zr + ZD_I + h * 64 + d0 + 8);
        const unsigned fa[8] = {f0.x, f0.y, f0.z, f0.w, f1.x, f1.y, f1.z, f1.w}, qa[8] = {q0.x, q0.y, q0.z, q0.w, q1.x, q1.y, q1.z, q1.w}, ia[8] = {i0.x, i0.y, i0.z, i0.w, i1.x, i1.y, i1.z, i1.w};
        if (P.layer == 0) {
#pragma unroll
            for (int j = 0; j < 16; ++j) {
                const float zf = (j & 1) ? bfhi(fa[j >> 1]) : bflo(fa[j >> 1]), zq = (j & 1) ? bfhi(qa[j >> 1]) : bflo(qa[j >> 1]);
                const float t = __expf(-fabsf(zf)), r = __builtin_amdgcn_rcpf(1.0f + t), tr = t * r;
                lf[j % ND] = fminf(zf, 0.f) - __logf(1.0f + t);
                kv[j % ND] = (zf >= 0.f) ? tr : r;
                qv[j % ND] = siluf(zq);
                vv[j] = (j & 1) ? bfhi(ia[j >> 1]) : bflo(ia[j >> 1]); }
        } else {
#pragma unroll
            for (int j = 0; j < 16; ++j) {
                const float zf = (j & 1) ? bfhi(fa[j >> 1]) : bflo(fa[j >> 1]), zq = (j & 1) ? bfhi(qa[j >> 1]) : bflo(qa[j >> 1]);
                const float lbv = sigm(P.lb_logits[256 + h * 64 + d0 + j] - P.lb_logits[h * 64 + d0 + j]);
                const float t = __expf(-fabsf(zf)), r = __builtin_amdgcn_rcpf(1.0f + t), tr = t * r;
                const float sp = (zf >= 0.f) ? r : tr, sn = (zf >= 0.f) ? tr : r;
                lf[j % ND] = __logf(lbv + (1.0f - lbv) * sp);
                kv[j % ND] = (1.0f - lbv) * sn;
                qv[j % ND] = siluf(zq);
                vv[j] = (j & 1) ? bfhi(ia[j >> 1]) : bflo(ia[j >> 1]); }
        }
    }
    const int fr = lane & 15, fg = lane >> 4;
    unsigned sreg[PHASE == 1 ? DK / 4 : 1]; unsigned ogr[PHASE == 1 ? 16 : 1];
    if constexpr (PHASE == 1) {
        const GAS bf16* sp = ST + ((size_t)(b * NCH + c) * 4 + h) * DK * 64;
#pragma unroll
        for (int i = 0; i < DK / 4; ++i) sreg[i] = sp[wl * 64 + lane + 256 * i];
#pragma unroll
        for (int tv = 0; tv < 4; ++tv)
#pragma unroll
            for (int r = 0; r < 4; ++r) ogr[tv * 4 + r] = P.Z[(crow + 16 * wl + 4 * fg + r) * ZLD + (DK == 32 ? ZC_OG : ZD_OG) + h * 64 + 16 * tv + fr];
    }
    float g[ND], gl[ND];
#pragma unroll
    for (int j = 0; j < ND; ++j) { g[j] = wave_incl_scan(lf[j]); gl[j] = lane_bcast(g[j], 63); }
#pragma unroll
    for (int j = 0; j < 16; ++j) VT[(16 * wl + j) * L2_RS + lane] = (bf16)f2bf(vv[j]);
    if (PHASE == 0) {
#pragma unroll
        for (int j = 0; j < ND; ++j) KH[(d0 + j) * L2_RS + lane] = (bf16)f2bf(kv[j] * __expf(gl[j] - g[j]));
        if (lane == 63) {
#pragma unroll
            for (int j = 0; j < ND; ++j) DEC[(size_t)(b * NCH + c) * 4 * DK + h * DK + d0 + j] = __expf(gl[j]);
        }
        __syncthreads();
        GAS bf16* so = ST + ((size_t)(b * NCH + c) * 4 + h) * DK * 64;
#pragma unroll
        for (int td = 0; td < DK / 16; ++td) { f32x4 acc = {0.f, 0.f, 0.f, 0.f};
#pragma unroll
            for (int ks = 0; ks < 2; ++ks) { const bf16x8 af = *(const LAS bf16x8*)(KH + (16 * td + fr) * L2_RS + 32 * ks + 8 * fg), bfv = *(const LAS bf16x8*)(VT + (16 * wl + fr) * L2_RS + 32 * ks + 8 * fg);
                acc = __builtin_amdgcn_mfma_f32_16x16x32_bf16(af, bfv, acc, 0, 0, 0); }
#pragma unroll
            for (int r = 0; r < 4; ++r) so[(16 * td + 4 * fg + r) * 64 + 16 * wl + fr] = (bf16)f2bf(acc[r]); }
        __syncthreads();
    } else {
        {
            unsigned qtw[ND / 2], ktw[ND / 2], qhw[ND / 2];
#pragma unroll
            for (int j = 0; j < ND; j += 2) { const float r0 = lane_bcast(g[j], 31), r1 = lane_bcast(g[j + 1], 31);
                qtw[j >> 1] = pk2(qv[j] * __expf(fminf(g[j] - r0, 80.f)), qv[j + 1] * __expf(fminf(g[j + 1] - r1, 80.f)));
                ktw[j >> 1] = pk2(kv[j] * __expf(fminf(r0 - g[j], 80.f)), kv[j + 1] * __expf(fminf(r1 - g[j + 1], 80.f)));
                qhw[j >> 1] = pk2(qv[j] * __expf(g[j]), qv[j + 1] * __expf(g[j + 1])); }
#pragma unroll
            for (int q4 = 0; q4 < ND / 8; ++q4) {
                *(LAS v4u*)(QT + lane * L2_RS + d0 + 8 * q4) = (v4u){qtw[4 * q4], qtw[4 * q4 + 1], qtw[4 * q4 + 2], qtw[4 * q4 + 3]};
                *(LAS v4u*)(KT + lane * L2_RS + d0 + 8 * q4) = (v4u){ktw[4 * q4], ktw[4 * q4 + 1], ktw[4 * q4 + 2], ktw[4 * q4 + 3]};
                *(LAS v4u*)(QH + lane * L2_RS + d0 + 8 * q4) = (v4u){qhw[4 * q4], qhw[4 * q4 + 1], qhw[4 * q4 + 2], qhw[4 * q4 + 3]}; }
        }
        {
#pragma unroll
            for (int i = 0; i < DK / 4; ++i) { const int idx = wl * 64 + lane + 256 * i; SS[(idx & 63) * L2_RS + (idx >> 6)] = (bf16)sreg[i]; }
        }
        __syncthreads();
        const int ti = wl;
        bf16x8 qf[DK / 32];
#pragma unroll
        for (int ks = 0; ks < DK / 32; ++ks) qf[ks] = *(const LAS bf16x8*)(QT + (16 * ti + fr) * L2_RS + 32 * ks + 8 * fg);
        bf16x8 pa[2];
#pragma unroll
        for (int tj = 0; tj < 4; ++tj) { f32x4 at = {0.f, 0.f, 0.f, 0.f};
            if (tj <= ti) {
#pragma unroll
                for (int ks = 0; ks < DK / 32; ++ks) { const bf16x8 kf = *(const LAS bf16x8*)(KT + (16 * tj + fr) * L2_RS + 32 * ks + 8 * fg);
                    at = __builtin_amdgcn_mfma_f32_16x16x32_bf16(kf, qf[ks], at, 0, 0, 0); } }
#pragma unroll
            for (int r = 0; r < 4; ++r) { const float v = (tj <= ti && (16 * tj + 4 * fg + r) <= (16 * ti + fr)) ? at[r] : 0.f; pa[tj >> 1][(tj & 1) * 4 + r] = (short)f2bf(v); } }
        f32x4 oacc[4];
#pragma unroll
        for (int tv = 0; tv < 4; ++tv) { f32x4 acc = {0.f, 0.f, 0.f, 0.f};
#pragma unroll
            for (int k2 = 0; k2 < 2; ++k2) { const v2u lo = *(const LAS v2u*)(VT + (16 * tv + fr) * L2_RS + 32 * k2 + 4 * fg), hi = *(const LAS v2u*)(VT + (16 * tv + fr) * L2_RS + 32 * k2 + 16 + 4 * fg);
                const v4u vb4 = (v4u){lo.x, lo.y, hi.x, hi.y};
                acc = __builtin_amdgcn_mfma_f32_16x16x32_bf16(pa[k2], __builtin_bit_cast(bf16x8, vb4), acc, 0, 0, 0); }
#pragma unroll
            for (int ks = 0; ks < DK / 32; ++ks) { const bf16x8 qh = *(const LAS bf16x8*)(QH + (16 * ti + fr) * L2_RS + 32 * ks + 8 * fg), sf = *(const LAS bf16x8*)(SS + (16 * tv + fr) * L2_RS + 32 * ks + 8 * fg);
                acc = __builtin_amdgcn_mfma_f32_16x16x32_bf16(qh, sf, acc, 0, 0, 0); }
            oacc[tv] = acc; }
        float rs[4];
#pragma unroll
        for (int r = 0; r < 4; ++r) { float ss = (oacc[0][r] * oacc[0][r] + oacc[1][r] * oacc[1][r]) + (oacc[2][r] * oacc[2][r] + oacc[3][r] * oacc[3][r]);
            ss += swz_xor<1>(ss); ss += swz_xor<2>(ss); ss += swz_xor<4>(ss); ss += swz_xor<8>(ss);
            rs[r] = __builtin_amdgcn_rsqf(ss * (1.0f / 64.0f) + EPS); }
#pragma unroll
        for (int tv = 0; tv < 4; ++tv) { const float ng = normg[16 * tv + fr];
#pragma unroll
            for (int r = 0; r < 4; ++r) { const size_t row = crow + 16 * ti + 4 * fg + r;
                const float og = bf2f(ogr[tv * 4 + r]);
                YS[row * 256 + h * 64 + 16 * tv + fr] = (bf16)f2bf(oacc[tv][r] * rs[r] * ng * siluf(og)); } }
        __syncthreads();
    }
}

constexpr int TK_CAP = 576, TK_TRIG = TK_CAP - 32, TK_K = 256, TK_SLACK = 32;
constexpr int TKW_BUF = 0, TKW_CT = 8 * TK_CAP * 4, TKW_TRASH = TKW_CT + 64, TKW_BYTES = TKW_TRASH + 256;
static_assert(TKW_BYTES * 8 <= MISC_OFF, "top-k LDS");
__device__ __forceinline__ unsigned tk_compact(LAS unsigned* bufq, LAS unsigned* trash, int n, unsigned lo_in, int slack, int lane, int& nkeep) {
    constexpr int NR = TK_CAP / 64; unsigned e[NR];
#pragma unroll
    for (int r = 0; r < NR; ++r) { const int idx = lane + 64 * r; const unsigned raw = bufq[idx]; e[r] = (idx < n) ? raw : 0u; }
    unsigned lmx = max(max(max(e[0], e[1]), max(e[2], e[3])), max(max(e[4], e[5]), max(e[6], e[7])));
    unsigned lmn = min(min(min(e[0] - 1u, e[1] - 1u), min(e[2] - 1u, e[3] - 1u)), min(min(e[4] - 1u, e[5] - 1u), min(e[6] - 1u, e[7] - 1u)));
#pragma unroll
    for (int r = 8; r < NR; ++r) { lmx = max(lmx, e[r]); lmn = min(lmn, e[r] - 1u); }
    const bool has = lmx != 0u;
    unsigned lo = lo_in + 1u, hi = wave_umax(lmx) + 1u;
    int clo = n;
    auto count_ge = [&](unsigned mid) { int c = 0;
#pragma unroll
        for (int r4 = 0; r4 < 8; r4 += 4) {
            unsigned long long m0 = __builtin_amdgcn_uicmp(e[r4], mid, 35  ), m1 = __builtin_amdgcn_uicmp(e[r4 + 1], mid, 35), m2 = __builtin_amdgcn_uicmp(e[r4 + 2], mid, 35), m3 = __builtin_amdgcn_uicmp(e[r4 + 3], mid, 35);
            asm volatile("" : "+s"(m0), "+s"(m1), "+s"(m2), "+s"(m3));
            c += __popcll(m0) + __popcll(m1) + __popcll(m2) + __popcll(m3); }
#pragma unroll
        for (int r = 8; r < NR; ++r) c += __popcll(__builtin_amdgcn_uicmp(e[r], mid, 35));
        return c; };
    { const unsigned p0 = wave_umax(has ? lmn + 1u : 0u), p1 = wave_umin(has ? lmx : 0xFFFFFFFFu);
#pragma unroll
      for (int k = 0; k < 2; ++k) { const unsigned mid = k ? p1 : p0;
          if (mid > lo && mid < hi && clo > TK_K + slack) { const int c = count_ge(mid); if (c >= TK_K) { lo = mid; clo = c; } else hi = mid; } } }
#pragma unroll 1
    while (hi - lo > 1u && clo > TK_K + slack) {
        const unsigned mid = lo + ((hi - lo) >> 1); const int c = count_ge(mid);
        if (c >= TK_K) { lo = mid; clo = c; } else hi = mid;
    }
    LDS_WAIT();
    int base = 0;
#pragma unroll
    for (int r = 0; r < NR; ++r) { const bool keep = e[r] >= lo; const unsigned long long m = __ballot(keep);
        const unsigned pre = __builtin_amdgcn_mbcnt_hi((unsigned)(m >> 32), __builtin_amdgcn_mbcnt_lo((unsigned)m, 0u));
        LAS unsigned* dst = keep ? bufq + base + pre : trash + lane;
        *dst = e[r];
        base += __popcll(m); }
    LDS_WAIT();
    nkeep = base;
    return lo - 1u;
}
__device__ __forceinline__ void tk_compact_all(LAS unsigned* buf, LAS unsigned* ct, int limit, int slack, int lane) {
#pragma unroll 1
    for (int ql = 0; ql < 8; ++ql) { const int n = __builtin_amdgcn_readfirstlane(ct[ql]);
        if (n > limit) { int nk; const unsigned T = tk_compact(buf + ql * TK_CAP, buf + TKW_TRASH / 4, n, __builtin_amdgcn_readfirstlane(ct[8 + ql]), slack, lane, nk); if (lane == 0) { ct[ql] = (unsigned)nk; ct[8 + ql] = T; } } }
    LDS_WAIT();
}
__device__ __forceinline__ void topk_attn_unit(const GAS bf16* Z, const GAS bf16* KIT, GAS bf16* YB, LAS unsigned char* lds, int b, int qb, int wave, int lane_in, unsigned long long& pr_acc) {
    unsigned long long pr_t0 = (MK_PROBE >= 20) ? __builtin_amdgcn_s_memrealtime() : 0ull; unsigned long long pr_c = 0ull;
    (void)lane_in; unsigned ones_u = ~0u; asm volatile("" : "+s"(ones_u));
    const int lane = (int)__builtin_amdgcn_mbcnt_hi(ones_u, __builtin_amdgcn_mbcnt_lo(ones_u, 0u));
    LAS unsigned char* wl = lds + wave * TKW_BYTES;
    LAS unsigned* buf = (LAS unsigned*)(wl + TKW_BUF); LAS unsigned* ct = (LAS unsigned*)(wl + TKW_CT);
    const int half = lane >> 5, l31 = lane & 31;
    const size_t growb = (size_t)b * SEQ;
    const int tq0 = qb * 64 + wave * 8;
    if (lane < 16) ct[lane] = 0u;
    bf16x8 aq[4];
    { const GAS bf16* qr = Z + (growb + tq0 + (l31 >> 2)) * ZLD + ZB_QI + (l31 & 3) * 64 + 8 * half;
#pragma unroll
      for (int ks = 0; ks < 4; ++ks) aq[ks] = *(const GAS bf16x8*)(qr + 16 * ks); }
    float wv[4][4];
#pragma unroll
    for (int g = 0; g < 4; ++g) { const v2u ww = *(const GAS v2u*)(Z + (growb + tq0 + 2 * g + half) * ZLD + ZB_WI);
        wv[g][0] = bflo(ww.x) * 0.0625f; wv[g][1] = bfhi(ww.x) * 0.0625f; wv[g][2] = bflo(ww.y) * 0.0625f; wv[g][3] = bfhi(ww.y) * 0.0625f; }
    unsigned thr[4] = {0u, 0u, 0u, 0u};
    constexpr unsigned OVB1 = (unsigned)(0x8000 - TK_TRIG - 1), OVB = OVB1 * 0x00010001u;
    unsigned cpk[4] = {OVB, OVB, OVB, OVB};
    unsigned sh16 = (unsigned)half << 4, hmask = half ? 0u : ~0u; asm volatile("" : "+v"(sh16), "+v"(hmask));
    LAS unsigned* hb = buf + half * TK_CAP - OVB1;
    LAS unsigned* tr0 = buf + TKW_TRASH / 4 + lane;
    LDS_WAIT();
    const int ktmax = (tq0 + 7) >> 5;
    const GAS unsigned char* kimg = (const GAS unsigned char*)KIT + (size_t)(growb >> 5) * 4096 + lane * 16;
#define TK_GLD(dst, KT) do { const GAS unsigned char* kb_ = kimg + (unsigned)(KT) * 4096u; _Pragma("unroll") for (int i_ = 0; i_ < 4; ++i_) dst[i_] = *(const GAS bf16x8*)(kb_ + i_ * 1024); } while (0)
    bf16x8 bk[4];
    TK_GLD(bk, 0);
#pragma unroll 1
    for (int kt = 0; kt <= ktmax; ++kt) {
        bf16x8 bkn[4];
        { const int ktn = (kt < ktmax) ? kt + 1 : kt; TK_GLD(bkn, ktn); }
        f32x16 acc;
#pragma unroll
        for (int r = 0; r < 16; ++r) acc[r] = 0.f;
#pragma unroll
        for (int ks = 0; ks < 4; ++ks) acc = __builtin_amdgcn_mfma_f32_32x32x16_bf16(aq[ks], bk[ks], acc, 0, 0, 0);
        const int key = 32 * kt + l31;
#pragma unroll
        for (int g = 0; g < 4; ++g) {
            const int tq = tq0 + 2 * g + half;
            float s = 0.f;
#pragma unroll
            for (int h = 0; h < 4; ++h) { const float av = acc[4 * g + h]; const int ib = __float_as_int(av); s = fmaf(wv[g][h], __builtin_bit_cast(float, ib > 0 ? ib : 0), s); }
            const unsigned bb = __float_as_uint(s);
            const unsigned ord = bb ^ ((unsigned)((int)bb >> 31) | 0x80000000u);
            const unsigned packed = (ord & 0xFFFFE000u) | (0x1FFFu - (unsigned)key);
            const bool pass = (key <= tq) && (packed > thr[g]);
            const unsigned long long mask = __builtin_amdgcn_sicmp(key, tq, 41  ) & __builtin_amdgcn_uicmp(packed, thr[g], 34  );
            {
                const unsigned mlo = (unsigned)mask, mhi = (unsigned)(mask >> 32);
                const unsigned pos = __builtin_amdgcn_mbcnt_hi(mhi, __builtin_amdgcn_mbcnt_lo(mlo & hmask, __builtin_amdgcn_ubfe(cpk[g], sh16, 16u)));
                LAS unsigned* d1 = hb + pos; asm volatile("" : "+v"(d1));
                LAS unsigned* dst = pass ? d1 : tr0 - 2 * g * TK_CAP;
                dst[2 * g * TK_CAP] = packed;
                cpk[g] += (unsigned)__popc(mlo) + ((unsigned)__popc(mhi) << 16);
            }
        }
        if (((cpk[0] | cpk[1] | cpk[2] | cpk[3]) & 0x80008000u) != 0u) {
#pragma unroll
            for (int g = 0; g < 4; ++g) if (l31 == 0) ct[2 * g + half] = __builtin_amdgcn_ubfe(cpk[g], sh16, 16u) - OVB1;
            LDS_WAIT();
            { const unsigned long long c0_ = (MK_PROBE >= 20) ? __builtin_amdgcn_s_memrealtime() : 0ull;
            tk_compact_all(buf, ct, TK_TRIG, TK_SLACK, lane);
            if (MK_PROBE >= 20) pr_c += __builtin_amdgcn_s_memrealtime() - c0_; }
#pragma unroll
            for (int g = 0; g < 4; ++g) { cpk[g] = ((unsigned)__builtin_amdgcn_readfirstlane(ct[2 * g]) | ((unsigned)__builtin_amdgcn_readfirstlane(ct[2 * g + 1]) << 16)) + OVB; thr[g] = ct[8 + 2 * g + half]; }
        }
#pragma unroll
        for (int ks = 0; ks < 4; ++ks) bk[ks] = bkn[ks];
    }
#pragma unroll
    for (int g = 0; g < 4; ++g) if (l31 == 0) ct[2 * g + half] = __builtin_amdgcn_ubfe(cpk[g], sh16, 16u) - OVB1;
    LDS_WAIT();
    { const unsigned long long c0_ = (MK_PROBE >= 20) ? __builtin_amdgcn_s_memrealtime() : 0ull;
    tk_compact_all(buf, ct, TK_K, 0, lane);
    if (MK_PROBE >= 20) pr_c += __builtin_amdgcn_s_memrealtime() - c0_; }
#pragma unroll 1
    for (int ql = 0; ql < 8; ++ql) { const int nq = __builtin_amdgcn_readfirstlane(ct[ql]); LAS unsigned* bq_ = buf + ql * TK_CAP;
#pragma unroll
        for (int r = 0; r < 4; ++r) { const int idx = lane + 64 * r; const unsigned e_ = bq_[idx]; const unsigned key_ = (idx < nq) ? 0x1FFFu - (e_ & 0x1FFFu) : 0u; bq_[idx] = ((unsigned)growb + key_) * (unsigned)(ZLD * 2); } }
    LDS_WAIT();
    const unsigned long long pr_t1 = (MK_PROBE >= 20) ? __builtin_amdgcn_s_memrealtime() : 0ull;
    unsigned ones_v = ~0u; asm volatile("" : "+s"(ones_v)); const int lane2 = (int)__builtin_amdgcn_mbcnt_hi(ones_v, __builtin_amdgcn_mbcnt_lo(ones_v, 0u));
    const GAS bf16* Z2 = Z; GAS bf16* YB2 = YB; int tq02 = tq0, b2 = b, wv2 = wave; asm volatile("" : "+s"(Z2), "+s"(YB2), "+s"(tq02), "+s"(b2), "+s"(wv2));
    const size_t growb2 = (size_t)b2 * SEQ;
    LAS unsigned char* wl2 = lds + wv2 * TKW_BYTES;
    LAS unsigned* buf2 = (LAS unsigned*)(wl2 + TKW_BUF); LAS float* ps2 = (LAS float*)buf2; LAS unsigned* ct2 = (LAS unsigned*)(wl2 + TKW_CT);
    const int fr = lane2 & 15, fg = lane2 >> 4;
    const int jj = lane2 >> 3, ch = lane2 & 7;
    const int q4 = fr >> 2, p4 = fr & 3;
    LAS unsigned char* vt = (LAS unsigned char*)buf2;
#define TK_LDK(dst, BQ, NN, bt) do { _Pragma("unroll") for (int t4_ = 0; t4_ < 4; ++t4_) { const unsigned o_ = (BQ)[16 * (4 * (bt) + t4_) + fr] + kl; \
        dst[t4_][0] = *(const GAS bf16x8*)(zk + o_); dst[t4_][1] = *(const GAS bf16x8*)(zk + o_ + 64); } } while (0)
#define TK_LDQ(dst, QROW) do { _Pragma("unroll") for (int ks_ = 0; ks_ < 2; ++ks_) { bf16x8 t_ = {0, 0, 0, 0, 0, 0, 0, 0}; \
        if (fr < 4) t_ = *(const GAS bf16x8*)(Z2 + (QROW) * ZLD + ZB_Q + fr * 64 + 32 * ks_ + 8 * fg); dst[ks_] = t_; } } while (0)
#define TK_MMA(src, bt) do { _Pragma("unroll") for (int t4_ = 0; t4_ < 4; ++t4_) { f32x4 c_ = {0.f, 0.f, 0.f, 0.f}; \
        c_ = __builtin_amdgcn_mfma_f32_16x16x32_bf16(src[t4_][0], bqf[0], c_, 0, 0, 0); c_ = __builtin_amdgcn_mfma_f32_16x16x32_bf16(src[t4_][1], bqf[1], c_, 0, 0, 0); sacc[4 * (bt) + t4_] = c_; } } while (0)
#define TK_LDV(dst, ks) do { _Pragma("unroll") for (int i_ = 0; i_ < 4; ++i_) { const unsigned o_ = bq[32 * (ks) + 16 * (jj >> 2) + 4 * i_ + (jj & 3)] + vl; dst[i_] = *(const GAS v4u*)(zv + o_); } } while (0)
    const GAS unsigned char* zk = (const GAS unsigned char*)Z2 + ZB_K * 2; const GAS unsigned char* zv = (const GAS unsigned char*)Z2 + ZB_V * 2;
    const unsigned kl = 16u * (unsigned)fg, vl = 16u * (unsigned)ch;
    bf16x8 kan[4][2], bqn[2];
    { const int n0 = __builtin_amdgcn_readfirstlane(ct2[0]); TK_LDK(kan, buf2, n0, 0); TK_LDQ(bqn, growb2 + tq02); }
#pragma unroll 1
    for (int ql = 0; ql < 8; ++ql) {
        const int n = __builtin_amdgcn_readfirstlane(ct2[ql]);
        const size_t qrow = growb2 + tq02 + ql;
        LAS unsigned* bq = buf2 + ql * TK_CAP;
        bf16x8 bqf[2], kaA[4][2], kaB[4][2];
#pragma unroll
        for (int ks = 0; ks < 2; ++ks) bqf[ks] = bqn[ks];
#pragma unroll
        for (int t4 = 0; t4 < 4; ++t4) { kaA[t4][0] = kan[t4][0]; kaA[t4][1] = kan[t4][1]; }
        f32x4 sacc[16];
        v4u vr[4][4];
        TK_LDK(kaB, bq, n, 1);
        TK_MMA(kaA, 0);
        TK_LDK(kaA, bq, n, 2);
        TK_MMA(kaB, 1);
        TK_LDK(kaB, bq, n, 3);
        TK_MMA(kaA, 2);
        TK_LDV(vr[0], 0); TK_LDV(vr[1], 1); TK_LDV(vr[2], 2);
        TK_MMA(kaB, 3);
        const int nfg = n - 4 * fg;
        float mx = -INFINITY;
#pragma unroll
        for (int kt = 0; kt < 16; ++kt)
#pragma unroll
            for (int r = 0; r < 4; ++r) { const float v = (16 * kt + r < nfg) ? sacc[kt][r] * 0.125f : -INFINITY; sacc[kt][r] = v; mx = fmaxf(mx, v); }
        mx = fmaxf(mx, swz_xor<16>(mx)); mx = half_max(mx);
        float sm = 0.f;
#pragma unroll
        for (int kt = 0; kt < 16; ++kt)
#pragma unroll
            for (int r = 0; r < 4; ++r) { const float e = __expf(sacc[kt][r] - mx); sacc[kt][r] = e; sm += e; }
        sm += swz_xor<16>(sm); sm = half_sum(sm);
        const float inv = __builtin_amdgcn_rcpf(sm);
        bf16x8 pa[8];
#pragma unroll
        for (int ks = 0; ks < 8; ++ks) {
            v4u w; w.x = pk2(sacc[2 * ks][0] * inv, sacc[2 * ks][1] * inv); w.y = pk2(sacc[2 * ks][2] * inv, sacc[2 * ks][3] * inv);
            w.z = pk2(sacc[2 * ks + 1][0] * inv, sacc[2 * ks + 1][1] * inv); w.w = pk2(sacc[2 * ks + 1][2] * inv, sacc[2 * ks + 1][3] * inv);
            pa[ks] = __builtin_bit_cast(bf16x8, w); }
        f32x4 oacc[4];
#pragma unroll
        for (int nt = 0; nt < 4; ++nt) oacc[nt] = (f32x4){0.f, 0.f, 0.f, 0.f};
#pragma unroll
        for (int ks = 0; ks < 8; ++ks) {
            if (ks + 3 < 8) TK_LDV(vr[(ks + 3) & 3], ks + 3);
            if (ks == 5) { const int qn = (ql < 7) ? ql + 1 : 7; const int nn = __builtin_amdgcn_readfirstlane(ct2[qn]); TK_LDK(kan, buf2 + qn * TK_CAP, nn, 0); TK_LDQ(bqn, growb2 + tq02 + qn); }
#pragma unroll
            for (int i = 0; i < 4; ++i) *(LAS v4u*)(vt + i * (TK_CAP * 4) + 1024 + jj * 128 + ch * 16) = vr[ks & 3][i];
            LDS_WAIT();
#pragma unroll
            for (int nt = 0; nt < 4; ++nt) {
                typedef short s4v __attribute__((ext_vector_type(4)));
                const s4v lo = __builtin_amdgcn_ds_read_tr16_b64_v4i16((LAS s4v*)(vt + fg * (TK_CAP * 4) + 1024 + q4 * 128 + (16 * nt + 4 * p4) * 2));
                const s4v hi = __builtin_amdgcn_ds_read_tr16_b64_v4i16((LAS s4v*)(vt + fg * (TK_CAP * 4) + 1024 + (4 + q4) * 128 + (16 * nt + 4 * p4) * 2));
                const bf16x8 vb = {lo[0], lo[1], lo[2], lo[3], hi[0], hi[1], hi[2], hi[3]};
                oacc[nt] = __builtin_amdgcn_mfma_f32_16x16x32_bf16(pa[ks], vb, oacc[nt], 0, 0, 0); }
            LDS_WAIT();
        }
        if (fg == 0) {
#pragma unroll
            for (int nt = 0; nt < 4; ++nt)
#pragma unroll
                for (int h = 0; h < 4; ++h) YB2[qrow * 256 + h * 64 + 16 * nt + fr] = (bf16)f2bf(oacc[nt][h]);
        }
    }
#undef TK_GLD
#undef TK_LDK
#undef TK_LDQ
#undef TK_MMA
#undef TK_LDV
    if (MK_PROBE >= 20) { const unsigned long long pr_t2 = __builtin_amdgcn_s_memrealtime(); pr_acc += (MK_PROBE == 20) ? (pr_t1 - pr_t0 - pr_c) : (MK_PROBE == 21) ? pr_c : (pr_t2 - pr_t1); }
}

__device__ __forceinline__ void zero_ys(GAS bf16* Y, int gtid, int gstride) { for (size_t i = gtid; i < (size_t)MG * 256 / 8; i += gstride) ((GAS v4u*)Y)[i] = (v4u){0u, 0u, 0u, 0u}; }

__device__ __forceinline__ const void* ld_arg(LAS unsigned char* lds, int k) {
    unsigned off = MISC_OFF + 128 + 8 * k; asm volatile("" : "+v"(off));
    const LAS unsigned* p = (const LAS unsigned*)(lds + off);
    const unsigned lo = __builtin_amdgcn_readfirstlane(p[0]), hi = __builtin_amdgcn_readfirstlane(p[1]);
    return (const void*)(((unsigned long long)hi << 32) | lo);
}
__device__ __forceinline__ bool run_step(int lo, int hi, int s) {
    asm volatile("" : "+s"(lo), "+s"(hi));
    return s >= lo && s < hi;
}
struct GatedOrder {
    int G, c;
    __device__ __forceinline__ void init(int G_, int c_) { G = G_; c = c_; }
    __device__ __forceinline__ bool next(int i, pg8::Unit& u) const {
        const int nb = i & 3, t = (i >> 2) * G + c; if (t >= (MG / 256) * 4) return false;
        u.pm = nb * (MG / 256) + (t >> 2); u.pn = nb * 4 + (t & 3); return true;
    }
    __device__ __forceinline__ void a_ready(const pg8::Unit&) const {}
    __device__ __forceinline__ void done(const pg8::Unit&) const {}
};
struct KArgs { const void* in[22]; float* out; unsigned char* ws; int step_lo, step_hi, li, pad; };
constexpr int N_STEPS = 32;

__global__ void __launch_bounds__(NTHREADS, 2) mega_fwd(KArgs a) {
    extern __shared__ __attribute__((aligned(16))) unsigned char lds_raw[];
    LAS unsigned char* lds = (LAS unsigned char*)lds_raw;
    volatile LAS unsigned* MISC = (volatile LAS unsigned*)(lds + MISC_OFF);
    const int G = gridDim.x; const int bx = blockIdx.x; const int vcu = (G % 8 == 0) ? (bx % 8) * (G / 8) + bx / 8 : bx;
    const int NGW = G * NWAVES, gstride = G * NTHREADS;
    if (threadIdx.x < 16) MISC[threadIdx.x] = 0u;
    const int wave_s = __builtin_amdgcn_readfirstlane(threadIdx.x >> 6);
    if (threadIdx.x < 22) ((volatile LAS unsigned long long*)(lds + MISC_OFF + 128))[threadIdx.x] = (unsigned long long)a.in[threadIdx.x];
    __syncthreads();
#define IN(k) ((const GAS float*)ld_arg(lds, (k)))
    GAS unsigned char* const ws_k = (GAS unsigned char*)a.ws;
    const bool use_bar = (a.step_hi - a.step_lo) > 1;
    XcdBarrier bar; bar.bar = (unsigned*)(ws_k + WS_CTL) + CW_BAR + a.li * XCD_BAR_WORDS; bar.x = 0; bar.st = nullptr;
    if (use_bar) bar = xcd_barrier_post((unsigned*)(ws_k + WS_CTL) + CW_BAR + a.li * XCD_BAR_WORDS, MISC + 8);
#define RUN(s) run_step(a.step_lo, a.step_hi, (s))
    unsigned long long pr_acc = 0ull, pr_prev = MK_PROBE ? __builtin_amdgcn_s_memrealtime() : 0ull; const unsigned long long pr_start = pr_prev;
#define SEAM(s) do { if (RUN(s) && RUN((s) + 1)) xcd_barrier(bar); if (MK_PROBE > 0 && MK_PROBE < 20) { const unsigned long long tn_ = __builtin_amdgcn_s_memrealtime(); \
        const int s_ = (s); const int ty_ = (s_ == 0) ? 1 : (s_ == 31) ? 12 : (((s_ - 1) % 15) == 0) ? 2 : (((s_ - 1) % 15) >= 11) ? (((s_ - 1) % 15) - 3) : ((((s_ - 1) % 15) - 1) % 5 + 3); \
        if (ty_ == MK_PROBE) pr_acc += tn_ - pr_prev; pr_prev = tn_; } } while (0)
#define STEP_IDS unsigned ones_ = ~0u; asm volatile("" : "+s"(ones_)); GAS unsigned char* ws = ws_k; asm volatile("" : "+s"(ws)); const int lane = (int)__builtin_amdgcn_mbcnt_hi(ones_, __builtin_amdgcn_mbcnt_lo(ones_, 0u)); int wave = wave_s; asm volatile("" : "+s"(wave)); \
    const int tid = wave * 64 + lane; const int gw = vcu * NWAVES + wave, gtid = vcu * NTHREADS + tid; (void)gw; (void)gtid;
#define STEP_L int l = l0; asm volatile("" : "+s"(l));
#define STEP_G int g = g0; asm volatile("" : "+s"(g));
#define P_CMOD ((GAS float*)(ws + WS_CMOD))
#define P_ROPE ((GAS float*)(ws + WS_ROPE))
#define P_H ((GAS bf16*)(ws + WS_H))
#define P_Z ((GAS bf16*)(ws + WS_Z))
#define P_GT ((GAS bf16*)(ws + WS_GATES))
#define P_YS ((GAS bf16*)(ws + WS_YS))
#define P_XR ((GAS bf16*)(ws + WS_MF32))
#define P_KIT ((GAS bf16*)(ws + WS_KIT))
#define P_STC ((GAS bf16*)(ws + WS_STC))
#define P_STD ((GAS bf16*)(ws + WS_STD))
#define P_DECC ((GAS float*)(ws + WS_DECC))
#define P_DECD ((GAS float*)(ws + WS_DECD))
#define P_U ((GAS bf16*)(ws + WS_U))

    if (RUN(0)) { STEP_IDS
        p0_weights(IN(7), IN(17), IN(18), IN(19), IN(20), ws, lds, gw, NGW, wave, lane);
        __syncthreads();
        p0_rope(P_ROPE, gtid, gstride);
        p0_cmod(IN(1), IN(3), IN(4), P_CMOD, lds, vcu, G, tid, wave, lane);
    }
    SEAM(0);

    for (int l0 = 0; l0 < NL; ++l0) {
        const int sb = 1 + l0 * 15;
        if (RUN(sb)) { STEP_IDS STEP_L
            if (MK_SKIP & 1) { if (l == 0) copy_rows(IN(0), P_XR, gw, NGW, lane); }
            else if (l == 0) norm_rows<true>(IN(0), P_H, IN(5) + l * DM, P_CMOD + (size_t)l * NB * 6144, 0, 1024, gw, NGW, lane);
            else norm_rows<false>(P_XR, P_H, IN(5) + l * DM, P_CMOD + (size_t)l * NB * 6144, 0, 1024, gw, NGW, lane);
        }
        SEAM(sb);
        for (int g0 = 0; g0 < NGRP; ++g0) {
            const int sg = sb + 1 + g0 * 5;
            if (RUN(sg) && !(MK_SKIP & 1)) { STEP_IDS STEP_L STEP_G
                pg8::Gemm gm{(const bf16*)(P_H + (size_t)g * MG * DM), (const bf16*)((const GAS bf16*)(ws + WS_WIN) + (size_t)l * NV * 1024), MG, NV, 1024};
                pg8::StaticOrder S; S.init(MG, NV, G, bx);
                EpiZ E{P_Z, P_GT};
                for (int rp = 0; rp < ((MK_REPEAT & 8) ? 2 : 1); ++rp) pg8::gemm_phase<EpiZ, pg8::StaticOrder, true, true>(lds, gm, S, E, tid);
            }
            SEAM(sg);
            if (RUN(sg + 1) && !(MK_SKIP & 1)) { STEP_IDS STEP_L STEP_G
                LinPar LP{P_Z, IN(12) + l * 16 * 128, IN(13) + l * 128, IN(15), l};
                constexpr int U_ROPE = 10 * (MG / NTHREADS), U_CONV = GB * 128, U_LIN = GB * NCH * 2;
                for (int u = vcu; u < U_ROPE + U_CONV + 2 * U_LIN; u += G) {
                    int r = u;
                    if (r < U_LIN) { if (!(MK_SKIP & 32)) lin2_unit<64, 0>(LP, P_STD, P_DECD, nullptr, nullptr, lds, r, wave); continue; } r -= U_LIN;
                    if (r < U_LIN) { if (!(MK_SKIP & 16)) lin2_unit<32, 0>(LP, P_STC, P_DECC, nullptr, nullptr, lds, r, wave); continue; } r -= U_LIN;
                    if (r < U_CONV) { if (!(MK_SKIP & 4)) conv2_unit(P_Z, P_YS, IN(8) + l * 31 * 256, IN(9) + l * 256, IN(10) + l * 256, IN(11) + l * 256, lds, r, wave); continue; } r -= U_CONV;
                    if (!(MK_SKIP & 8)) rope_unit(P_Z, P_KIT, (const GAS int*)IN(2) + (size_t)g * MG, P_ROPE, r, tid);
                }
                if (MK_SKIP & 4) zero_ys(P_YS, gtid, gstride);
                if (MK_SKIP & 8) zero_ys(P_YS + (size_t)MG * 256, gtid, gstride);
                if (MK_SKIP & 16) zero_ys(P_YS + (size_t)2 * MG * 256, gtid, gstride);
                if (MK_SKIP & 32) zero_ys(P_YS + (size_t)3 * MG * 256, gtid, gstride);
            }
            SEAM(sg + 1);
            if (RUN(sg + 2) && !(MK_SKIP & 1)) { STEP_IDS STEP_L STEP_G
                constexpr int U_SCAN = (GB * 4096 + GB * 8192) / 192;
                if (!(MK_SKIP & 48)) for (int u = vcu; u < U_SCAN; u += G) scan_unit(P_STC, P_STD, P_DECC, P_DECD, u, tid);
                if (!(MK_SKIP & 8)) for (int rp = 0; rp < ((MK_REPEAT & 1) ? 2 : 1); ++rp) {
                    const int W = G / GB;
                    if (W > 0 && vcu < W * GB) { const int b = vcu / W, j = vcu % W;
                        for (int p2 = 2 * j; p2 < 128; p2 += 2 * W) for (int it = 0; it < 2; ++it) { const int p = p2 >> 1; topk_attn_unit(P_Z, P_KIT, P_YS + (size_t)MG * 256, lds, b, it ? p : 127 - p, wave, lane, pr_acc); } }
                }
            }
            SEAM(sg + 2);
            if (RUN(sg + 3) && !(MK_SKIP & 1)) { STEP_IDS STEP_L STEP_G
                LinPar LP{P_Z, IN(12) + l * 16 * 128, IN(13) + l * 128, IN(15), l};
                constexpr int U_LIN = GB * NCH * 2;
                for (int rp = 0; rp < ((MK_REPEAT & 2) ? 2 : 1); ++rp)
                for (int u = vcu; u < 2 * U_LIN; u += G) {
                    if (u < U_LIN) { if (!(MK_SKIP & 16)) lin2_unit<32, 1>(LP, P_STC, nullptr, IN(14) + l * 64, P_YS + (size_t)2 * MG * 256, lds, u, wave); }
                    else { if (!(MK_SKIP & 32)) lin2_unit<64, 1>(LP, P_STD, nullptr, IN(16) + l * 64, P_YS + (size_t)3 * MG * 256, lds, u - U_LIN, wave); }
                }
            }
            SEAM(sg + 3);
            if (RUN(sg + 4) && !(MK_SKIP & 1)) { STEP_IDS STEP_L STEP_G
                pg8::Gemm gm{(const bf16*)(P_YS), (const bf16*)((const GAS bf16*)(ws + WS_WBO) + (size_t)l * 4 * 1024 * 256), 4 * MG, 4 * 1024, 256};
                GatedOrder S; S.init(G, vcu);
                EpiGated E{P_GT, P_H + (size_t)g * MG * DM};
                for (int rp = 0; rp < ((MK_REPEAT & 32) ? 2 : 1); ++rp) pg8::gemm_phase<EpiGated, GatedOrder, true, true>(lds, gm, S, E, tid);
            }
            SEAM(sg + 4);
        }
        if (RUN(sb + 11) && !(MK_SKIP & 1)) { STEP_IDS STEP_L
            pg8::Gemm gm{(const bf16*)(P_H), (const bf16*)((const GAS bf16*)(ws + WS_WO) + (size_t)l * 1024 * 1024), M_ALL, 1024, 1024};
            pg8::StaticOrder S; S.init(M_ALL, 1024, G, bx);
            if (l == 0) { EpiResid<true> E{IN(0), P_XR, P_CMOD + (size_t)l * NB * 6144 + 2048}; pg8::gemm_phase<EpiResid<true>, pg8::StaticOrder, true, true>(lds, gm, S, E, tid); }
            else { EpiResid<false> E{P_XR, P_XR, P_CMOD + (size_t)l * NB * 6144 + 2048}; pg8::gemm_phase<EpiResid<false>, pg8::StaticOrder, true, true>(lds, gm, S, E, tid); }
        }
        SEAM(sb + 11);
        if (RUN(sb + 12) && !(MK_SKIP & 2)) { STEP_IDS STEP_L
            norm_rows<false>(P_XR, P_H, IN(6) + l * DM, P_CMOD + (size_t)l * NB * 6144, 3072, 4096, gw, NGW, lane); }
        SEAM(sb + 12);
        if (RUN(sb + 13) && !(MK_SKIP & 2)) { STEP_IDS STEP_L
            pg8::Gemm gm{(const bf16*)(P_H), (const bf16*)((const GAS bf16*)(ws + WS_W1) + (size_t)l * DFF * 1024), M_ALL, DFF, 1024};
            pg8::StaticOrder S; S.init(M_ALL, DFF, G, bx);
            EpiRelu2 E{P_U};
            for (int rp = 0; rp < ((MK_REPEAT & 16) ? 2 : 1); ++rp) pg8::gemm_phase<EpiRelu2, pg8::StaticOrder, true, true>(lds, gm, S, E, tid);
        }
        SEAM(sb + 13);
        if (RUN(sb + 14) && !(MK_SKIP & 2)) { STEP_IDS STEP_L
            pg8::Gemm gm{(const bf16*)(P_U), (const bf16*)((const GAS bf16*)(ws + WS_W2) + (size_t)l * 1024 * DFF), M_ALL, 1024, DFF};
            pg8::StaticOrder S; S.init(M_ALL, 1024, G, bx);
            EpiResid<false> E{P_XR, P_XR, P_CMOD + (size_t)l * NB * 6144 + 5120};
            pg8::gemm_phase<EpiResid<false>, pg8::StaticOrder, true, true>(lds, gm, S, E, tid);
        }
        SEAM(sb + 14);
    }
    if (RUN(31)) { STEP_IDS
        float oscale = 1.0f;
        if (MK_PROBE) { const unsigned long long tt_ = __builtin_amdgcn_s_memrealtime() - pr_start; oscale = 1.0f + (float)pr_acc / ((float)tt_ * (float)MK_PROBE_DIV); }
        final_norm_rows(P_XR, ((GAS float*)a.out), IN(21), gw, NGW, lane, oscale); }
#undef RUN
#undef SEAM
}

extern "C" void kernel_launch(void* const* d_in, const int* in_sizes, int n_in, void* d_out, int out_size, void* d_ws, size_t ws_size, hipStream_t stream) {
    static int grid = 0;
    if (grid == 0) {
        if (n_in != 22 || out_size != M_ALL * DM || ws_size < WS_END) { fprintf(stderr, "kernel_launch: unexpected problem shape (n_in %d out %d ws %zu)\n", n_in, out_size, ws_size); grid = -1; return; }
        int dev = 0, cus = 0, per_cu = 0;
        if (hipGetDevice(&dev) != hipSuccess || hipDeviceGetAttribute(&cus, hipDeviceAttributeMultiprocessorCount, dev) != hipSuccess) { grid = -1; return; }
        if (hipFuncSetAttribute((const void*)mega_fwd, hipFuncAttributeMaxDynamicSharedMemorySize, LDS_BYTES) != hipSuccess) { fprintf(stderr, "kernel_launch: hipFuncSetAttribute failed\n"); grid = -1; return; }
        if (hipOccupancyMaxActiveBlocksPerMultiprocessor(&per_cu, (const void*)mega_fwd, NTHREADS, LDS_BYTES) != hipSuccess || per_cu < 1) fprintf(stderr, "kernel_launch: occupancy query reports %d\n", per_cu);
        (void)hipGetLastError();
        grid = cus;
    }
    if (grid < 0) return;
    (void)hipMemsetAsync((char*)d_ws + WS_CTL, 0, CTL_ZERO_BYTES, stream);
    KArgs a{};
    for (int i = 0; i < 22; ++i) a.in[i] = d_in[i];
    a.out = (float*)d_out; a.ws = (unsigned char*)d_ws; a.pad = 0;
#if MK_N_LAUNCHES == 1
    a.step_lo = 0; a.step_hi = N_STEPS; a.li = 0;
    hipLaunchKernelGGL(mega_fwd, dim3(grid), dim3(NTHREADS), LDS_BYTES, stream, a);
#else
    for (int s = 0; s < N_STEPS; ++s) { a.step_lo = s; a.step_hi = s + 1; a.li = s;
        hipLaunchKernelGGL(mega_fwd, dim3(grid), dim3(NTHREADS), LDS_BYTES, stream, a); }
#endif
}
```

```cpp
#include <hip/hip_runtime.h>
#include <cstdio>
#include <cstdint>

namespace pg8 {
#define PG8_LAS __attribute__((address_space(3)))
typedef unsigned short bf16_t;
typedef short bf16x8 __attribute__((ext_vector_type(8)));
typedef float f32x4 __attribute__((ext_vector_type(4)));
typedef unsigned u32x4 __attribute__((ext_vector_type(4)));
constexpr int BM = 256, BK = 64, HALF = 128, HTB = HALF * BK * 2  , STAGE_BYTES = 8 * HTB, NXCD = 8, WGM = 4;

__host__ __device__ __forceinline__ int lds_byte(int r, int c) { const int st = (r >> 4) * 2 + (c >> 5), rr = r & 15, cc = c & 31, ob = rr * 64 + cc * 2; return st * 1024 + (ob ^ (((ob >> 9) & 1) << 5)); }
__host__ __device__ __forceinline__ void stage_rc(int b, int& R, int& C) { const int st = b / 1024, sb = b % 1024, swz = sb ^ (((sb >> 9) & 1) << 5); R = (st >> 1) * 16 + swz / 64; C = (st & 1) * 32 + (swz % 64) / 2; }
__host__ __device__ __forceinline__ int perm32(int rho) { const int n = rho >> 4, i = rho & 15; return 8 * (i >> 2) + 4 * n + (i & 3); }

struct Unit { int pm, pn; };
struct Gemm { const bf16_t* A; const bf16_t* Bt; int M, N, K; };

struct StaticOrder {
    int nM, nN, nwg, G, c;
    __host__ __device__ void init(int M, int N, int G_, int c_) { nM = M / BM; nN = N / BM; nwg = nM * nN; G = G_; c = c_; }
    __host__ __device__ bool next(int i, Unit& u) const {
        const long L = (long)i * G + c; if (L >= nwg) return false;
        int wgid = (int)L; { const int q = nwg / NXCD, r = nwg % NXCD, xcd = wgid % NXCD, off = wgid / NXCD; wgid = (xcd < r ? xcd * (q + 1) : r * (q + 1) + (xcd - r) * q) + off; }
        const int nig = WGM * nN, gid = wgid / nig, fm = gid * WGM, gsz = (nM - fm) < WGM ? (nM - fm) : WGM;
        u.pm = fm + ((wgid % nig) % gsz); u.pn = (wgid % nig) / gsz; return true;
    }
    __device__ __forceinline__ void a_ready(const Unit&) const {}
    __device__ __forceinline__ void done(const Unit&) const {}
};
__device__ __forceinline__ unsigned cvt_pk_bf16(float lo, float hi) { typedef __bf16 bf16pair_ __attribute__((ext_vector_type(2))); const bf16pair_ v = {(__bf16)lo, (__bf16)hi}; return __builtin_bit_cast(unsigned, v); }
typedef float f32x2 __attribute__((ext_vector_type(2)));
template <class Epi, class Sched, bool ALIGN_EPI = false, bool SP2 = false>
__device__ __forceinline__ void gemm_phase(PG8_LAS unsigned char* lds, const Gemm g, const Sched& S, const Epi& E, int tid_in) {
    int tid_l = tid_in; asm volatile("" : "+v"(tid_l));
    const int tid = tid_l, wid = __builtin_amdgcn_readfirstlane(tid >> 6), lane = tid & 63, wr = wid >> 2, wc = wid & 3, fr = lane & 15, fq = lane >> 4;
    const int K = g.K, nt = K / BK;
    unsigned voffA[2], voffB[2];
#pragma unroll
    for (int i = 0; i < 2; ++i) { int R, C; stage_rc(tid * 16 + i * 8192, R, C); const int Rb = Epi::PERM ? ((R & ~31) + perm32(R & 31)) : R;
        voffA[i] = (unsigned)(R * K + C) * 2u; voffB[i] = (unsigned)(Rb * K + C) * 2u; }
    const size_t kstep = (size_t)(BK * 2);
    const size_t hstep = (size_t)HALF * K * 2;
    const size_t tstep = 2 * hstep;
    const unsigned ldsw = (unsigned)wid * 1024u;
    const int aoff = lds_byte(wr * 64 + fr, fq * 8), boff = lds_byte(wc * 32 + fr, fq * 8);
#define PG8_SA(b, h) (((b) * 2 + (h)) * HTB)
#define PG8_SB(b, h) ((4 + (b) * 2 + (h)) * HTB)
#define PG8_STAGE(bufoff, gbase, voff) do { _Pragma("unroll") for (int _i = 0; _i < 2; ++_i) \
        __builtin_amdgcn_global_load_lds((const unsigned*)((const char*)(gbase) + (voff)[_i]), (PG8_LAS unsigned*)(lds + (bufoff) + ldsw + _i * 8192), 16, 0, 0); } while (0)
#define PG8_LDA(dst, b, h) do { _Pragma("unroll") for (int m = 0; m < 4; ++m) _Pragma("unroll") for (int k = 0; k < 2; ++k) dst[m][k] = *(const PG8_LAS bf16x8*)(lds + PG8_SA(b, h) + aoff + m * 2048 + k * 1024); } while (0)
#define PG8_LDB(dst, b, h) do { _Pragma("unroll") for (int n = 0; n < 2; ++n) _Pragma("unroll") for (int k = 0; k < 2; ++k) dst[n][k] = *(const PG8_LAS bf16x8*)(lds + PG8_SB(b, h) + boff + n * 2048 + k * 1024); } while (0)
#define PG8_MMA(ai, bj, At, Bt) do { __builtin_amdgcn_s_setprio(1); _Pragma("unroll") for (int m = 0; m < 4; ++m) _Pragma("unroll") for (int n = 0; n < 2; ++n) _Pragma("unroll") for (int k = 0; k < 2; ++k) \
        acc[ai][bj][m][n] = __builtin_amdgcn_mfma_f32_16x16x32_bf16(Bt[n][k], At[m][k], acc[ai][bj][m][n], 0, 0, 0); __builtin_amdgcn_s_setprio(0); } while (0)
#define PG8_WAIT_V(n) asm volatile("s_waitcnt vmcnt(" #n ")" ::: "memory")
#define PG8_WAIT_L(n) asm volatile("s_waitcnt lgkmcnt(" #n ")" ::: "memory")
#define PG8_BAR __builtin_amdgcn_s_barrier()
#define PG8_SCHED __builtin_amdgcn_sched_barrier(0)
    Unit cur, nxt; int ui = 0;
    if (!S.next(0, cur)) return;
    f32x4 acc[2][2][4][2];
#pragma unroll
    for (int a = 0; a < 2; ++a)
#pragma unroll
        for (int b = 0; b < 2; ++b)
#pragma unroll
            for (int m = 0; m < 4; ++m)
#pragma unroll
                for (int n = 0; n < 2; ++n) acc[a][b][m][n] = (f32x4){0.f, 0.f, 0.f, 0.f};
    bf16x8 At[4][2], B0[2][2], B1[2][2];
    const char* cA = (const char*)g.A + (size_t)cur.pm * tstep; const char* cB = (const char*)g.Bt + (size_t)cur.pn * tstep;
    S.a_ready(cur);
    if constexpr (SP2) {
        PG8_STAGE(PG8_SB(0, 0), cB, voffB); PG8_STAGE(PG8_SB(0, 1), cB + hstep, voffB); PG8_STAGE(PG8_SA(0, 0), cA, voffA); PG8_STAGE(PG8_SA(0, 1), cA + hstep, voffA);
        if (wr == 1) PG8_BAR;
        PG8_WAIT_V(2); PG8_BAR;
        PG8_STAGE(PG8_SB(1, 0), cB + kstep, voffB); PG8_STAGE(PG8_SA(1, 0), cA + kstep, voffA); PG8_STAGE(PG8_SB(1, 1), cB + hstep + kstep, voffB);
        PG8_WAIT_V(6); PG8_BAR;
    } else {
        PG8_STAGE(PG8_SB(0, 0), cB, voffB); PG8_STAGE(PG8_SA(0, 0), cA, voffA); PG8_STAGE(PG8_SB(0, 1), cB + hstep, voffB); PG8_STAGE(PG8_SA(0, 1), cA + hstep, voffA);
        if (wr == 1) PG8_BAR;
        PG8_WAIT_V(4); PG8_BAR;
        PG8_STAGE(PG8_SB(1, 0), cB + kstep, voffB); PG8_STAGE(PG8_SA(1, 0), cA + kstep, voffA); PG8_STAGE(PG8_SB(1, 1), cB + hstep + kstep, voffB);
        PG8_WAIT_V(6); PG8_BAR;
    }
    for (;;) {
        const bool has_next = S.next(ui + 1, nxt);
        const char* nA = has_next ? (const char*)g.A + (size_t)nxt.pm * tstep : cA; const char* nB = has_next ? (const char*)g.Bt + (size_t)nxt.pn * tstep : cB;
        for (int t = 0; t < nt; t += 2) {
            const bool last = (t == nt - 2);
            const char* a1 = cA + (size_t)(t + 1) * kstep;
            const char* a2 = last ? nA : cA + (size_t)(t + 2) * kstep; const char* b2 = last ? nB : cB + (size_t)(t + 2) * kstep;
            const char* a3 = a2 + kstep; const char* b3 = b2 + kstep;
            if (last && has_next) S.a_ready(nxt);
            if constexpr (SP2) {
            PG8_LDB(B0, 0, 0); PG8_LDB(B1, 0, 1); PG8_SCHED; PG8_LDA(At, 0, 0); PG8_STAGE(PG8_SA(1, 1), a1 + hstep, voffA);
            PG8_WAIT_V(8); PG8_WAIT_L(0); PG8_BAR; PG8_MMA(0, 0, At, B0); PG8_MMA(0, 1, At, B1); PG8_BAR; PG8_SCHED;
            PG8_LDA(At, 0, 1); PG8_STAGE(PG8_SB(0, 0), b2, voffB); PG8_STAGE(PG8_SB(0, 1), b2 + hstep, voffB); PG8_STAGE(PG8_SA(0, 0), a2, voffA);
            PG8_WAIT_V(8); PG8_WAIT_L(0); PG8_BAR; PG8_MMA(1, 0, At, B0); PG8_MMA(1, 1, At, B1); PG8_BAR; PG8_SCHED;
            PG8_LDB(B0, 1, 0); PG8_LDB(B1, 1, 1); PG8_SCHED; PG8_LDA(At, 1, 0); PG8_STAGE(PG8_SA(0, 1), a2 + hstep, voffA);
            PG8_WAIT_V(8); PG8_WAIT_L(0); PG8_BAR; PG8_MMA(0, 0, At, B0); PG8_MMA(0, 1, At, B1); PG8_BAR; PG8_SCHED;
            PG8_LDA(At, 1, 1); PG8_STAGE(PG8_SB(1, 0), b3, voffB); PG8_STAGE(PG8_SB(1, 1), b3 + hstep, voffB); PG8_STAGE(PG8_SA(1, 0), a3, voffA);
            PG8_WAIT_V(8); PG8_WAIT_L(0); PG8_BAR; PG8_MMA(1, 0, At, B0); PG8_MMA(1, 1, At, B1); PG8_BAR; PG8_SCHED;
            } else {
            PG8_LDB(B0, 0, 0); PG8_SCHED; PG8_LDA(At, 0, 0); PG8_STAGE(PG8_SA(1, 1), a1 + hstep, voffA);
            PG8_WAIT_L(8); PG8_BAR; PG8_WAIT_L(0); PG8_MMA(0, 0, At, B0); PG8_BAR; PG8_SCHED;
            PG8_LDB(B1, 0, 1); PG8_STAGE(PG8_SB(0, 0), b2, voffB);
            PG8_BAR; PG8_WAIT_L(0); PG8_MMA(0, 1, At, B1); PG8_BAR;
            PG8_LDA(At, 0, 1); PG8_STAGE(PG8_SA(0, 0), a2, voffA);
            PG8_BAR; PG8_WAIT_L(0); PG8_MMA(1, 0, At, B0); PG8_BAR; PG8_SCHED;
            PG8_STAGE(PG8_SB(0, 1), b2 + hstep, voffB);
            PG8_WAIT_V(6); PG8_BAR; PG8_MMA(1, 1, At, B1); PG8_BAR;
            PG8_LDB(B0, 1, 0); PG8_SCHED; PG8_LDA(At, 1, 0); PG8_STAGE(PG8_SA(0, 1), a2 + hstep, voffA);
            PG8_WAIT_L(8); PG8_BAR; PG8_WAIT_L(0); PG8_MMA(0, 0, At, B0); PG8_BAR; PG8_SCHED;
            PG8_LDB(B1, 1, 1); PG8_STAGE(PG8_SB(1, 0), b3, voffB);
            PG8_BAR; PG8_WAIT_L(0); PG8_MMA(0, 1, At, B1); PG8_BAR;
            PG8_LDA(At, 1, 1); PG8_STAGE(PG8_SA(1, 0), a3, voffA);
            PG8_BAR; PG8_WAIT_L(0); PG8_MMA(1, 0, At, B0); PG8_BAR; PG8_SCHED;
            PG8_STAGE(PG8_SB(1, 1), b3 + hstep, voffB);
            PG8_WAIT_V(6); PG8_BAR; PG8_MMA(1, 1, At, B1); PG8_BAR;
            }
        }
        if constexpr (ALIGN_EPI) { if (wr == 0) PG8_BAR; }
        if constexpr (!Epi::AFTER_DRAIN) { unsigned o_ = ~0u; asm volatile("" : "+s"(o_)); const int l_ = (int)__builtin_amdgcn_mbcnt_hi(o_, __builtin_amdgcn_mbcnt_lo(o_, 0u));
            E(acc, cur, wr, wc, l_ & 15, l_ >> 4); S.done(cur); }
        if (!has_next) break;
        if (!E.keep_acc(cur)) {
#pragma unroll
        for (int a = 0; a < 2; ++a)
#pragma unroll
            for (int b = 0; b < 2; ++b)
#pragma unroll
                for (int m = 0; m < 4; ++m)
#pragma unroll
                    for (int n = 0; n < 2; ++n) acc[a][b][m][n] = (f32x4){0.f, 0.f, 0.f, 0.f};
        }
        cur = nxt; cA = nA; cB = nB; ++ui;
        if constexpr (ALIGN_EPI) { if (wr == 1) PG8_BAR; }
    }
    PG8_WAIT_V(0);
    if constexpr (!ALIGN_EPI) { if (wr == 0) PG8_BAR; }
    PG8_BAR;
    if constexpr (Epi::AFTER_DRAIN) { E.fused(acc, cur, wr, wc, fr, fq, lds, wid, lane); S.done(cur); }
#undef PG8_SA
#undef PG8_SB
#undef PG8_STAGE
#undef PG8_LDA
#undef PG8_LDB
#undef PG8_MMA
#undef PG8_WAIT_V
#undef PG8_WAIT_L
#undef PG8_BAR
#undef PG8_SCHED
}
}

#ifndef MK_N_LAUNCHES
#define MK_N_LAUNCHES 1
#endif
#ifndef MK_REPEAT
#define MK_REPEAT 0
#endif
#ifndef MK_PROBE
#define MK_PROBE 0
#endif
#ifndef MK_PROBE_DIV
#define MK_PROBE_DIV 1
#endif
#ifndef MK_SKIP
#define MK_SKIP 0
#endif
constexpr int NB = 8, SEQ = 8192, DM = 1024, NL = 2, BW = 256, DFF = 4096;
constexpr int M_ALL = NB * SEQ;
constexpr int NGRP = 2, GB = NB / NGRP;
constexpr int MG = GB * SEQ;
constexpr int N_IN = 7124, NV = 7168, ZLD = 3072, GLD = 4096;
constexpr int NCH = SEQ / 64;
constexpr float EPS = 1e-6f;
constexpr int ZA_VAL = 0, ZA_GATE = 256, ZB_Q = 512, ZB_K = 768, ZB_V = 832, ZB_QI = 896, ZB_KI = 1152, ZB_WI = 1216;
constexpr int ZC_Q = 1224, ZC_K = 1352, ZC_V = 1480, ZC_OG = 1736, ZC_GLR = 1992, ZD_F = 2008, ZD_Q = 2264, ZD_I = 2520, ZD_OG = 2776;
__host__ __device__ __forceinline__ int win_src(int j) { if (j < 1220) return j; if (j < 1224) return -1; if (j < 3032) return j - 4; if (j < 3072) return -1;
    const int gi = j - 3072, q = gi >> 8, t = gi & 255; const int nbr = 2 * (t >> 7) + ((t >> 2) & 1), x = ((t >> 5) & 3) * 16 + ((t >> 3) & 3) * 4 + (t & 3);
    return 3028 + nbr * 1024 + 64 * q + x; }

constexpr size_t MiB = 1u << 20;
constexpr size_t WS_CTL = 0, CTL_ZERO_BYTES = 1 * MiB;
constexpr size_t WS_CMOD = 1 * MiB;
constexpr size_t WS_ROPE = 1 * MiB + 512 * 1024;
constexpr size_t WS_WIN = 4 * MiB;
constexpr size_t WS_WBO = 32 * MiB;
constexpr size_t WS_WO = 36 * MiB;
constexpr size_t WS_W1 = 40 * MiB;
constexpr size_t WS_W2 = 56 * MiB;
constexpr size_t WS_H = 76 * MiB;
constexpr size_t WS_Z = 204 * MiB;
constexpr size_t WS_GATES = 396 * MiB;
constexpr size_t WS_YS = 652 * MiB;
constexpr size_t WS_MF32 = 716 * MiB;
constexpr size_t WS_STC = 844 * MiB;
constexpr size_t WS_STD = 860 * MiB;
constexpr size_t WS_DECC = 892 * MiB;
constexpr size_t WS_DECD = 893 * MiB;
constexpr size_t WS_U = 204 * MiB;
constexpr size_t WS_KIT = 896 * MiB;
constexpr size_t WS_END = 900 * MiB;
constexpr int CW_BAR = 4096;

constexpr int NWAVES = 8, NTHREADS = 512;
constexpr int LDS_BYTES = 163840, MISC_OFF = LDS_BYTES - 512;

#define GAS __attribute__((address_space(1)))
#define LAS __attribute__((address_space(3)))
typedef unsigned short bf16;
typedef unsigned v4u __attribute__((ext_vector_type(4)));
typedef unsigned v2u __attribute__((ext_vector_type(2)));
typedef float f32x4 __attribute__((ext_vector_type(4)));
typedef short bf16x8 __attribute__((ext_vector_type(8)));
typedef float f32x16 __attribute__((ext_vector_type(16)));
#define LDS_WAIT() asm volatile("s_waitcnt lgkmcnt(0)" ::: "memory")
#define VM_WAIT() asm volatile("s_waitcnt vmcnt(0)" ::: "memory")
__device__ __forceinline__ float bf2f(unsigned v) { return __uint_as_float(v << 16); }
__device__ __forceinline__ float bflo(unsigned w) { return __uint_as_float(w << 16); }
__device__ __forceinline__ float bfhi(unsigned w) { return __uint_as_float(w & 0xffff0000u); }
typedef __bf16 bf16pair_t __attribute__((ext_vector_type(2)));
__device__ __forceinline__ unsigned pk2(float lo, float hi) { const bf16pair_t v = {(__bf16)lo, (__bf16)hi}; return __builtin_bit_cast(unsigned, v); }
__device__ __forceinline__ unsigned f2bf(float f) { return (unsigned)__builtin_bit_cast(unsigned short, (__bf16)f); }
template <int M> __device__ __forceinline__ float swz_xor(float v) { return __builtin_bit_cast(float, __builtin_amdgcn_ds_swizzle(__builtin_bit_cast(int, v), 0x1F | (M << 10))); }
__device__ __forceinline__ float half_sum(float v) { const unsigned u = __builtin_bit_cast(unsigned, v); auto r = __builtin_amdgcn_permlane32_swap(u, u, false, false);
    return __builtin_bit_cast(float, (unsigned)r[0]) + __builtin_bit_cast(float, (unsigned)r[1]); }
__device__ __forceinline__ float half_max(float v) { const unsigned u = __builtin_bit_cast(unsigned, v); auto r = __builtin_amdgcn_permlane32_swap(u, u, false, false);
    return fmaxf(__builtin_bit_cast(float, (unsigned)r[0]), __builtin_bit_cast(float, (unsigned)r[1])); }
__device__ __forceinline__ float wave_sum(float v) { v += swz_xor<1>(v); v += swz_xor<2>(v); v += swz_xor<4>(v); v += swz_xor<8>(v); v += swz_xor<16>(v); return half_sum(v); }
__device__ __forceinline__ float wave_max(float v) { v = fmaxf(v, swz_xor<1>(v)); v = fmaxf(v, swz_xor<2>(v)); v = fmaxf(v, swz_xor<4>(v)); v = fmaxf(v, swz_xor<8>(v)); v = fmaxf(v, swz_xor<16>(v)); return half_max(v); }
__device__ __forceinline__ float sigm(float x) { return __builtin_amdgcn_rcpf(1.0f + __expf(-x)); }
__device__ __forceinline__ float siluf(float x) { return x * sigm(x); }
__device__ __forceinline__ float logsigm(float x) { return fminf(x, 0.f) - __logf(1.0f + __expf(-fabsf(x))); }

#define XB_TMO      128
#define XB_XCNT(j)  (256  + 64 * (j))
#define XB_XSUB(j)  (1280 + 64 * (j))
#define XB_XGEN(j)  (2304 + 64 * (j))
#define XB_TOP      3328
#define XB_TOPGEN   3392
#define XCD_BAR_WORDS 3456
#define XB_SPIN_CAP (1u << 18)
__device__ __forceinline__ unsigned xb_ld(unsigned* p)              { return __hip_atomic_load(p, __ATOMIC_RELAXED, __HIP_MEMORY_SCOPE_AGENT); }
__device__ __forceinline__ unsigned xb_add(unsigned* p, unsigned v) { return __hip_atomic_fetch_add(p, v, __ATOMIC_RELAXED, __HIP_MEMORY_SCOPE_AGENT); }
__device__ __forceinline__ unsigned xb_xcc_id() { return (unsigned)__builtin_amdgcn_s_getreg((3 << 11) | 20) & 0xFu; }
#define XB_SPIN(cond, bar) do { unsigned _sp = 0; while (cond) { __builtin_amdgcn_s_sleep(1); \
    if ((++_sp & 255u) == 0u) { if (xb_ld(&(bar)[XB_TMO])) break; if (_sp > XB_SPIN_CAP) { atomicAdd(&(bar)[XB_TMO], 1u); break; } } } } while (0)
struct XcdBarrier { unsigned* bar; unsigned x; volatile LAS unsigned* st; };
__device__ __forceinline__ XcdBarrier xcd_barrier_post(unsigned* bar, volatile LAS unsigned* st) {
    XcdBarrier b; b.bar = bar; b.x = xb_xcc_id(); b.st = st;
    if (threadIdx.x == 0) (void)xb_add(&bar[XB_XCNT(b.x)], 1u);
    return b;
}
__device__ __forceinline__ void xcd_barrier_complete(unsigned* bar, unsigned x, unsigned& nloc, unsigned& nx) {
    const unsigned G = gridDim.x * gridDim.y * gridDim.z;
    unsigned sum, cnt, mine, sp = 0u;
    for (;;) {
        sum = 0u; cnt = 0u; mine = 0u;
#pragma unroll
        for (unsigned j = 0; j < 16; ++j) { const unsigned c = xb_ld(&bar[XB_XCNT(j)]); sum += c; cnt += (c > 0u) ? 1u : 0u; mine = (j == x) ? c : mine; }
        if (sum == G) break;
        __builtin_amdgcn_s_sleep(1);
        if ((++sp & 255u) == 0u) { if (xb_ld(&bar[XB_TMO])) break; if (sp > XB_SPIN_CAP) { atomicAdd(&bar[XB_TMO], 1u); break; } }
    }
    nloc = mine > 0u ? mine : 1u; nx = cnt > 0u ? cnt : 1u;
}
__device__ __forceinline__ void xcd_barrier(const XcdBarrier& b) {
    asm volatile("s_waitcnt vmcnt(0)" ::: "memory");
    __syncthreads();
    if (threadIdx.x == 0) {
        unsigned* bar = b.bar;
        __builtin_amdgcn_s_waitcnt(0);
        unsigned nloc = b.st[0], nx = b.st[1];
        if (nloc == 0u) { xcd_barrier_complete(bar, b.x, nloc, nx); b.st[0] = nloc; b.st[1] = nx; }
        const unsigned old = xb_add(&bar[XB_XSUB(b.x)], 1u);
        const unsigned gen = old / nloc;
        if (old + 1u == (gen + 1u) * nloc) {
            __builtin_amdgcn_fence(__ATOMIC_RELEASE, "agent");
            asm volatile("s_waitcnt vmcnt(0)" ::: "memory");
            const unsigned og = xb_add(&bar[XB_TOP], 1u);
            const unsigned tg = og / nx;
            if (og + 1u == (tg + 1u) * nx) xb_add(&bar[XB_TOPGEN], 1u);
            else XB_SPIN(xb_ld(&bar[XB_TOPGEN]) == tg, bar);
            __builtin_amdgcn_fence(__ATOMIC_ACQUIRE, "agent");
            xb_add(&bar[XB_XGEN(b.x)], 1u);
            asm volatile("s_waitcnt vmcnt(0)" ::: "memory");
        } else {
            XB_SPIN(xb_ld(&bar[XB_XGEN(b.x)]) == gen, bar);
            __builtin_amdgcn_fence(__ATOMIC_ACQUIRE, "agent");
            asm volatile("s_waitcnt vmcnt(0)" ::: "memory");
        }
    }
    __syncthreads();
}

struct EpiZ {
    static constexpr bool PERM = true, AFTER_DRAIN = false;
    __device__ __forceinline__ bool keep_acc(const pg8::Unit&) const { return false; }
    GAS bf16* Z; GAS bf16* Gt;
    __device__ __forceinline__ void operator()(const pg8::f32x4 (&acc)[2][2][4][2], const pg8::Unit& u, int wr, int wc, int fr_, int fq_) const {
        int fr = fr_, fq = fq_; asm volatile("" : "+v"(fr), "+v"(fq));
        if (u.pn < 12) {
            const int row0 = u.pm * 256 + wr * 64 + fr, col0 = u.pn * 256 + wc * 32 + 8 * fq;
#pragma unroll
            for (int ai = 0; ai < 2; ++ai)
#pragma unroll
                for (int m = 0; m < 4; ++m) { GAS bf16* rowp = Z + (size_t)(row0 + ai * 128 + m * 16) * ZLD + col0;
#pragma unroll
                    for (int bj = 0; bj < 2; ++bj) { const pg8::f32x4 v0 = acc[ai][bj][m][0], v1 = acc[ai][bj][m][1];
                        pg8::u32x4 w; w.x = pg8::cvt_pk_bf16(v0[0], v0[1]); w.y = pg8::cvt_pk_bf16(v0[2], v0[3]); w.z = pg8::cvt_pk_bf16(v1[0], v1[1]); w.w = pg8::cvt_pk_bf16(v1[2], v1[3]);
                        __builtin_nontemporal_store(w, (GAS pg8::u32x4*)(rowp + bj * 128)); } }
        } else {
            const int tid = (wr * 4 + wc) * 64 + fq * 16 + fr;
            GAS unsigned char* tb = (GAS unsigned char*)Gt + (size_t)(u.pm * 16 + (u.pn - 12)) * 131072 + tid * 8;
#pragma unroll
            for (int ai = 0; ai < 2; ++ai)
#pragma unroll
                for (int m = 0; m < 4; ++m) { float p0[4], p1[4], p2[4], p3[4];
#pragma unroll
                    for (int j = 0; j < 4; ++j) {
                        const float d0 = fminf(1.0f + __expf(-acc[ai][0][m][0][j]), 1e30f), d1 = fminf(1.0f + __expf(-acc[ai][0][m][1][j]), 1e30f);
                        const float d2 = fminf(1.0f + __expf(-acc[ai][1][m][0][j]), 1e30f), d3 = fminf(1.0f + __expf(-acc[ai][1][m][1][j]), 1e30f);
                        const float i0 = __builtin_amdgcn_rcpf(d0), i1 = __builtin_amdgcn_rcpf(d1), i2 = __builtin_amdgcn_rcpf(d2), i3 = __builtin_amdgcn_rcpf(d3);
                        p0[j] = d1 * i0; p1[j] = d2 * i1; p2[j] = d3 * i2; p3[j] = i3; }
                    GAS unsigned char* cb = tb + (ai * 4 + m) * 4096;
                    __builtin_nontemporal_store((v2u){pg8::cvt_pk_bf16(p0[0], p0[1]), pg8::cvt_pk_bf16(p0[2], p0[3])}, (GAS v2u*)(cb));
                    __builtin_nontemporal_store((v2u){pg8::cvt_pk_bf16(p1[0], p1[1]), pg8::cvt_pk_bf16(p1[2], p1[3])}, (GAS v2u*)(cb + 32768));
                    __builtin_nontemporal_store((v2u){pg8::cvt_pk_bf16(p2[0], p2[1]), pg8::cvt_pk_bf16(p2[2], p2[3])}, (GAS v2u*)(cb + 2 * 32768));
                    __builtin_nontemporal_store((v2u){pg8::cvt_pk_bf16(p3[0], p3[1]), pg8::cvt_pk_bf16(p3[2], p3[3])}, (GAS v2u*)(cb + 3 * 32768)); }
        }
    }
};
struct EpiGated {
    static constexpr bool PERM = true, AFTER_DRAIN = false;
    const GAS bf16* Gt; GAS bf16* Mo;
    __device__ __forceinline__ bool keep_acc(const pg8::Unit& u) const { return (u.pn >> 2) < 3; }
    __device__ __forceinline__ void operator()(pg8::f32x4 (&acc)[2][2][4][2], const pg8::Unit& u, int wr, int wc, int fr_, int fq_) const {
        int fr = fr_, fq = fq_; asm volatile("" : "+v"(fr), "+v"(fq));
        const int nb = u.pn >> 2;
        const int row0 = (u.pm - nb * (MG / 256)) * 256 + wr * 64 + fr, col0 = (u.pn & 3) * 256 + wc * 32 + 8 * fq;
        const int tz = (wr * 4 + 2 * (wc & 1) + (fq >> 1)) * 64 + (2 * (fq & 1)) * 16 + fr;
        const GAS unsigned char* tb = (const GAS unsigned char*)Gt + ((size_t)((u.pm - nb * (MG / 256)) * 16 + 4 * (u.pn & 3) + (wc >> 1)) * 4 + nb) * 32768 + tz * 8;
        v2u gf[2][4][2][2];
#pragma unroll
        for (int ai = 0; ai < 2; ++ai)
#pragma unroll
            for (int m = 0; m < 4; ++m)
#pragma unroll
                for (int bj = 0; bj < 2; ++bj)
#pragma unroll
                    for (int n = 0; n < 2; ++n) gf[ai][m][bj][n] = *(const GAS v2u*)(tb + (unsigned)(bj * (2 * 131072) + (ai * 4 + m) * 4096 + n * 128));
#pragma unroll
        for (int ai = 0; ai < 2; ++ai)
#pragma unroll
            for (int m = 0; m < 4; ++m) { const unsigned r = (unsigned)(row0 + ai * 128 + m * 16);
#pragma unroll
                for (int bj = 0; bj < 2; ++bj) {
                    pg8::f32x4 v0 = acc[ai][bj][m][0], v1 = acc[ai][bj][m][1];
                    const v2u a0 = gf[ai][m][bj][0], a1 = gf[ai][m][bj][1];
                    v0[0] *= bflo(a0.x); v0[1] *= bfhi(a0.x); v0[2] *= bflo(a0.y); v0[3] *= bfhi(a0.y); v1[0] *= bflo(a1.x); v1[1] *= bfhi(a1.x); v1[2] *= bflo(a1.y); v1[3] *= bfhi(a1.y);
                    if (nb < 3) { acc[ai][bj][m][0] = v0; acc[ai][bj][m][1] = v1; }
                    else { const unsigned c = (unsigned)(col0 + bj * 128); v4u o; o.x = pg8::cvt_pk_bf16(v0[0], v0[1]); o.y = pg8::cvt_pk_bf16(v0[2], v0[3]); o.z = pg8::cvt_pk_bf16(v1[0], v1[1]); o.w = pg8::cvt_pk_bf16(v1[2], v1[3]);
                        *(GAS v4u*)(Mo + (r * 1024u + c)) = o; } } }
    }
};
template <bool BASE_F32> struct EpiResid {
    static constexpr bool PERM = true, AFTER_DRAIN = false;
    __device__ __forceinline__ bool keep_acc(const pg8::Unit&) const { return false; }
    const GAS void* base; GAS bf16* out; const GAS float* gv;
    __device__ __forceinline__ void operator()(const pg8::f32x4 (&acc)[2][2][4][2], const pg8::Unit& u, int wr, int wc, int fr_, int fq_) const {
        int fr = fr_, fq = fq_; asm volatile("" : "+v"(fr), "+v"(fq));
        const int row0 = u.pm * 256 + wr * 64 + fr, col0 = u.pn * 256 + wc * 32 + 8 * fq;
        const GAS float* gb = gv + (size_t)((u.pm * 256) / SEQ) * 6144 + col0;
        pg8::f32x4 g4[2][2];
#pragma unroll
        for (int bj = 0; bj < 2; ++bj)
#pragma unroll
            for (int n = 0; n < 2; ++n) g4[bj][n] = *(const GAS pg8::f32x4*)(gb + bj * 128 + n * 4);
        if constexpr (BASE_F32) {
#pragma unroll
            for (int ai = 0; ai < 2; ++ai) { pg8::f32x4 bs[4][2][2];
#pragma unroll
                for (int m = 0; m < 4; ++m) { const size_t off = (size_t)(row0 + ai * 128 + m * 16) * 1024 + col0;
#pragma unroll
                    for (int bj = 0; bj < 2; ++bj) { bs[m][bj][0] = *(const GAS pg8::f32x4*)((const GAS float*)base + off + bj * 128); bs[m][bj][1] = *(const GAS pg8::f32x4*)((const GAS float*)base + off + bj * 128 + 4); } }
                asm volatile("" ::: "memory");
#pragma unroll
                for (int m = 0; m < 4; ++m) { const size_t off = (size_t)(row0 + ai * 128 + m * 16) * 1024 + col0;
#pragma unroll
                    for (int bj = 0; bj < 2; ++bj) { const pg8::f32x4 v0 = bs[m][bj][0] + g4[bj][0] * acc[ai][bj][m][0], v1 = bs[m][bj][1] + g4[bj][1] * acc[ai][bj][m][1];
                        v4u o; o.x = pg8::cvt_pk_bf16(v0[0], v0[1]); o.y = pg8::cvt_pk_bf16(v0[2], v0[3]); o.z = pg8::cvt_pk_bf16(v1[0], v1[1]); o.w = pg8::cvt_pk_bf16(v1[2], v1[3]);
                        *(GAS v4u*)(out + off + bj * 128) = o; } }
                asm volatile("" ::: "memory"); }
        } else {
#pragma unroll
            for (int ai = 0; ai < 2; ++ai) { v4u bw[4][2];
#pragma unroll
                for (int m = 0; m < 4; ++m) { const size_t off = (size_t)(row0 + ai * 128 + m * 16) * 1024 + col0;
#pragma unroll
                    for (int bj = 0; bj < 2; ++bj) bw[m][bj] = *(const GAS v4u*)((const GAS bf16*)base + off + bj * 128); }
                asm volatile("" ::: "memory");
#pragma unroll
                for (int m = 0; m < 4; ++m) { const size_t off = (size_t)(row0 + ai * 128 + m * 16) * 1024 + col0;
#pragma unroll
                    for (int bj = 0; bj < 2; ++bj) { const v4u w = bw[m][bj];
                        const pg8::f32x4 b0 = (pg8::f32x4){bflo(w.x), bfhi(w.x), bflo(w.y), bfhi(w.y)}, b1 = (pg8::f32x4){bflo(w.z), bfhi(w.z), bflo(w.w), bfhi(w.w)};
                        const pg8::f32x4 v0 = b0 + g4[bj][0] * acc[ai][bj][m][0], v1 = b1 + g4[bj][1] * acc[ai][bj][m][1];
                        v4u o; o.x = pg8::cvt_pk_bf16(v0[0], v0[1]); o.y = pg8::cvt_pk_bf16(v0[2], v0[3]); o.z = pg8::cvt_pk_bf16(v1[0], v1[1]); o.w = pg8::cvt_pk_bf16(v1[2], v1[3]);
                        *(GAS v4u*)(out + off + bj * 128) = o; } }
                asm volatile("" ::: "memory"); }
        }
    }
};
struct EpiRelu2 {
    static constexpr bool PERM = true, AFTER_DRAIN = false;
    __device__ __forceinline__ bool keep_acc(const pg8::Unit&) const { return false; }
    GAS bf16* O;
    __device__ __forceinline__ void operator()(const pg8::f32x4 (&acc)[2][2][4][2], const pg8::Unit& u, int wr, int wc, int fr_, int fq_) const {
        int fr = fr_, fq = fq_; asm volatile("" : "+v"(fr), "+v"(fq));
        const int row0 = u.pm * 256 + wr * 64 + fr, col0 = u.pn * 256 + wc * 32 + 8 * fq;
#pragma unroll
        for (int ai = 0; ai < 2; ++ai)
#pragma unroll
            for (int m = 0; m < 4; ++m) { GAS bf16* rowp = O + (size_t)(row0 + ai * 128 + m * 16) * DFF + col0;
#pragma unroll
                for (int bj = 0; bj < 2; ++bj) { pg8::f32x4 v0 = acc[ai][bj][m][0], v1 = acc[ai][bj][m][1];
#pragma unroll
                    for (int j = 0; j < 4; ++j) { const float a = fmaxf(v0[j], 0.f), b = fmaxf(v1[j], 0.f); v0[j] = a * a; v1[j] = b * b; }
                    pg8::u32x4 w; w.x = pg8::cvt_pk_bf16(v0[0], v0[1]); w.y = pg8::cvt_pk_bf16(v0[2], v0[3]); w.z = pg8::cvt_pk_bf16(v1[0], v1[1]); w.w = pg8::cvt_pk_bf16(v1[2], v1[3]);
                    __builtin_nontemporal_store(w, (GAS pg8::u32x4*)(rowp + bj * 128)); } }
    }
};

template <bool MAPPED>
__device__ __forceinline__ void p0_item(const GAS float* W, int K, int ldw, GAS bf16* WT, LAS float* scr, int nblk, int item, int lane) {
    const int kb = item / nblk, nb = item % nblk, k0 = 64 * kb, n0 = 32 * nb;
    const int nv = n0 + (lane & 31); const int src = MAPPED ? win_src(nv) : nv;
    float wv_[32];
#pragma unroll
    for (int i = 0; i < 32; ++i) { const int kk = 2 * i + (lane >> 5); wv_[i] = (src >= 0) ? W[(size_t)(k0 + kk) * ldw + src] : 0.f; }
#pragma unroll
    for (int i = 0; i < 32; ++i) { const int kk = 2 * i + (lane >> 5); scr[kk * 33 + (lane & 31)] = wv_[i]; }
    LDS_WAIT(); asm volatile("" ::: "memory");
    const int c = lane & 7;
#pragma unroll
    for (int j = 0; j < 4; ++j) { const int n = (lane >> 3) + 8 * j; const LAS float* s = scr + (8 * c) * 33 + n;
        v4u o; o.x = pk2(s[0 * 33], s[1 * 33]); o.y = pk2(s[2 * 33], s[3 * 33]); o.z = pk2(s[4 * 33], s[5 * 33]); o.w = pk2(s[6 * 33], s[7 * 33]);
        *(GAS v4u*)(WT + (size_t)(n0 + n) * K + k0 + 8 * c) = o; }
    LDS_WAIT(); asm volatile("" ::: "memory");
}
__device__ __forceinline__ void p0_weights(const GAS float* w_in, const GAS float* w_bo, const GAS float* w_o, const GAS float* w1, const GAS float* w2, GAS unsigned char* ws, LAS unsigned char* lds, int gw, int NGW, int wave, int lane) {
    LAS float* scr = (LAS float*)(lds + wave * 8704);
    constexpr int I_IN = 16 * (NV / 32), I_BO = 4 * 32, I_O = 16 * 32, I_1 = 16 * 128, I_2 = 64 * 32;
    constexpr int NITEMS = NL * (I_IN + 4 * I_BO + I_O + I_1 + I_2);
    for (int it = gw; it < NITEMS; it += NGW) {
        int r = it;
        if (r < NL * I_IN) { const int l = r / I_IN; r -= l * I_IN; p0_item<true>(w_in + (size_t)l * 1024 * N_IN, 1024, N_IN, (GAS bf16*)(ws + WS_WIN) + (size_t)l * NV * 1024, scr, NV / 32, r, lane); continue; } r -= NL * I_IN;
        if (r < NL * 4 * I_BO) { const int ln = r / I_BO; r -= ln * I_BO; p0_item<false>(w_bo + (size_t)ln * 256 * 1024, 256, 1024, (GAS bf16*)(ws + WS_WBO) + (size_t)ln * 1024 * 256, scr, 32, r, lane); continue; } r -= NL * 4 * I_BO;
        if (r < NL * I_O) { const int l = r / I_O; r -= l * I_O; p0_item<false>(w_o + (size_t)l * 1024 * 1024, 1024, 1024, (GAS bf16*)(ws + WS_WO) + (size_t)l * 1024 * 1024, scr, 32, r, lane); continue; } r -= NL * I_O;
        if (r < NL * I_1) { const int l = r / I_1; r -= l * I_1; p0_item<false>(w1 + (size_t)l * 1024 * DFF, 1024, DFF, (GAS bf16*)(ws + WS_W1) + (size_t)l * DFF * 1024, scr, 128, r, lane); continue; } r -= NL * I_1;
        { const int l = r / I_2; r -= l * I_2; p0_item<false>(w2 + (size_t)l * DFF * 1024, DFF, 1024, (GAS bf16*)(ws + WS_W2) + (size_t)l * 1024 * DFF, scr, 32, r, lane); }
    }
}
__device__ __forceinline__ void p0_rope(GAS float* T, int gtid, int gstride) {
    for (int idx = gtid; idx < 16384 * 8; idx += gstride) {
        const int p = idx >> 3, j = idx & 7;
        const double inv = (j == 0) ? 1.0 : (j == 1) ? 0.19392274474868576 : (j == 2) ? 0.03760603093086393 : (j == 3) ? 0.007292664737217109 : (j == 4) ? 0.001414213562373095 :
                           (j == 5) ? 0.0002742481756762073 : (j == 6) ? 5.318295896944988e-05 : 1.031338537721246e-05;
        const double ang = (double)p * inv;
        const double n = __builtin_rint(ang * 0.15915494309189535);
        double r = __builtin_fma(-n, 6.283185307179586, ang); r = __builtin_fma(-n, 2.4492935982947064e-16, r);
        const double r2 = r * r;
        double s = 1.0, c = 1.0;
#pragma unroll
        for (int k = 14; k >= 1; --k) { s = 1.0 - r2 * s / (double)((2 * k) * (2 * k + 1)); c = 1.0 - r2 * c / (double)((2 * k - 1) * (2 * k)); }
        T[p * 16 + j] = (float)c; T[p * 16 + 8 + j] = (float)(r * s);
    }
}
__device__ __forceinline__ void p0_cmod(const GAS float* cin, const GAS float* ada_w, const GAS float* ada_b, GAS float* cmod, LAS unsigned char* lds, int vcu, int G, int tid, int wave, int lane) {
    LAS float* ca = (LAS float*)lds;
    LAS float* red = (LAS float*)(lds + 32768);
    for (int i = tid; i < 8192; i += NTHREADS) { const int b = i >> 10, k = i & 1023; const float v = cin[i]; ca[k * 8 + b] = siluf(v); }
    __syncthreads();
    for (int u = vcu; u < NL * 96; u += G) {
        const int l = u / 96, j0 = (u % 96) * 64;
        const GAS float* W = ada_w + (size_t)l * 1024 * 6144 + j0 + lane;
        float acc[8];
#pragma unroll
        for (int b = 0; b < 8; ++b) acc[b] = 0.f;
#pragma unroll 16
        for (int k = wave * 128; k < wave * 128 + 128; ++k) {
            const float wv = W[(size_t)k * 6144];
            const f32x4 c0 = *(const LAS f32x4*)(ca + k * 8), c1 = *(const LAS f32x4*)(ca + k * 8 + 4);
            acc[0] += c0[0] * wv; acc[1] += c0[1] * wv; acc[2] += c0[2] * wv; acc[3] += c0[3] * wv;
            acc[4] += c1[0] * wv; acc[5] += c1[1] * wv; acc[6] += c1[2] * wv; acc[7] += c1[3] * wv;
        }
#pragma unroll
        for (int b = 0; b < 8; ++b) red[(wave * 8 + b) * 64 + lane] = acc[b];
        __syncthreads();
        { const int b = tid >> 6, jj = tid & 63; float s = 0.f;
#pragma unroll
          for (int w = 0; w < 8; ++w) s += red[(w * 8 + b) * 64 + jj];
          cmod[((size_t)l * NB + b) * 6144 + j0 + jj] = s + ada_b[l * 6144 + j0 + jj]; }
        __syncthreads();
    }
}

template <bool IN_F32>
__device__ __forceinline__ void norm_rows(const GAS void* xin, GAS bf16* hout, const GAS float* gvec, const GAS float* cm  , int off_sh, int off_sc, int gw, int NGW, int lane) {
    const int WPB = NGW / NB;
    { const int bb = gw / WPB;
        const GAS float* cb = cm + (size_t)bb * 6144;
        float A[16], Bv[16];
#pragma unroll
        for (int hf = 0; hf < 2; ++hf)
#pragma unroll
            for (int q = 0; q < 2; ++q) { const int col = 512 * hf + 8 * lane + 4 * q;
                const f32x4 g4 = *(const GAS f32x4*)(gvec + col), sc4 = *(const GAS f32x4*)(cb + off_sc + col), sh4 = *(const GAS f32x4*)(cb + off_sh + col);
#pragma unroll
                for (int j = 0; j < 4; ++j) { A[8 * hf + 4 * q + j] = g4[j] * (sc4[j] + 1.0f); Bv[8 * hf + 4 * q + j] = sh4[j]; } }
        constexpr int RB = 4;
        auto finish_row = [&](const float (&v)[16], size_t m) {
            float ss = 0.f;
#pragma unroll
            for (int j = 0; j < 16; ++j) ss += v[j] * v[j];
            const float rr = __builtin_amdgcn_rsqf(wave_sum(ss) * (1.0f / DM) + EPS);
            GAS v4u* o16 = (GAS v4u*)(hout + m * DM);
#pragma unroll
            for (int hf = 0; hf < 2; ++hf) { float y[8];
#pragma unroll
                for (int j = 0; j < 8; ++j) y[j] = v[8 * hf + j] * rr * A[8 * hf + j] + Bv[8 * hf + j];
                v4u w; w.x = pk2(y[0], y[1]); w.y = pk2(y[2], y[3]); w.z = pk2(y[4], y[5]); w.w = pk2(y[6], y[7]); o16[64 * hf + lane] = w; } };
        int r = gw - bb * WPB;
#pragma unroll 1
        for (; r + (RB - 1) * WPB < SEQ; r += RB * WPB) {
            float v[RB][16];
#pragma unroll
            for (int k = 0; k < RB; ++k) { const size_t m = (size_t)bb * SEQ + r + k * WPB;
                if (IN_F32) { const GAS f32x4* xr = (const GAS f32x4*)((const GAS float*)xin + m * DM);
#pragma unroll
                    for (int hf = 0; hf < 2; ++hf)
#pragma unroll
                        for (int q = 0; q < 2; ++q) { const f32x4 t = xr[128 * hf + 2 * lane + q]; v[k][8 * hf + 4 * q] = t[0]; v[k][8 * hf + 4 * q + 1] = t[1]; v[k][8 * hf + 4 * q + 2] = t[2]; v[k][8 * hf + 4 * q + 3] = t[3]; } }
                else { const GAS v4u* xr = (const GAS v4u*)((const GAS bf16*)xin + m * DM);
#pragma unroll
                    for (int hf = 0; hf < 2; ++hf) { const v4u w = xr[64 * hf + lane];
                        v[k][8 * hf] = bflo(w.x); v[k][8 * hf + 1] = bfhi(w.x); v[k][8 * hf + 2] = bflo(w.y); v[k][8 * hf + 3] = bfhi(w.y); v[k][8 * hf + 4] = bflo(w.z); v[k][8 * hf + 5] = bfhi(w.z); v[k][8 * hf + 6] = bflo(w.w); v[k][8 * hf + 7] = bfhi(w.w); } } }
            asm volatile("" ::: "memory");
#pragma unroll
            for (int k = 0; k < RB; ++k) finish_row(v[k], (size_t)bb * SEQ + r + k * WPB);
        }
#pragma unroll 1
        for (; r < SEQ; r += WPB) {
            const size_t m = (size_t)bb * SEQ + r; float v[16];
            if (IN_F32) { const GAS f32x4* xr = (const GAS f32x4*)((const GAS float*)xin + m * DM);
#pragma unroll
                for (int hf = 0; hf < 2; ++hf)
#pragma unroll
                    for (int q = 0; q < 2; ++q) { const f32x4 t = xr[128 * hf + 2 * lane + q]; v[8 * hf + 4 * q] = t[0]; v[8 * hf + 4 * q + 1] = t[1]; v[8 * hf + 4 * q + 2] = t[2]; v[8 * hf + 4 * q + 3] = t[3]; } }
            else { const GAS v4u* xr = (const GAS v4u*)((const GAS bf16*)xin + m * DM);
#pragma unroll
                for (int hf = 0; hf < 2; ++hf) { const v4u w = xr[64 * hf + lane];
                    v[8 * hf] = bflo(w.x); v[8 * hf + 1] = bfhi(w.x); v[8 * hf + 2] = bflo(w.y); v[8 * hf + 3] = bfhi(w.y); v[8 * hf + 4] = bflo(w.z); v[8 * hf + 5] = bfhi(w.z); v[8 * hf + 6] = bflo(w.w); v[8 * hf + 7] = bfhi(w.w); } }
            finish_row(v, m);
        }
    }
}
__device__ __forceinline__ void final_norm_rows(const GAS bf16* xin, GAS float* xout, const GAS float* gvec, int gw, int NGW, int lane, float oscale) {
    float A[16];
#pragma unroll
    for (int hf = 0; hf < 2; ++hf)
#pragma unroll
        for (int q = 0; q < 2; ++q) { const f32x4 g4 = *(const GAS f32x4*)(gvec + 512 * hf + 8 * lane + 4 * q);
#pragma unroll
            for (int j = 0; j < 4; ++j) A[8 * hf + 4 * q + j] = g4[j]; }
    constexpr int RB = 4;
    auto finish_row = [&](const float (&v)[16], int m) {
        float ss = 0.f;
#pragma unroll
        for (int j = 0; j < 16; ++j) ss += v[j] * v[j];
        const float rr = __builtin_amdgcn_rsqf(wave_sum(ss) * (1.0f / DM) + EPS) * oscale;
        GAS f32x4* xo = (GAS f32x4*)(xout + (size_t)m * DM);
#pragma unroll
        for (int hf = 0; hf < 2; ++hf)
#pragma unroll
            for (int q = 0; q < 2; ++q) { f32x4 o;
#pragma unroll
                for (int j = 0; j < 4; ++j) o[j] = v[8 * hf + 4 * q + j] * rr * A[8 * hf + 4 * q + j];
                xo[128 * hf + 2 * lane + q] = o; } };
    auto load_row = [&](float (&v)[16], int m) { const GAS v4u* xr = (const GAS v4u*)(xin + (size_t)m * DM);
#pragma unroll
        for (int hf = 0; hf < 2; ++hf) { const v4u w = xr[64 * hf + lane];
            v[8 * hf] = bflo(w.x); v[8 * hf + 1] = bfhi(w.x); v[8 * hf + 2] = bflo(w.y); v[8 * hf + 3] = bfhi(w.y); v[8 * hf + 4] = bflo(w.z); v[8 * hf + 5] = bfhi(w.z); v[8 * hf + 6] = bflo(w.w); v[8 * hf + 7] = bfhi(w.w); } };
    int m = gw;
#pragma unroll 1
    for (; m + (RB - 1) * NGW < M_ALL; m += RB * NGW) { float v[RB][16];
#pragma unroll
        for (int k = 0; k < RB; ++k) load_row(v[k], m + k * NGW);
        asm volatile("" ::: "memory");
#pragma unroll
        for (int k = 0; k < RB; ++k) finish_row(v[k], m + k * NGW); }
#pragma unroll 1
    for (; m < M_ALL; m += NGW) { float v[16]; load_row(v, m); finish_row(v, m); }
}
__device__ __forceinline__ void copy_rows(const GAS float* xin, GAS bf16* xout, int gw, int NGW, int lane) {
    for (int m = gw; m < M_ALL; m += NGW) {
        const GAS f32x4* xr = (const GAS f32x4*)(xin + (size_t)m * DM) + lane; GAS v2u* xo = (GAS v2u*)(xout + (size_t)m * DM) + lane;
#pragma unroll
        for (int j = 0; j < 4; ++j) { const f32x4 t = xr[64 * j]; v2u w; w.x = pk2(t[0], t[1]); w.y = pk2(t[2], t[3]); xo[64 * j] = w; }
    }
}

__device__ __forceinline__ void rope_unit(GAS bf16* Z, GAS bf16* KIT, const GAS int* pos, const GAS float* T, int u, int tid) {
    const int blk = u / (MG / NTHREADS), row = (u % (MG / NTHREADS)) * NTHREADS + tid;
    int p = pos[row]; p = p < 0 ? 0 : (p > 16383 ? 16383 : p);
    const GAS f32x4* tp = (const GAS f32x4*)(T + (size_t)p * 16);
    const f32x4 c0 = tp[0], c1 = tp[1], s0 = tp[2], s1 = tp[3];
    const float cs[8] = {c0[0], c0[1], c0[2], c0[3], c1[0], c1[1], c1[2], c1[3]};
    const float sn[8] = {s0[0], s0[1], s0[2], s0[3], s1[0], s1[1], s1[2], s1[3]};
    const int col = (blk < 4) ? ZB_Q + 64 * blk : (blk == 4) ? ZB_K : (blk < 9) ? ZB_QI + 64 * (blk - 5) : ZB_KI;
    GAS v4u* ptr = (GAS v4u*)(Z + (size_t)row * ZLD + col);
    const v4u a = ptr[0], b = ptr[1];
    const unsigned aw[4] = {a.x, a.y, a.z, a.w}, bw[4] = {b.x, b.y, b.z, b.w};
    unsigned oa[4], ob[4];
#pragma unroll
    for (int q = 0; q < 4; ++q) {
        const float x1l = bflo(aw[q]), x1h = bfhi(aw[q]), x2l = bflo(bw[q]), x2h = bfhi(bw[q]);
        const float cl = cs[2 * q], ch = cs[2 * q + 1], sl = sn[2 * q], sh = sn[2 * q + 1];
        oa[q] = pk2(x1l * cl - x2l * sl, x1h * ch - x2h * sh);
        ob[q] = pk2(x1l * sl + x2l * cl, x1h * sh + x2h * ch);
    }
    if (blk == 9) {
        GAS v4u* kt = (GAS v4u*)((GAS unsigned char*)KIT + (size_t)(row >> 5) * 4096 + (row & 31) * 16);
        kt[0] = (v4u){oa[0], oa[1], oa[2], oa[3]}; kt[32] = (v4u){ob[0], ob[1], ob[2], ob[3]};
#pragma unroll
        for (int c = 2; c < 8; ++c) kt[(c >> 1) * 64 + (c & 1) * 32] = ptr[c];
    } else { ptr[0] = (v4u){oa[0], oa[1], oa[2], oa[3]}; ptr[1] = (v4u){ob[0], ob[1], ob[2], ob[3]}; }
}
__device__ __forceinline__ void conv_unit(const GAS bf16* Z, GAS bf16* YA, const GAS float* cw, const GAS float* cb, const GAS float* lng, const GAS float* lnb, LAS unsigned char* lds, int u, int tid, int wave, int lane) {
    LAS float* uL = (LAS float*)lds;
    LAS float* cv = (LAS float*)(lds + 62 * 256 * 4);
    const int b = u >> 8, blk = u & 255, t0 = blk * 32; const size_t growb = (size_t)b * SEQ;
    for (int e = tid; e < 62 * 256; e += NTHREADS) { const int tt = e >> 8, c = e & 255, t = t0 - 30 + tt; float val = 0.f;
        if (t >= 0) { const GAS bf16* zr = Z + (growb + t) * ZLD; val = bf2f(zr[ZA_VAL + c]) * sigm(bf2f(zr[ZA_GATE + c])); }
        uL[e] = val; }
    __syncthreads();
    { const int c = tid & 255, hf = tid >> 8; float w[31];
#pragma unroll
      for (int k = 0; k < 31; ++k) w[k] = cw[k * 256 + c];
      const float bias = cb[c];
#pragma unroll 1
      for (int tt = 0; tt < 16; ++tt) { const int tl = 16 * hf + tt; float acc = bias;
#pragma unroll
          for (int k = 0; k < 31; ++k) acc += uL[(tl + k) * 256 + c] * w[k];
          cv[tl * 256 + c] = acc; } }
    __syncthreads();
#pragma unroll
    for (int q = 0; q < 4; ++q) { const int tl = 4 * wave + q;
        const f32x4 x = *(const LAS f32x4*)(cv + tl * 256 + 4 * lane);
        const float mu = wave_sum((x[0] + x[1]) + (x[2] + x[3])) * (1.0f / 256.0f);
        const f32x4 d = x - mu;
        const float var = wave_sum((d[0] * d[0] + d[1] * d[1]) + (d[2] * d[2] + d[3] * d[3])) * (1.0f / 256.0f);
        const float rs = __builtin_amdgcn_rsqf(var + EPS);
        const f32x4 g4 = *(const GAS f32x4*)(lng + 4 * lane), b4 = *(const GAS f32x4*)(lnb + 4 * lane);
        f32x4 y = d * rs * g4 + b4;
        v2u o; o.x = pk2(siluf(y[0]), siluf(y[1])); o.y = pk2(siluf(y[2]), siluf(y[3]));
        *(GAS v2u*)(YA + (growb + t0 + tl) * 256 + 4 * lane) = o; }
    __syncthreads();
}

__device__ __forceinline__ void conv2_unit(const GAS bf16* Z, GAS bf16* YA, const GAS float* cw, const GAS float* cb, const GAS float* lng, const GAS float* lnb, LAS unsigned char* lds, int u, int wave) {
    unsigned ones_u = ~0u; asm volatile("" : "+s"(ones_u));
    const int lane = (int)__builtin_amdgcn_mbcnt_hi(ones_u, __builtin_amdgcn_mbcnt_lo(ones_u, 0u));
    const int tid = wave * 64 + lane;
    LAS bf16* uH = (LAS bf16*)lds;
    LAS unsigned* uW = (LAS unsigned*)lds;
    LAS float* cv = (LAS float*)(lds + 47 * 256 * 4);
    const int b = u >> 7, blk = u & 127, t0 = blk * 64; const size_t growb = (size_t)b * SEQ;
    for (int e = tid; e < 94 * 32; e += NTHREADS) { const int tt = e >> 5, ch = e & 31, t = t0 - 30 + tt;
        v4u vw = {0u, 0u, 0u, 0u}, gw = {0u, 0u, 0u, 0u};
        if (t >= 0) { const GAS bf16* zr = Z + (growb + t) * ZLD; vw = *(const GAS v4u*)(zr + ZA_VAL + 8 * ch); gw = *(const GAS v4u*)(zr + ZA_GATE + 8 * ch); }
        const unsigned va[4] = {vw.x, vw.y, vw.z, vw.w}, ga[4] = {gw.x, gw.y, gw.z, gw.w};
        LAS bf16* dst = uH + ((tt >> 1) * 256 + 8 * ch) * 2 + (tt & 1);
#pragma unroll
        for (int j = 0; j < 8; ++j) { const float v = (j & 1) ? bfhi(va[j >> 1]) : bflo(va[j >> 1]), g = (j & 1) ? bfhi(ga[j >> 1]) : bflo(ga[j >> 1]);
            dst[2 * j] = (bf16)f2bf((t >= 0) ? v * sigm(g) : 0.f); } }
    __syncthreads();
    { const int c = tid & 255, hf = tid >> 8; float w[31];
#pragma unroll
      for (int k = 0; k < 31; ++k) w[k] = cw[k * 256 + c];
      const float bias = cb[c];
#pragma unroll 1
      for (int gq = 0; gq < 4; ++gq) { const int o0 = 32 * hf + 8 * gq;
          float acc[8];
#pragma unroll
          for (int o = 0; o < 8; ++o) acc[o] = bias;
#pragma unroll
          for (int kp = 0; kp < 19; ++kp) { const unsigned xw = uW[((o0 >> 1) + kp) * 256 + c];
              const float x0 = bflo(xw), x1 = bfhi(xw);
#pragma unroll
              for (int o = 0; o < 8; ++o) { const int k0 = 2 * kp - o, k1 = 2 * kp + 1 - o;
                  if (k0 >= 0 && k0 <= 30) acc[o] += x0 * w[k0];
                  if (k1 >= 0 && k1 <= 30) acc[o] += x1 * w[k1]; } }
#pragma unroll
          for (int o = 0; o < 8; ++o) cv[(o0 + o) * 256 + c] = acc[o]; } }
    __syncthreads();
#pragma unroll 2
    for (int q = 0; q < 8; ++q) { const int tl = 8 * wave + q;
        const f32x4 x = *(const LAS f32x4*)(cv + tl * 256 + 4 * lane);
        const float mu = wave_sum((x[0] + x[1]) + (x[2] + x[3])) * (1.0f / 256.0f);
        const f32x4 d = x - mu;
        const float var = wave_sum((d[0] * d[0] + d[1] * d[1]) + (d[2] * d[2] + d[3] * d[3])) * (1.0f / 256.0f);
        const float rs = __builtin_amdgcn_rsqf(var + EPS);
        const f32x4 g4 = *(const GAS f32x4*)(lng + 4 * lane), b4 = *(const GAS f32x4*)(lnb + 4 * lane);
        f32x4 y = d * rs * g4 + b4;
        v2u o; o.x = pk2(siluf(y[0]), siluf(y[1])); o.y = pk2(siluf(y[2]), siluf(y[3]));
        *(GAS v2u*)(YA + (growb + t0 + tl) * 256 + 4 * lane) = o; }
    __syncthreads();
}

struct LinPar { const GAS bf16* Z; const GAS float* gate_w; const GAS float* gate_b; const GAS float* lb_logits; int layer; };
constexpr int L_LF = 0, L_Q = 16384, L_K = 32768, L_V = 49152, L_QT = 65536, L_KT = 82944, L_QH = 100352, L_AT = 117760, L_S = 135168;
constexpr int TS = 68;
template <int DK>
__device__ __forceinline__ void lin_load(const LinPar& P, LAS unsigned char* lds, int b, int c, int h, int tid) {
    LAS float* gL = (LAS float*)(lds + L_LF); LAS float* qL = (LAS float*)(lds + L_Q); LAS float* kL = (LAS float*)(lds + L_K); LAS float* vL = (LAS float*)(lds + L_V);
    const int t = tid >> 3, part = tid & 7;
    const GAS bf16* zr = P.Z + ((size_t)b * SEQ + c * 64 + t) * ZLD;
    if (DK == 32) {
        const v2u qw = *(const GAS v2u*)(zr + ZC_Q + h * 32 + 4 * part), kw = *(const GAS v2u*)(zr + ZC_K + h * 32 + 4 * part);
        const float qs = 0.17677669529663687f;
        const float qv[4] = {bflo(qw.x) * qs, bfhi(qw.x) * qs, bflo(qw.y) * qs, bfhi(qw.y) * qs};
        const float kv[4] = {bflo(kw.x), bfhi(kw.x), bflo(kw.y), bfhi(kw.y)};
        const v4u g0 = *(const GAS v4u*)(zr + ZC_GLR), g1 = *(const GAS v4u*)(zr + ZC_GLR + 8);
        const unsigned gw[8] = {g0.x, g0.y, g0.z, g0.w, g1.x, g1.y, g1.z, g1.w};
        float a[4];
#pragma unroll
        for (int j = 0; j < 4; ++j) a[j] = P.gate_b[h * 32 + 4 * part + j];
#pragma unroll
        for (int r2 = 0; r2 < 8; ++r2) { const float x0 = bflo(gw[r2]), x1 = bfhi(gw[r2]);
            const f32x4 w0 = *(const GAS f32x4*)(P.gate_w + (2 * r2) * 128 + h * 32 + 4 * part), w1 = *(const GAS f32x4*)(P.gate_w + (2 * r2 + 1) * 128 + h * 32 + 4 * part);
#pragma unroll
            for (int j = 0; j < 4; ++j) a[j] += x0 * w0[j] + x1 * w1[j]; }
#pragma unroll
        for (int j = 0; j < 4; ++j) { const int d = 4 * part + j; gL[t * DK + d] = logsigm(a[j]) * (1.0f / 16.0f); qL[t * DK + d] = qv[j]; kL[t * DK + d] = kv[j]; }
        const v4u vw = *(const GAS v4u*)(zr + ZC_V + h * 64 + 8 * part);
        const unsigned vv[4] = {vw.x, vw.y, vw.z, vw.w};
#pragma unroll
        for (int j = 0; j < 4; ++j) { vL[t * 64 + 8 * part + 2 * j] = bflo(vv[j]); vL[t * 64 + 8 * part + 2 * j + 1] = bfhi(vv[j]); }
    } else {
        const v4u fw = *(const GAS v4u*)(zr + ZD_F + h * 64 + 8 * part), qw = *(const GAS v4u*)(zr + ZD_Q + h * 64 + 8 * part), iw = *(const GAS v4u*)(zr + ZD_I + h * 64 + 8 * part);
        const unsigned fa[4] = {fw.x, fw.y, fw.z, fw.w}, qa[4] = {qw.x, qw.y, qw.z, qw.w}, ia[4] = {iw.x, iw.y, iw.z, iw.w};
#pragma unroll
        for (int j = 0; j < 8; ++j) { const int d = 8 * part + j;
            const float zf = (j & 1) ? bfhi(fa[j >> 1]) : bflo(fa[j >> 1]), zq = (j & 1) ? bfhi(qa[j >> 1]) : bflo(qa[j >> 1]), zi = (j & 1) ? bfhi(ia[j >> 1]) : bflo(ia[j >> 1]);
            float lbv = 0.f;
            if (P.layer == 1) lbv = sigm(P.lb_logits[256 + h * 64 + d] - P.lb_logits[h * 64 + d]);
            const float sg = sigm(zf);
            const float f = lbv + (1.0f - lbv) * sg;
            gL[t * DK + d] = (P.layer == 0) ? logsigm(zf) : __logf(f);
            kL[t * DK + d] = (1.0f - lbv) * sigm(-zf);
            qL[t * DK + d] = siluf(zq);
            vL[t * 64 + d] = zi; }
    }
    __syncthreads();
    if (tid < DK) { float run = 0.f;
#pragma unroll 4
        for (int tt = 0; tt < 64; ++tt) { run += gL[tt * DK + tid]; gL[tt * DK + tid] = run; } }
    __syncthreads();
}
template <int DK>
__device__ __forceinline__ void lin_local_unit(const LinPar& P, GAS float* ST, GAS float* DEC, LAS unsigned char* lds, int u, int tid) {
    const int b = u / (NCH * 4), c = (u / 4) % NCH, h = u & 3;
    lin_load<DK>(P, lds, b, c, h, tid);
    LAS float* gL = (LAS float*)(lds + L_LF); LAS float* kL = (LAS float*)(lds + L_K); LAS float* vL = (LAS float*)(lds + L_V);
    for (int e = tid; e < 64 * DK; e += NTHREADS) { const int d = e % DK; kL[e] = kL[e] * __expf(gL[63 * DK + d] - gL[e]); }
    __syncthreads();
    constexpr int VPT = DK / 8, NVO = 64 / VPT;
    const int d = tid / NVO, vo = tid % NVO;
    float acc[VPT];
#pragma unroll
    for (int j = 0; j < VPT; ++j) acc[j] = 0.f;
#pragma unroll 4
    for (int t = 0; t < 64; ++t) { const float kk = kL[t * DK + d];
#pragma unroll
        for (int j = 0; j < VPT; ++j) acc[j] += kk * vL[t * 64 + vo * VPT + j]; }
    GAS float* so = ST + ((size_t)(b * NCH + c) * 4 + h) * DK * 64 + d * 64 + vo * VPT;
#pragma unroll
    for (int j = 0; j < VPT; ++j) so[j] = acc[j];
    if (tid < DK) DEC[(size_t)(b * NCH + c) * 4 * DK + h * DK + tid] = __expf(gL[63 * DK + tid]);
    __syncthreads();
}
__device__ __forceinline__ void scan_unit(GAS bf16* STC, GAS bf16* STD, const GAS float* DECC, const GAS float* DECD, int u, int tid) {
    if (tid >= 192) return;
    const int e = u * 192 + tid;
    GAS unsigned* sp; const GAS float* dp; size_t sstride, dstride;
    if (e < GB * 4096) { const int b = e / 4096, rem = e % 4096; sp = (GAS unsigned*)STC + (size_t)b * NCH * 4096 + rem; sstride = 4096; dp = DECC + (size_t)b * NCH * 128 + rem / 32; dstride = 128; }
    else { const int e2 = e - GB * 4096; const int b = e2 / 8192, rem = e2 % 8192; sp = (GAS unsigned*)STD + (size_t)b * NCH * 8192 + rem; sstride = 8192; dp = DECD + (size_t)b * NCH * 256 + rem / 32; dstride = 256; }
    float s0 = 0.f, s1 = 0.f;
#pragma unroll 1
    for (int c0 = 0; c0 < NCH; c0 += 16) {
        unsigned uu[16]; float dd[16];
#pragma unroll
        for (int i = 0; i < 16; ++i) { uu[i] = sp[(size_t)(c0 + i) * sstride]; dd[i] = dp[(size_t)(c0 + i) * dstride]; }
#pragma unroll
        for (int i = 0; i < 16; ++i) { sp[(size_t)(c0 + i) * sstride] = pk2(s0, s1); s0 = dd[i] * s0 + bflo(uu[i]); s1 = dd[i] * s1 + bfhi(uu[i]); }
    }
}
template <int DK>
__device__ __forceinline__ void lin_out_unit(const LinPar& P, const GAS float* ST, const GAS float* normg, GAS bf16* YS, LAS unsigned char* lds, int u, int tid) {
    const int b = u / (NCH * 4), c = (u / 4) % NCH, h = u & 3;
    lin_load<DK>(P, lds, b, c, h, tid);
    LAS float* gL = (LAS float*)(lds + L_LF); LAS float* qL = (LAS float*)(lds + L_Q); LAS float* kL = (LAS float*)(lds + L_K); LAS float* vL = (LAS float*)(lds + L_V);
    LAS float* qT = (LAS float*)(lds + L_QT); LAS float* kT = (LAS float*)(lds + L_KT); LAS float* qH = (LAS float*)(lds + L_QH); LAS float* aT = (LAS float*)(lds + L_AT); LAS float* sM = (LAS float*)(lds + L_S);
    for (int e = tid; e < 64 * DK; e += NTHREADS) { const int t = e / DK, d = e % DK;
        const float g = gL[e], r = gL[31 * DK + d], q = qL[e], k = kL[e];
        qT[d * TS + t] = q * __expf(fminf(g - r, 80.f)); kT[d * TS + t] = k * __expf(fminf(r - g, 80.f)); qH[d * TS + t] = q * __expf(g); }
    { const GAS float* sp = ST + ((size_t)(b * NCH + c) * 4 + h) * DK * 64;
      for (int e = tid; e < DK * 64; e += NTHREADS) sM[e] = sp[e]; }
    __syncthreads();
    const int i = tid >> 3, jo = tid & 7;
    { float a[8];
#pragma unroll
      for (int j = 0; j < 8; ++j) a[j] = 0.f;
#pragma unroll 4
      for (int d = 0; d < DK; ++d) { const float qv = qT[d * TS + i];
          const f32x4 k0 = *(const LAS f32x4*)(kT + d * TS + 8 * jo), k1 = *(const LAS f32x4*)(kT + d * TS + 8 * jo + 4);
          a[0] += qv * k0[0]; a[1] += qv * k0[1]; a[2] += qv * k0[2]; a[3] += qv * k0[3]; a[4] += qv * k1[0]; a[5] += qv * k1[1]; a[6] += qv * k1[2]; a[7] += qv * k1[3]; }
#pragma unroll
      for (int j = 0; j < 8; ++j) { const int jj = 8 * jo + j; aT[jj * TS + i] = (jj <= i) ? a[j] : 0.f; } }
    __syncthreads();
    { float o[8];
#pragma unroll
      for (int j = 0; j < 8; ++j) o[j] = 0.f;
#pragma unroll 4
      for (int j = 0; j < 64; ++j) { const float av = aT[j * TS + i];
          const f32x4 v0 = *(const LAS f32x4*)(vL + j * 64 + 8 * jo), v1 = *(const LAS f32x4*)(vL + j * 64 + 8 * jo + 4);
          o[0] += av * v0[0]; o[1] += av * v0[1]; o[2] += av * v0[2]; o[3] += av * v0[3]; o[4] += av * v1[0]; o[5] += av * v1[1]; o[6] += av * v1[2]; o[7] += av * v1[3]; }
#pragma unroll 4
      for (int d = 0; d < DK; ++d) { const float qv = qH[d * TS + i];
          const f32x4 s0 = *(const LAS f32x4*)(sM + d * 64 + 8 * jo), s1 = *(const LAS f32x4*)(sM + d * 64 + 8 * jo + 4);
          o[0] += qv * s0[0]; o[1] += qv * s0[1]; o[2] += qv * s0[2]; o[3] += qv * s0[3]; o[4] += qv * s1[0]; o[5] += qv * s1[1]; o[6] += qv * s1[2]; o[7] += qv * s1[3]; }
      float ss = 0.f;
#pragma unroll
      for (int j = 0; j < 8; ++j) ss += o[j] * o[j];
      ss += swz_xor<1>(ss); ss += swz_xor<2>(ss); ss += swz_xor<4>(ss);
      const float rs = __builtin_amdgcn_rsqf(ss * (1.0f / 64.0f) + EPS);
      const size_t grow = (size_t)b * SEQ + c * 64 + i;
      const v4u ogw = *(const GAS v4u*)(P.Z + grow * ZLD + (DK == 32 ? ZC_OG : ZD_OG) + h * 64 + 8 * jo);
      const unsigned oga[4] = {ogw.x, ogw.y, ogw.z, ogw.w};
      const f32x4 n0 = *(const GAS f32x4*)(normg + 8 * jo), n1 = *(const GAS f32x4*)(normg + 8 * jo + 4);
      const float ng[8] = {n0[0], n0[1], n0[2], n0[3], n1[0], n1[1], n1[2], n1[3]};
      float y[8];
#pragma unroll
      for (int j = 0; j < 8; ++j) { const float og = (j & 1) ? bfhi(oga[j >> 1]) : bflo(oga[j >> 1]); y[j] = o[j] * rs * ng[j] * siluf(og); }
      v4u w; w.x = pk2(y[0], y[1]); w.y = pk2(y[2], y[3]); w.z = pk2(y[4], y[5]); w.w = pk2(y[6], y[7]);
      *(GAS v4u*)(YS + grow * 256 + h * 64 + 8 * jo) = w; }
    __syncthreads();
}

constexpr int L2_RS = 72;
constexpr int L2_QT = 0, L2_KT = 9216, L2_QH = 18432, L2_VT = 27648, L2_ST = 36864, L2_KH = 46080, L2_HEAD = 55296;
template <int CTRL, int RM> __device__ __forceinline__ float dpp_add(float v) { return v + __builtin_bit_cast(float, __builtin_amdgcn_update_dpp(0, __builtin_bit_cast(int, v), CTRL, RM, 0xF, false)); }
__device__ __forceinline__ float wave_incl_scan(float x) {
    x = dpp_add<0x111, 0xF>(x); x = dpp_add<0x112, 0xF>(x); x = dpp_add<0x114, 0xF>(x); x = dpp_add<0x118, 0xF>(x);
    x = dpp_add<0x142, 0xA>(x); x = dpp_add<0x143, 0xC>(x);
    return x;
}
__device__ __forceinline__ float lane_bcast(float v, int l) { return __builtin_bit_cast(float, __builtin_amdgcn_readlane(__builtin_bit_cast(int, v), l)); }
template <int CTRL, int RM> __device__ __forceinline__ unsigned dpp_umax(unsigned v) { return max(v, (unsigned)__builtin_amdgcn_update_dpp(0, (int)v, CTRL, RM, 0xF, false)); }
template <int CTRL, int RM> __device__ __forceinline__ unsigned dpp_umin(unsigned v) { return min(v, (unsigned)__builtin_amdgcn_update_dpp(-1, (int)v, CTRL, RM, 0xF, false)); }
__device__ __forceinline__ unsigned wave_umax(unsigned x) { x = dpp_umax<0x111, 0xF>(x); x = dpp_umax<0x112, 0xF>(x); x = dpp_umax<0x114, 0xF>(x); x = dpp_umax<0x118, 0xF>(x);
    x = dpp_umax<0x142, 0xA>(x); x = dpp_umax<0x143, 0xC>(x); return (unsigned)__builtin_amdgcn_readlane((int)x, 63); }
__device__ __forceinline__ unsigned wave_umin(unsigned x) { x = dpp_umin<0x111, 0xF>(x); x = dpp_umin<0x112, 0xF>(x); x = dpp_umin<0x114, 0xF>(x); x = dpp_umin<0x118, 0xF>(x);
    x = dpp_umin<0x142, 0xA>(x); x = dpp_umin<0x143, 0xC>(x); return (unsigned)__builtin_amdgcn_readlane((int)x, 63); }
template <int DK, int PHASE>
__device__ __forceinline__ void lin2_unit(const LinPar& P, GAS bf16* ST, GAS float* DEC, const GAS float* normg, GAS bf16* YS, LAS unsigned char* lds, int u, int wave) {
    unsigned ones_u = ~0u; asm volatile("" : "+s"(ones_u));
    const int lane = (int)__builtin_amdgcn_mbcnt_hi(ones_u, __builtin_amdgcn_mbcnt_lo(ones_u, 0u));
    const int hg = wave >> 2, wl = wave & 3;
    const int b = u / (NCH * 2), c = (u >> 1) % NCH, h = 2 * (u & 1) + hg;
    LAS unsigned char* hb = lds + hg * L2_HEAD;
    LAS bf16* QT = (LAS bf16*)(hb + L2_QT); LAS bf16* KT = (LAS bf16*)(hb + L2_KT); LAS bf16* QH = (LAS bf16*)(hb + L2_QH);
    LAS bf16* VT = (LAS bf16*)(hb + L2_VT); LAS bf16* SS = (LAS bf16*)(hb + L2_ST); LAS bf16* KH = (LAS bf16*)(hb + L2_KH);
    constexpr int ND = DK / 4;
    const int d0 = wl * ND;
    const size_t crow = (size_t)b * SEQ + c * 64;
    const GAS bf16* zr = P.Z + (crow + lane) * ZLD;
    float lf[ND], qv[ND], kv[ND], vv[16];
    if constexpr (DK == 32) {
        const v4u qw = *(const GAS v4u*)(zr + ZC_Q + h * 32 + d0), kw = *(const GAS v4u*)(zr + ZC_K + h * 32 + d0);
        const unsigned qa[4] = {qw.x, qw.y, qw.z, qw.w}, ka[4] = {kw.x, kw.y, kw.z, kw.w};
        const v4u g0 = *(const GAS v4u*)(zr + ZC_GLR), g1 = *(const GAS v4u*)(zr + ZC_GLR + 8);
        const unsigned gw[8] = {g0.x, g0.y, g0.z, g0.w, g1.x, g1.y, g1.z, g1.w};
        float a[ND];
#pragma unroll
        for (int j = 0; j < ND; ++j) a[j] = P.gate_b[h * 32 + d0 + j];
#pragma unroll
        for (int r2 = 0; r2 < 8; ++r2) { const float x0 = bflo(gw[r2]), x1 = bfhi(gw[r2]);
#pragma unroll
            for (int j = 0; j < ND; ++j) a[j] += x0 * P.gate_w[(2 * r2) * 128 + h * 32 + d0 + j] + x1 * P.gate_w[(2 * r2 + 1) * 128 + h * 32 + d0 + j]; }
#pragma unroll
        for (int j = 0; j < ND; ++j) { lf[j] = logsigm(a[j]) * (1.0f / 16.0f);
            qv[j] = ((j & 1) ? bfhi(qa[j >> 1]) : bflo(qa[j >> 1])) * 0.17677669529663687f; kv[j] = (j & 1) ? bfhi(ka[j >> 1]) : bflo(ka[j >> 1]); }
        const v4u v0 = *(const GAS v4u*)(zr + ZC_V + h * 64 + 16 * wl), v1 = *(const GAS v4u*)(zr + ZC_V + h * 64 + 16 * wl + 8);
        const unsigned va[8] = {v0.x, v0.y, v0.z, v0.w, v1.x, v1.y, v1.z, v1.w};
#pragma unroll
        for (int j = 0; j < 16; ++j) vv[j] = (j & 1) ? bfhi(va[j >> 1]) : bflo(va[j >> 1]);
    } else {
        const v4u f0 = *(const GAS v4u*)(zr + ZD_F + h * 64 + d0), f1 = *(const GAS v4u*)(zr + ZD_F + h * 64 + d0 + 8);
        const v4u q0 = *(const GAS v4u*)(zr + ZD_Q + h * 64 + d0), q1 = *(const GAS v4u*)(zr + ZD_Q + h * 64 + d0 + 8);
        const v4u i0 = *(const GAS v4u*)(zr + ZD_I + h * 64 + d0), i1 = *(const GAS v4u*)(zr + ZD_I + h * 64 + d0 + 8);
        const unsigned fa[8] = {f0.x, f0.y, f0.z, f0.w, f1.x, f1.y, f1.z, f1.w}, qa[8] = {q0.x, q0.y, q0.z, q0.w, q1.x, q1.y, q1.z, q1.w}, ia[8] = {i0.x, i0.y, i0.z, i0.w, i1.x, i1.y, i1.z, i1.w};
        if (P.layer == 0) {
#pragma unroll
            for (int j = 0; j < 16; ++j) {
                const float zf = (j & 1) ? bfhi(fa[j >> 1]) : bflo(fa[j >> 1]), zq = (j & 1) ? bfhi(qa[j >> 1]) : bflo(qa[j >> 1]);
                const float t = __expf(-fabsf(zf)), r = __builtin_amdgcn_rcpf(1.0f + t), tr = t * r;
                lf[j % ND] = fminf(zf, 0.f) - __logf(1.0f + t);
                kv[j % ND] = (zf >= 0.f) ? tr : r;
                qv[j % ND] = siluf(zq);
                vv[j] = (j & 1) ? bfhi(ia[j >> 1]) : bflo(ia[j >> 1]); }
        } else {
#pragma unroll
            for (int j = 0; j < 16; ++j) {
                const float zf = (j & 1) ? bfhi(fa[j >> 1]) : bflo(fa[j >> 1]), zq = (j & 1) ? bfhi(qa[j >> 1]) : bflo(qa[j >> 1]);
                const float lbv = sigm(P.lb_logits[256 + h * 64 + d0 + j] - P.lb_logits[h * 64 + d0 + j]);
                const float t = __expf(-fabsf(zf)), r = __builtin_amdgcn_rcpf(1.0f + t), tr = t * r;
                const float sp = (zf >= 0.f) ? r : tr, sn = (zf >= 0.f) ? tr : r;
                lf[j % ND] = __logf(lbv + (1.0f - lbv) * sp);
                kv[j % ND] = (1.0f - lbv) * sn;
                qv[j % ND] = siluf(zq);
                vv[j] = (j & 1) ? bfhi(ia[j >> 1]) : bflo(ia[j >> 1]); }
        }
    }
    const int fr = lane & 15, fg = lane >> 4;
    unsigned sreg[PHASE == 1 ? DK / 4 : 1]; unsigned ogr[PHASE == 1 ? 16 : 1];
    if constexpr (PHASE == 1) {
        const GAS bf16* sp = ST + ((size_t)(b * NCH + c) * 4 + h) * DK * 64;
#pragma unroll
        for (int i = 0; i < DK / 4; ++i) sreg[i] = sp[wl * 64 + lane + 256 * i];
#pragma unroll
        for (int tv = 0; tv < 4; ++tv)
#pragma unroll
            for (int r = 0; r < 4; ++r) ogr[tv * 4 + r] = P.Z[(crow + 16 * wl + 4 * fg + r) * ZLD + (DK == 32 ? ZC_OG : ZD_OG) + h * 64 + 16 * tv + fr];
    }
    float g[ND], gl[ND];
#pragma unroll
    for (int j = 0; j < ND; ++j) { g[j] = wave_incl_scan(lf[j]); gl[j] = lane_bcast(g[j], 63); }
#pragma unroll
    for (int j = 0; j < 16; ++j) VT[(16 * wl + j) * L2_RS + lane] = (bf16)f2bf(vv[j]);
    if (PHASE == 0) {
#pragma unroll
        for (int j = 0; j < ND; ++j) KH[(d0 + j) * L2_RS + lane] = (bf16)f2bf(kv[j] * __expf(gl[j] - g[j]));
        if (lane == 63) {
#pragma unroll
            for (int j = 0; j < ND; ++j) DEC[(size_t)(b * NCH + c) * 4 * DK + h * DK + d0 + j] = __expf(gl[j]);
        }
        __syncthreads();
        GAS bf16* so = ST + ((size_t)(b * NCH + c) * 4 + h) * DK * 64;
#pragma unroll
        for (int td = 0; td < DK / 16; ++td) { f32x4 acc = {0.f, 0.f, 0.f, 0.f};
#pragma unroll
            for (int ks = 0; ks < 2; ++ks) { const bf16x8 af = *(const LAS bf16x8*)(KH + (16 * td + fr) * L2_RS + 32 * ks + 8 * fg), bfv = *(const LAS bf16x8*)(VT + (16 * wl + fr) * L2_RS + 32 * ks + 8 * fg);
                acc = __builtin_amdgcn_mfma_f32_16x16x32_bf16(af, bfv, acc, 0, 0, 0); }
#pragma unroll
            for (int r = 0; r < 4; ++r) so[(16 * td + 4 * fg + r) * 64 + 16 * wl + fr] = (bf16)f2bf(acc[r]); }
        __syncthreads();
    } else {
        {
            unsigned qtw[ND / 2], ktw[ND / 2], qhw[ND / 2];
#pragma unroll
            for (int j = 0; j < ND; j += 2) { const float r0 = lane_bcast(g[j], 31), r1 = lane_bcast(g[j + 1], 31);
                qtw[j >> 1] = pk2(qv[j] * __expf(fminf(g[j] - r0, 80.f)), qv[j + 1] * __expf(fminf(g[j + 1] - r1, 80.f)));
                ktw[j >> 1] = pk2(kv[j] * __expf(fminf(r0 - g[j], 80.f)), kv[j + 1] * __expf(fminf(r1 - g[j + 1], 80.f)));
                qhw[j >> 1] = pk2(qv[j] * __expf(g[j]), qv[j + 1] * __expf(g[j + 1])); }
#pragma unroll
            for (int q4 = 0; q4 < ND / 8; ++q4) {
                *(LAS v4u*)(QT + lane * L2_RS + d0 + 8 * q4) = (v4u){qtw[4 * q4], qtw[4 * q4 + 1], qtw[4 * q4 + 2], qtw[4 * q4 + 3]};
                *(LAS v4u*)(KT + lane * L2_RS + d0 + 8 * q4) = (v4u){ktw[4 * q4], ktw[4 * q4 + 1], ktw[4 * q4 + 2], ktw[4 * q4 + 3]};
                *(LAS v4u*)(QH + lane * L2_RS + d0 + 8 * q4) = (v4u){qhw[4 * q4], qhw[4 * q4 + 1], qhw[4 * q4 + 2], qhw[4 * q4 + 3]}; }
        }
        {
#pragma unroll
            for (int i = 0; i < DK / 4; ++i) { const int idx = wl * 64 + lane + 256 * i; SS[(idx & 63) * L2_RS + (idx >> 6)] = (bf16)sreg[i]; }
        }
        __syncthreads();
        const int ti = wl;
        bf16x8 qf[DK / 32];
#pragma unroll
        for (int ks = 0; ks < DK / 32; ++ks) qf[ks] = *(const LAS bf16x8*)(QT + (16 * ti + fr) * L2_RS + 32 * ks + 8 * fg);
        bf16x8 pa[2];
#pragma unroll
        for (int tj = 0; tj < 4; ++tj) { f32x4 at = {0.f, 0.f, 0.f, 0.f};
            if (tj <= ti) {
#pragma unroll
                for (int ks = 0; ks < DK / 32; ++ks) { const bf16x8 kf = *(const LAS bf16x8*)(KT + (16 * tj + fr) * L2_RS + 32 * ks + 8 * fg);
                    at = __builtin_amdgcn_mfma_f32_16x16x32_bf16(kf, qf[ks], at, 0, 0, 0); } }
#pragma unroll
            for (int r = 0; r < 4; ++r) { const float v = (tj <= ti && (16 * tj + 4 * fg + r) <= (16 * ti + fr)) ? at[r] : 0.f; pa[tj >> 1][(tj & 1) * 4 + r] = (short)f2bf(v); } }
        f32x4 oacc[4];
#pragma unroll
        for (int tv = 0; tv < 4; ++tv) { f32x4 acc = {0.f, 0.f, 0.f, 0.f};
#pragma unroll
            for (int k2 = 0; k2 < 2; ++k2) { const v2u lo = *(const LAS v2u*)(VT + (16 * tv + fr) * L2_RS + 32 * k2 + 4 * fg), hi = *(const LAS v2u*)(VT + (16 * tv + fr) * L2_RS + 32 * k2 + 16 + 4 * fg);
                const v4u vb4 = (v4u){lo.x, lo.y, hi.x, hi.y};
                acc = __builtin_amdgcn_mfma_f32_16x16x32_bf16(pa[k2], __builtin_bit_cast(bf16x8, vb4), acc, 0, 0, 0); }
#pragma unroll
            for (int ks = 0; ks < DK / 32; ++ks) { const bf16x8 qh = *(const LAS bf16x8*)(QH + (16 * ti + fr) * L2_RS + 32 * ks + 8 * fg), sf = *(const LAS bf16x8*)(SS + (16 * tv + fr) * L2_RS + 32 * ks + 8 * fg);
                acc = __builtin_amdgcn_mfma_f32_16x16x32_bf16(qh, sf, acc, 0, 0, 0); }
            oacc[tv] = acc; }
        float rs[4];
#pragma unroll
        for (int r = 0; r < 4; ++r) { float ss = (oacc[0][r] * oacc[0][r] + oacc[1][r] * oacc[1][r]) + (oacc[2][r] * oacc[2][r] + oacc[3][r] * oacc[3][r]);
            ss += swz_xor<1>(ss); ss += swz_xor<2>(ss); ss += swz_xor<4>(ss); ss += swz_xor<8>(ss);
            rs[r] = __builtin_amdgcn_rsqf(ss * (1.0f / 64.0f) + EPS); }
#pragma unroll
        for (int tv = 0; tv < 4; ++tv) { const float ng = normg[16 * tv + fr];
#pragma unroll
            for (int r = 0; r < 4; ++r) { const size_t row = crow + 16 * ti + 4 * fg + r;
                const float og = bf2f(ogr[tv * 4 + r]);
                YS[row * 256 + h * 64 + 16 * tv + fr] = (bf16)f2bf(oacc[tv][r] * rs[r] * ng * siluf(og)); } }
        __syncthreads();
    }
}

constexpr int TK_CAP = 576, TK_TRIG = TK_CAP - 32, TK_K = 256, TK_SLACK = 32;
constexpr int TKW_BUF = 0, TKW_CT = 8 * TK_CAP * 4, TKW_TRASH = TKW_CT + 64, TKW_BYTES = TKW_TRASH + 256;
static_assert(TKW_BYTES * 8 <= MISC_OFF, "top-k LDS");
__device__ __forceinline__ unsigned tk_compact(LAS unsigned* bufq, LAS unsigned* trash, int n, unsigned lo_in, int slack, int lane, int& nkeep) {
    constexpr int NR = TK_CAP / 64; unsigned e[NR];
#pragma unroll
    for (int r = 0; r < NR; ++r) { const int idx = lane + 64 * r; const unsigned raw = bufq[idx]; e[r] = (idx < n) ? raw : 0u; }
    unsigned lmx = max(max(max(e[0], e[1]), max(e[2], e[3])), max(max(e[4], e[5]), max(e[6], e[7])));
    unsigned lmn = min(min(min(e[0] - 1u, e[1] - 1u), min(e[2] - 1u, e[3] - 1u)), min(min(e[4] - 1u, e[5] - 1u), min(e[6] - 1u, e[7] - 1u)));
#pragma unroll
    for (int r = 8; r < NR; ++r) { lmx = max(lmx, e[r]); lmn = min(lmn, e[r] - 1u); }
    const bool has = lmx != 0u;
    unsigned lo = lo_in + 1u, hi = wave_umax(lmx) + 1u;
    int clo = n;
    auto count_ge = [&](unsigned mid) { int c = 0;
#pragma unroll
        for (int r4 = 0; r4 < 8; r4 += 4) {
            unsigned long long m0 = __builtin_amdgcn_uicmp(e[r4], mid, 35  ), m1 = __builtin_amdgcn_uicmp(e[r4 + 1], mid, 35), m2 = __builtin_amdgcn_uicmp(e[r4 + 2], mid, 35), m3 = __builtin_amdgcn_uicmp(e[r4 + 3], mid, 35);
            asm volatile("" : "+s"(m0), "+s"(m1), "+s"(m2), "+s"(m3));
            c += __popcll(m0) + __popcll(m1) + __popcll(m2) + __popcll(m3); }
#pragma unroll
        for (int r = 8; r < NR; ++r) c += __popcll(__builtin_amdgcn_uicmp(e[r], mid, 35));
        return c; };
    { const unsigned p0 = wave_umax(has ? lmn + 1u : 0u), p1 = wave_umin(has ? lmx : 0xFFFFFFFFu);
#pragma unroll
      for (int k = 0; k < 2; ++k) { const unsigned mid = k ? p1 : p0;
          if (mid > lo && mid < hi && clo > TK_K + slack) { const int c = count_ge(mid); if (c >= TK_K) { lo = mid; clo = c; } else hi = mid; } } }
#pragma unroll 1
    while (hi - lo > 1u && clo > TK_K + slack) {
        const unsigned mid = lo + ((hi - lo) >> 1); const int c = count_ge(mid);
        if (c >= TK_K) { lo = mid; clo = c; } else hi = mid;
    }
    LDS_WAIT();
    int base = 0;
#pragma unroll
    for (int r = 0; r < NR; ++r) { const bool keep = e[r] >= lo; const unsigned long long m = __ballot(keep);
        const unsigned pre = __builtin_amdgcn_mbcnt_hi((unsigned)(m >> 32), __builtin_amdgcn_mbcnt_lo((unsigned)m, 0u));
        LAS unsigned* dst = keep ? bufq + base + pre : trash + lane;
        *dst = e[r];
        base += __popcll(m); }
    LDS_WAIT();
    nkeep = base;
    return lo - 1u;
}
__device__ __forceinline__ void tk_compact_all(LAS unsigned* buf, LAS unsigned* ct, int limit, int slack, int lane) {
#pragma unroll 1
    for (int ql = 0; ql < 8; ++ql) { const int n = __builtin_amdgcn_readfirstlane(ct[ql]);
        if (n > limit) { int nk; const unsigned T = tk_compact(buf + ql * TK_CAP, buf + TKW_TRASH / 4, n, __builtin_amdgcn_readfirstlane(ct[8 + ql]), slack, lane, nk); if (lane == 0) { ct[ql] = (unsigned)nk; ct[8 + ql] = T; } } }
    LDS_WAIT();
}
__device__ __forceinline__ void topk_attn_unit(const GAS bf16* Z, const GAS bf16* KIT, GAS bf16* YB, LAS unsigned char* lds, int b, int qb, int wave, int lane_in, unsigned long long& pr_acc) {
    unsigned long long pr_t0 = (MK_PROBE >= 20) ? __builtin_amdgcn_s_memrealtime() : 0ull; unsigned long long pr_c = 0ull;
    (void)lane_in; unsigned ones_u = ~0u; asm volatile("" : "+s"(ones_u));
    const int lane = (int)__builtin_amdgcn_mbcnt_hi(ones_u, __builtin_amdgcn_mbcnt_lo(ones_u, 0u));
    LAS unsigned char* wl = lds + wave * TKW_BYTES;
    LAS unsigned* buf = (LAS unsigned*)(wl + TKW_BUF); LAS unsigned* ct = (LAS unsigned*)(wl + TKW_CT);
    const int half = lane >> 5, l31 = lane & 31;
    const size_t growb = (size_t)b * SEQ;
    const int tq0 = qb * 64 + wave * 8;
    if (lane < 16) ct[lane] = 0u;
    bf16x8 aq[4];
    { const GAS bf16* qr = Z + (growb + tq0 + (l31 >> 2)) * ZLD + ZB_QI + (l31 & 3) * 64 + 8 * half;
#pragma unroll
      for (int ks = 0; ks < 4; ++ks) aq[ks] = *(const GAS bf16x8*)(qr + 16 * ks); }
    float wv[4][4];
#pragma unroll
    for (int g = 0; g < 4; ++g) { const v2u ww = *(const GAS v2u*)(Z + (growb + tq0 + 2 * g + half) * ZLD + ZB_WI);
        wv[g][0] = bflo(ww.x) * 0.0625f; wv[g][1] = bfhi(ww.x) * 0.0625f; wv[g][2] = bflo(ww.y) * 0.0625f; wv[g][3] = bfhi(ww.y) * 0.0625f; }
    unsigned thr[4] = {0u, 0u, 0u, 0u};
    constexpr unsigned OVB1 = (unsigned)(0x8000 - TK_TRIG - 1), OVB = OVB1 * 0x00010001u;
    unsigned cpk[4] = {OVB, OVB, OVB, OVB};
    unsigned sh16 = (unsigned)half << 4, hmask = half ? 0u : ~0u; asm volatile("" : "+v"(sh16), "+v"(hmask));
    LAS unsigned* hb = buf + half * TK_CAP - OVB1;
    LAS unsigned* tr0 = buf + TKW_TRASH / 4 + lane;
    LDS_WAIT();
    const int ktmax = (tq0 + 7) >> 5;
    const GAS unsigned char* kimg = (const GAS unsigned char*)KIT + (size_t)(growb >> 5) * 4096 + lane * 16;
#define TK_GLD(dst, KT) do { const GAS unsigned char* kb_ = kimg + (unsigned)(KT) * 4096u; _Pragma("unroll") for (int i_ = 0; i_ < 4; ++i_) dst[i_] = *(const GAS bf16x8*)(kb_ + i_ * 1024); } while (0)
    bf16x8 bk[4];
    TK_GLD(bk, 0);
#pragma unroll 1
    for (int kt = 0; kt <= ktmax; ++kt) {
        bf16x8 bkn[4];
        { const int ktn = (kt < ktmax) ? kt + 1 : kt; TK_GLD(bkn, ktn); }
        f32x16 acc;
#pragma unroll
        for (int r = 0; r < 16; ++r) acc[r] = 0.f;
#pragma unroll
        for (int ks = 0; ks < 4; ++ks) acc = __builtin_amdgcn_mfma_f32_32x32x16_bf16(aq[ks], bk[ks], acc, 0, 0, 0);
        const int key = 32 * kt + l31;
#pragma unroll
        for (int g = 0; g < 4; ++g) {
            const int tq = tq0 + 2 * g + half;
            float s = 0.f;
#pragma unroll
            for (int h = 0; h < 4; ++h) { const float av = acc[4 * g + h]; const int ib = __float_as_int(av); s = fmaf(wv[g][h], __builtin_bit_cast(float, ib > 0 ? ib : 0), s); }
            const unsigned bb = __float_as_uint(s);
            const unsigned ord = bb ^ ((unsigned)((int)bb >> 31) | 0x80000000u);
            const unsigned packed = (ord & 0xFFFFE000u) | (0x1FFFu - (unsigned)key);
            const bool pass = (key <= tq) && (packed > thr[g]);
            const unsigned long long mask = __builtin_amdgcn_sicmp(key, tq, 41  ) & __builtin_amdgcn_uicmp(packed, thr[g], 34  );
            {
                const unsigned mlo = (unsigned)mask, mhi = (unsigned)(mask >> 32);
                const unsigned pos = __builtin_amdgcn_mbcnt_hi(mhi, __builtin_amdgcn_mbcnt_lo(mlo & hmask, __builtin_amdgcn_ubfe(cpk[g], sh16, 16u)));
                LAS unsigned* d1 = hb + pos; asm volatile("" : "+v"(d1));
                LAS unsigned* dst = pass ? d1 : tr0 - 2 * g * TK_CAP;
                dst[2 * g * TK_CAP] = packed;
                cpk[g] += (unsigned)__popc(mlo) + ((unsigned)__popc(mhi) << 16);
            }
        }
        if (((cpk[0] | cpk[1] | cpk[2] | cpk[3]) & 0x80008000u) != 0u) {
#pragma unroll
            for (int g = 0; g < 4; ++g) if (l31 == 0) ct[2 * g + half] = __builtin_amdgcn_ubfe(cpk[g], sh16, 16u) - OVB1;
            LDS_WAIT();
            { const unsigned long long c0_ = (MK_PROBE >= 20) ? __builtin_amdgcn_s_memrealtime() : 0ull;
            tk_compact_all(buf, ct, TK_TRIG, TK_SLACK, lane);
            if (MK_PROBE >= 20) pr_c += __builtin_amdgcn_s_memrealtime() - c0_; }
#pragma unroll
            for (int g = 0; g < 4; ++g) { cpk[g] = ((unsigned)__builtin_amdgcn_readfirstlane(ct[2 * g]) | ((unsigned)__builtin_amdgcn_readfirstlane(ct[2 * g + 1]) << 16)) + OVB; thr[g] = ct[8 + 2 * g + half]; }
        }
#pragma unroll
        for (int ks = 0; ks < 4; ++ks) bk[ks] = bkn[ks];
    }
#pragma unroll
    for (int g = 0; g < 4; ++g) if (l31 == 0) ct[2 * g + half] = __builtin_amdgcn_ubfe(cpk[g], sh16, 16u) - OVB1;
    LDS_WAIT();
    { const unsigned long long c0_ = (MK_PROBE >= 20) ? __builtin_amdgcn_s_memrealtime() : 0ull;
    tk_compact_all(buf, ct, TK_K, 0, lane);
    if (MK_PROBE >= 20) pr_c += __builtin_amdgcn_s_memrealtime() - c0_; }
#pragma unroll 1
    for (int ql = 0; ql < 8; ++ql) { const int nq = __builtin_amdgcn_readfirstlane(ct[ql]); LAS unsigned* bq_ = buf + ql * TK_CAP;
#pragma unroll
        for (int r = 0; r < 4; ++r) { const int idx = lane + 64 * r; const unsigned e_ = bq_[idx]; const unsigned key_ = (idx < nq) ? 0x1FFFu - (e_ & 0x1FFFu) : 0u; bq_[idx] = ((unsigned)growb + key_) * (unsigned)(ZLD * 2); } }
    LDS_WAIT();
    const unsigned long long pr_t1 = (MK_PROBE >= 20) ? __builtin_amdgcn_s_memrealtime() : 0ull;
    unsigned ones_v = ~0u; asm volatile("" : "+s"(ones_v)); const int lane2 = (int)__builtin_amdgcn_mbcnt_hi(ones_v, __builtin_amdgcn_mbcnt_lo(ones_v, 0u));
    const GAS bf16* Z2 = Z; GAS bf16* YB2 = YB; int tq02 = tq0, b2 = b, wv2 = wave; asm volatile("" : "+s"(Z2), "+s"(YB2), "+s"(tq02), "+s"(b2), "+s"(wv2));
    const size_t growb2 = (size_t)b2 * SEQ;
    LAS unsigned char* wl2 = lds + wv2 * TKW_BYTES;
    LAS unsigned* buf2 = (LAS unsigned*)(wl2 + TKW_BUF); LAS float* ps2 = (LAS float*)buf2; LAS unsigned* ct2 = (LAS unsigned*)(wl2 + TKW_CT);
    const int fr = lane2 & 15, fg = lane2 >> 4;
    const int jj = lane2 >> 3, ch = lane2 & 7;
    const int q4 = fr >> 2, p4 = fr & 3;
    LAS unsigned char* vt = (LAS unsigned char*)buf2;
#define TK_LDK(dst, BQ, NN, bt) do { _Pragma("unroll") for (int t4_ = 0; t4_ < 4; ++t4_) { const unsigned o_ = (BQ)[16 * (4 * (bt) + t4_) + fr] + kl; \
        dst[t4_][0] = *(const GAS bf16x8*)(zk + o_); dst[t4_][1] = *(const GAS bf16x8*)(zk + o_ + 64); } } while (0)
#define TK_LDQ(dst, QROW) do { _Pragma("unroll") for (int ks_ = 0; ks_ < 2; ++ks_) { bf16x8 t_ = {0, 0, 0, 0, 0, 0, 0, 0}; \
        if (fr < 4) t_ = *(const GAS bf16x8*)(Z2 + (QROW) * ZLD + ZB_Q + fr * 64 + 32 * ks_ + 8 * fg); dst[ks_] = t_; } } while (0)
#define TK_MMA(src, bt) do { _Pragma("unroll") for (int t4_ = 0; t4_ < 4; ++t4_) { f32x4 c_ = {0.f, 0.f, 0.f, 0.f}; \
        c_ = __builtin_amdgcn_mfma_f32_16x16x32_bf16(src[t4_][0], bqf[0], c_, 0, 0, 0); c_ = __builtin_amdgcn_mfma_f32_16x16x32_bf16(src[t4_][1], bqf[1], c_, 0, 0, 0); sacc[4 * (bt) + t4_] = c_; } } while (0)
#define TK_LDV(dst, ks) do { _Pragma("unroll") for (int i_ = 0; i_ < 4; ++i_) { const unsigned o_ = bq[32 * (ks) + 16 * (jj >> 2) + 4 * i_ + (jj & 3)] + vl; dst[i_] = *(const GAS v4u*)(zv + o_); } } while (0)
    const GAS unsigned char* zk = (const GAS unsigned char*)Z2 + ZB_K * 2; const GAS unsigned char* zv = (const GAS unsigned char*)Z2 + ZB_V * 2;
    const unsigned kl = 16u * (unsigned)fg, vl = 16u * (unsigned)ch;
    bf16x8 kan[4][2], bqn[2];
    { const int n0 = __builtin_amdgcn_readfirstlane(ct2[0]); TK_LDK(kan, buf2, n0, 0); TK_LDQ(bqn, growb2 + tq02); }
#pragma unroll 1
    for (int ql = 0; ql < 8; ++ql) {
        const int n = __builtin_amdgcn_readfirstlane(ct2[ql]);
        const size_t qrow = growb2 + tq02 + ql;
        LAS unsigned* bq = buf2 + ql * TK_CAP;
        bf16x8 bqf[2], kaA[4][2], kaB[4][2];
#pragma unroll
        for (int ks = 0; ks < 2; ++ks) bqf[ks] = bqn[ks];
#pragma unroll
        for (int t4 = 0; t4 < 4; ++t4) { kaA[t4][0] = kan[t4][0]; kaA[t4][1] = kan[t4][1]; }
        f32x4 sacc[16];
        v4u vr[4][4];
        TK_LDK(kaB, bq, n, 1);
        TK_MMA(kaA, 0);
        TK_LDK(kaA, bq, n, 2);
        TK_MMA(kaB, 1);
        TK_LDK(kaB, bq, n, 3);
        TK_MMA(kaA, 2);
        TK_LDV(vr[0], 0); TK_LDV(vr[1], 1); TK_LDV(vr[2], 2);
        TK_MMA(kaB, 3);
        const int nfg = n - 4 * fg;
        float mx = -INFINITY;
#pragma unroll
        for (int kt = 0; kt < 16; ++kt)
#pragma unroll
            for (int r = 0; r < 4; ++r) { const float v = (16 * kt + r < nfg) ? sacc[kt][r] * 0.125f : -INFINITY; sacc[kt][r] = v; mx = fmaxf(mx, v); }
        mx = fmaxf(mx, swz_xor<16>(mx)); mx = half_max(mx);
        float sm = 0.f;
#pragma unroll
        for (int kt = 0; kt < 16; ++kt)
#pragma unroll
            for (int r = 0; r < 4; ++r) { const float e = __expf(sacc[kt][r] - mx); sacc[kt][r] = e; sm += e; }
        sm += swz_xor<16>(sm); sm = half_sum(sm);
        const float inv = __builtin_amdgcn_rcpf(sm);
        bf16x8 pa[8];
#pragma unroll
        for (int ks = 0; ks < 8; ++ks) {
            v4u w; w.x = pk2(sacc[2 * ks][0] * inv, sacc[2 * ks][1] * inv); w.y = pk2(sacc[2 * ks][2] * inv, sacc[2 * ks][3] * inv);
            w.z = pk2(sacc[2 * ks + 1][0] * inv, sacc[2 * ks + 1][1] * inv); w.w = pk2(sacc[2 * ks + 1][2] * inv, sacc[2 * ks + 1][3] * inv);
            pa[ks] = __builtin_bit_cast(bf16x8, w); }
        f32x4 oacc[4];
#pragma unroll
        for (int nt = 0; nt < 4; ++nt) oacc[nt] = (f32x4){0.f, 0.f, 0.f, 0.f};
#pragma unroll
        for (int ks = 0; ks < 8; ++ks) {
            if (ks + 3 < 8) TK_LDV(vr[(ks + 3) & 3], ks + 3);
            if (ks == 5) { const int qn = (ql < 7) ? ql + 1 : 7; const int nn = __builtin_amdgcn_readfirstlane(ct2[qn]); TK_LDK(kan, buf2 + qn * TK_CAP, nn, 0); TK_LDQ(bqn, growb2 + tq02 + qn); }
#pragma unroll
            for (int i = 0; i < 4; ++i) *(LAS v4u*)(vt + i * (TK_CAP * 4) + 1024 + jj * 128 + ch * 16) = vr[ks & 3][i];
            LDS_WAIT();
#pragma unroll
            for (int nt = 0; nt < 4; ++nt) {
                typedef short s4v __attribute__((ext_vector_type(4)));
                const s4v lo = __builtin_amdgcn_ds_read_tr16_b64_v4i16((LAS s4v*)(vt + fg * (TK_CAP * 4) + 1024 + q4 * 128 + (16 * nt + 4 * p4) * 2));
                const s4v hi = __builtin_amdgcn_ds_read_tr16_b64_v4i16((LAS s4v*)(vt + fg * (TK_CAP * 4) + 1024 + (4 + q4) * 128 + (16 * nt + 4 * p4) * 2));
                const bf16x8 vb = {lo[0], lo[1], lo[2], lo[3], hi[0], hi[1], hi[2], hi[3]};
                oacc[nt] = __builtin_amdgcn_mfma_f32_16x16x32_bf16(pa[ks], vb, oacc[nt], 0, 0, 0); }
            LDS_WAIT();
        }
        if (fg == 0) {
#pragma unroll
            for (int nt = 0; nt < 4; ++nt)
#pragma unroll
                for (int h = 0; h < 4; ++h) YB2[qrow * 256 + h * 64 + 16 * nt + fr] = (bf16)f2bf(oacc[nt][h]);
        }
    }
#undef TK_GLD
#undef TK_LDK
#undef TK_LDQ
#undef TK_MMA
#undef TK_LDV
    if (MK_PROBE >= 20) { const unsigned long long pr_t2 = __builtin_amdgcn_s_memrealtime(); pr_acc += (MK_PROBE == 20) ? (pr_t1 - pr_t0 - pr_c) : (MK_PROBE == 21) ? pr_c : (pr_t2 - pr_t1); }
}

__device__ __forceinline__ void zero_ys(GAS bf16* Y, int gtid, int gstride) { for (size_t i = gtid; i < (size_t)MG * 256 / 8; i += gstride) ((GAS v4u*)Y)[i] = (v4u){0u, 0u, 0u, 0u}; }

__device__ __forceinline__ const void* ld_arg(LAS unsigned char* lds, int k) {
    unsigned off = MISC_OFF + 128 + 8 * k; asm volatile("" : "+v"(off));
    const LAS unsigned* p = (const LAS unsigned*)(lds + off);
    const unsigned lo = __builtin_amdgcn_readfirstlane(p[0]), hi = __builtin_amdgcn_readfirstlane(p[1]);
    return (const void*)(((unsigned long long)hi << 32) | lo);
}
__device__ __forceinline__ bool run_step(int lo, int hi, int s) {
    asm volatile("" : "+s"(lo), "+s"(hi));
    return s >= lo && s < hi;
}
struct GatedOrder {
    int G, c;
    __device__ __forceinline__ void init(int G_, int c_) { G = G_; c = c_; }
    __device__ __forceinline__ bool next(int i, pg8::Unit& u) const {
        const int nb = i & 3, t = (i >> 2) * G + c; if (t >= (MG / 256) * 4) return false;
        u.pm = nb * (MG / 256) + (t >> 2); u.pn = nb * 4 + (t & 3); return true;
    }
    __device__ __forceinline__ void a_ready(const pg8::Unit&) const {}
    __device__ __forceinline__ void done(const pg8::Unit&) const {}
};
struct KArgs { const void* in[22]; float* out; unsigned char* ws; int step_lo, step_hi, li, pad; };
constexpr int N_STEPS = 32;

__global__ void __launch_bounds__(NTHREADS, 2) mega_fwd(KArgs a) {
    extern __shared__ __attribute__((aligned(16))) unsigned char lds_raw[];
    LAS unsigned char* lds = (LAS unsigned char*)lds_raw;
    volatile LAS unsigned* MISC = (volatile LAS unsigned*)(lds + MISC_OFF);
    const int G = gridDim.x; const int bx = blockIdx.x; const int vcu = (G % 8 == 0) ? (bx % 8) * (G / 8) + bx / 8 : bx;
    const int NGW = G * NWAVES, gstride = G * NTHREADS;
    if (threadIdx.x < 16) MISC[threadIdx.x] = 0u;
    const int wave_s = __builtin_amdgcn_readfirstlane(threadIdx.x >> 6);
    if (threadIdx.x < 22) ((volatile LAS unsigned long long*)(lds + MISC_OFF + 128))[threadIdx.x] = (unsigned long long)a.in[threadIdx.x];
    __syncthreads();
#define IN(k) ((const GAS float*)ld_arg(lds, (k)))
    GAS unsigned char* const ws_k = (GAS unsigned char*)a.ws;
    const bool use_bar = (a.step_hi - a.step_lo) > 1;
    XcdBarrier bar; bar.bar = (unsigned*)(ws_k + WS_CTL) + CW_BAR + a.li * XCD_BAR_WORDS; bar.x = 0; bar.st = nullptr;
    if (use_bar) bar = xcd_barrier_post((unsigned*)(ws_k + WS_CTL) + CW_BAR + a.li * XCD_BAR_WORDS, MISC + 8);
#define RUN(s) run_step(a.step_lo, a.step_hi, (s))
    unsigned long long pr_acc = 0ull, pr_prev = MK_PROBE ? __builtin_amdgcn_s_memrealtime() : 0ull; const unsigned long long pr_start = pr_prev;
#define SEAM(s) do { if (RUN(s) && RUN((s) + 1)) xcd_barrier(bar); if (MK_PROBE > 0 && MK_PROBE < 20) { const unsigned long long tn_ = __builtin_amdgcn_s_memrealtime(); \
        const int s_ = (s); const int ty_ = (s_ == 0) ? 1 : (s_ == 31) ? 12 : (((s_ - 1) % 15) == 0) ? 2 : (((s_ - 1) % 15) >= 11) ? (((s_ - 1) % 15) - 3) : ((((s_ - 1) % 15) - 1) % 5 + 3); \
        if (ty_ == MK_PROBE) pr_acc += tn_ - pr_prev; pr_prev = tn_; } } while (0)
#define STEP_IDS unsigned ones_ = ~0u; asm volatile("" : "+s"(ones_)); GAS unsigned char* ws = ws_k; asm volatile("" : "+s"(ws)); const int lane = (int)__builtin_amdgcn_mbcnt_hi(ones_, __builtin_amdgcn_mbcnt_lo(ones_, 0u)); int wave = wave_s; asm volatile("" : "+s"(wave)); \
    const int tid = wave * 64 + lane; const int gw = vcu * NWAVES + wave, gtid = vcu * NTHREADS + tid; (void)gw; (void)gtid;
#define STEP_L int l = l0; asm volatile("" : "+s"(l));
#define STEP_G int g = g0; asm volatile("" : "+s"(g));
#define P_CMOD ((GAS float*)(ws + WS_CMOD))
#define P_ROPE ((GAS float*)(ws + WS_ROPE))
#define P_H ((GAS bf16*)(ws + WS_H))
#define P_Z ((GAS bf16*)(ws + WS_Z))
#define P_GT ((GAS bf16*)(ws + WS_GATES))
#define P_YS ((GAS bf16*)(ws + WS_YS))
#define P_XR ((GAS bf16*)(ws + WS_MF32))
#define P_KIT ((GAS bf16*)(ws + WS_KIT))
#define P_STC ((GAS bf16*)(ws + WS_STC))
#define P_STD ((GAS bf16*)(ws + WS_STD))
#define P_DECC ((GAS float*)(ws + WS_DECC))
#define P_DECD ((GAS float*)(ws + WS_DECD))
#define P_U ((GAS bf16*)(ws + WS_U))

    if (RUN(0)) { STEP_IDS
        p0_weights(IN(7), IN(17), IN(18), IN(19), IN(20), ws, lds, gw, NGW, wave, lane);
        __syncthreads();
        p0_rope(P_ROPE, gtid, gstride);
        p0_cmod(IN(1), IN(3), IN(4), P_CMOD, lds, vcu, G, tid, wave, lane);
    }
    SEAM(0);

    for (int l0 = 0; l0 < NL; ++l0) {
        const int sb = 1 + l0 * 15;
        if (RUN(sb)) { STEP_IDS STEP_L
            if (MK_SKIP & 1) { if (l == 0) copy_rows(IN(0), P_XR, gw, NGW, lane); }
            else if (l == 0) norm_rows<true>(IN(0), P_H, IN(5) + l * DM, P_CMOD + (size_t)l * NB * 6144, 0, 1024, gw, NGW, lane);
            else norm_rows<false>(P_XR, P_H, IN(5) + l * DM, P_CMOD + (size_t)l * NB * 6144, 0, 1024, gw, NGW, lane);
        }
        SEAM(sb);
        for (int g0 = 0; g0 < NGRP; ++g0) {
            const int sg = sb + 1 + g0 * 5;
            if (RUN(sg) && !(MK_SKIP & 1)) { STEP_IDS STEP_L STEP_G
                pg8::Gemm gm{(const bf16*)(P_H + (size_t)g * MG * DM), (const bf16*)((const GAS bf16*)(ws + WS_WIN) + (size_t)l * NV * 1024), MG, NV, 1024};
                pg8::StaticOrder S; S.init(MG, NV, G, bx);
                EpiZ E{P_Z, P_GT};
                for (int rp = 0; rp < ((MK_REPEAT & 8) ? 2 : 1); ++rp) pg8::gemm_phase<EpiZ, pg8::StaticOrder, true, true>(lds, gm, S, E, tid);
            }
            SEAM(sg);
            if (RUN(sg + 1) && !(MK_SKIP & 1)) { STEP_IDS STEP_L STEP_G
                LinPar LP{P_Z, IN(12) + l * 16 * 128, IN(13) + l * 128, IN(15), l};
                constexpr int U_ROPE = 10 * (MG / NTHREADS), U_CONV = GB * 128, U_LIN = GB * NCH * 2;
                for (int u = vcu; u < U_ROPE + U_CONV + 2 * U_LIN; u += G) {
                    int r = u;
                    if (r < U_LIN) { if (!(MK_SKIP & 32)) lin2_unit<64, 0>(LP, P_STD, P_DECD, nullptr, nullptr, lds, r, wave); continue; } r -= U_LIN;
                    if (r < U_LIN) { if (!(MK_SKIP & 16)) lin2_unit<32, 0>(LP, P_STC, P_DECC, nullptr, nullptr, lds, r, wave); continue; } r -= U_LIN;
                    if (r < U_CONV) { if (!(MK_SKIP & 4)) conv2_unit(P_Z, P_YS, IN(8) + l * 31 * 256, IN(9) + l * 256, IN(10) + l * 256, IN(11) + l * 256, lds, r, wave); continue; } r -= U_CONV;
                    if (!(MK_SKIP & 8)) rope_unit(P_Z, P_KIT, (const GAS int*)IN(2) + (size_t)g * MG, P_ROPE, r, tid);
                }
                if (MK_SKIP & 4) zero_ys(P_YS, gtid, gstride);
                if (MK_SKIP & 8) zero_ys(P_YS + (size_t)MG * 256, gtid, gstride);
                if (MK_SKIP & 16) zero_ys(P_YS + (size_t)2 * MG * 256, gtid, gstride);
                if (MK_SKIP & 32) zero_ys(P_YS + (size_t)3 * MG * 256, gtid, gstride);
            }
            SEAM(sg + 1);
            if (RUN(sg + 2) && !(MK_SKIP & 1)) { STEP_IDS STEP_L STEP_G
                constexpr int U_SCAN = (GB * 4096 + GB * 8192) / 192;
                if (!(MK_SKIP & 48)) for (int u = vcu; u < U_SCAN; u += G) scan_unit(P_STC, P_STD, P_DECC, P_DECD, u, tid);
                if (!(MK_SKIP & 8)) for (int rp = 0; rp < ((MK_REPEAT & 1) ? 2 : 1); ++rp) {
                    const int W = G / GB;
                    if (W > 0 && vcu < W * GB) { const int b = vcu / W, j = vcu % W;
                        for (int p2 = 2 * j; p2 < 128; p2 += 2 * W) for (int it = 0; it < 2; ++it) { const int p = p2 >> 1; topk_attn_unit(P_Z, P_KIT, P_YS + (size_t)MG * 256, lds, b, it ? p : 127 - p, wave, lane, pr_acc); } }
                }
            }
            SEAM(sg + 2);
            if (RUN(sg + 3) && !(MK_SKIP & 1)) { STEP_IDS STEP_L STEP_G
                LinPar LP{P_Z, IN(12) + l * 16 * 128, IN(13) + l * 128, IN(15), l};
                constexpr int U_LIN = GB * NCH * 2;
                for (int rp = 0; rp < ((MK_REPEAT & 2) ? 2 : 1); ++rp)
                for (int u = vcu; u < 2 * U_LIN; u += G) {
                    if (u < U_LIN) { if (!(MK_SKIP & 16)) lin2_unit<32, 1>(LP, P_STC, nullptr, IN(14) + l * 64, P_YS + (size_t)2 * MG * 256, lds, u, wave); }
                    else { if (!(MK_SKIP & 32)) lin2_unit<64, 1>(LP, P_STD, nullptr, IN(16) + l * 64, P_YS + (size_t)3 * MG * 256, lds, u - U_LIN, wave); }
                }
            }
            SEAM(sg + 3);
            if (RUN(sg + 4) && !(MK_SKIP & 1)) { STEP_IDS STEP_L STEP_G
                pg8::Gemm gm{(const bf16*)(P_YS), (const bf16*)((const GAS bf16*)(ws + WS_WBO) + (size_t)l * 4 * 1024 * 256), 4 * MG, 4 * 1024, 256};
                GatedOrder S; S.init(G, vcu);
                EpiGated E{P_GT, P_H + (size_t)g * MG * DM};
                for (int rp = 0; rp < ((MK_REPEAT & 32) ? 2 : 1); ++rp) pg8::gemm_phase<EpiGated, GatedOrder, true, true>(lds, gm, S, E, tid);
            }
            SEAM(sg + 4);
        }
        if (RUN(sb + 11) && !(MK_SKIP & 1)) { STEP_IDS STEP_L
            pg8::Gemm gm{(const bf16*)(P_H), (const bf16*)((const GAS bf16*)(ws + WS_WO) + (size_t)l * 1024 * 1024), M_ALL, 1024, 1024};
            pg8::StaticOrder S; S.init(M_ALL, 1024, G, bx);
            if (l == 0) { EpiResid<true> E{IN(0), P_XR, P_CMOD + (size_t)l * NB * 6144 + 2048}; pg8::gemm_phase<EpiResid<true>, pg8::StaticOrder, true, true>(lds, gm, S, E, tid); }
            else { EpiResid<false> E{P_XR, P_XR, P_CMOD + (size_t)l * NB * 6144 + 2048}; pg8::gemm_phase<EpiResid<false>, pg8::StaticOrder, true, true>(lds, gm, S, E, tid); }
        }
        SEAM(sb + 11);
        if (RUN(sb + 12) && !(MK_SKIP & 2)) { STEP_IDS STEP_L
            norm_rows<false>(P_XR, P_H, IN(6) + l * DM, P_CMOD + (size_t)l * NB * 6144, 3072, 4096, gw, NGW, lane); }
        SEAM(sb + 12);
        if (RUN(sb + 13) && !(MK_SKIP & 2)) { STEP_IDS STEP_L
            pg8::Gemm gm{(const bf16*)(P_H), (const bf16*)((const GAS bf16*)(ws + WS_W1) + (size_t)l * DFF * 1024), M_ALL, DFF, 1024};
            pg8::StaticOrder S; S.init(M_ALL, DFF, G, bx);
            EpiRelu2 E{P_U};
            for (int rp = 0; rp < ((MK_REPEAT & 16) ? 2 : 1); ++rp) pg8::gemm_phase<EpiRelu2, pg8::StaticOrder, true, true>(lds, gm, S, E, tid);
        }
        SEAM(sb + 13);
        if (RUN(sb + 14) && !(MK_SKIP & 2)) { STEP_IDS STEP_L
            pg8::Gemm gm{(const bf16*)(P_U), (const bf16*)((const GAS bf16*)(ws + WS_W2) + (size_t)l * 1024 * DFF), M_ALL, 1024, DFF};
            pg8::StaticOrder S; S.init(M_ALL, 1024, G, bx);
            EpiResid<false> E{P_XR, P_XR, P_CMOD + (size_t)l * NB * 6144 + 5120};
            pg8::gemm_phase<EpiResid<false>, pg8::StaticOrder, true, true>(lds, gm, S, E, tid);
        }
        SEAM(sb + 14);
    }
    if (RUN(31)) { STEP_IDS
        float oscale = 1.0f;
        if (MK_PROBE) { const unsigned long long tt_ = __builtin_amdgcn_s_memrealtime() - pr_start; oscale = 1.0f + (float)pr_acc / ((float)tt_ * (float)MK_PROBE_DIV); }
        final_norm_rows(P_XR, ((GAS float*)a.out), IN(21), gw, NGW, lane, oscale); }
#undef RUN
#undef SEAM
}

extern "C" void kernel_launch(void* const* d_in, const int* in_sizes, int n_in, void* d_out, int out_size, void* d_ws, size_t ws_size, hipStream_t stream) {
    static int grid = 0;
    if (grid == 0) {
        if (n_in != 22 || out_size != M_ALL * DM || ws_size < WS_END) { fprintf(stderr, "kernel_launch: unexpected problem shape (n_in %d out %d ws %zu)\n", n_in, out_size, ws_size); grid = -1; return; }
        int dev = 0, cus = 0, per_cu = 0;
        if (hipGetDevice(&dev) != hipSuccess || hipDeviceGetAttribute(&cus, hipDeviceAttributeMultiprocessorCount, dev) != hipSuccess) { grid = -1; return; }
        if (hipFuncSetAttribute((const void*)mega_fwd, hipFuncAttributeMaxDynamicSharedMemorySize, LDS_BYTES) != hipSuccess) { fprintf(stderr, "kernel_launch: hipFuncSetAttribute failed\n"); grid = -1; return; }
        if (hipOccupancyMaxActiveBlocksPerMultiprocessor(&per_cu, (const void*)mega_fwd, NTHREADS, LDS_BYTES) != hipSuccess || per_cu < 1) fprintf(stderr, "kernel_launch: occupancy query reports %d\n", per_cu);
        (void)hipGetLastError();
        grid = cus;
    }
    if (grid < 0) return;
    (void)hipMemsetAsync((char*)d_ws + WS_CTL, 0, CTL_ZERO_BYTES, stream);
    KArgs a{};
    for (int i = 0; i < 22; ++i) a.in[i] = d_in[i];
    a.out = (float*)d_out; a.ws = (unsigned char*)d_ws; a.pad = 0;
#if MK_N_LAUNCHES == 1
    a.step_lo = 0; a.step_hi = N_STEPS; a.li = 0;
    hipLaunchKernelGGL(mega_fwd, dim3(grid), dim3(NTHREADS), LDS_BYTES, stream, a);
#else
    for (int s = 0; s < N_STEPS; ++s) { a.step_lo = s; a.step_hi = s + 1; a.li = s;
        hipLaunchKernelGGL(mega_fwd, dim3(grid), dim3(NTHREADS), LDS_BYTES, stream, a); }
#endif
}
```
